# Optimizing an MI355X kernel written in HIP

```python
import math
import jax, jax.numpy as jnp
from jax import lax
import numpy as np


D_MODEL = 1024
BATCH = 1
SEQ = 16384
DEPTH = 4

GRID_W = 64
ROPE_THETA = 10000.0
EPS = 1e-6
NEG_INF = -1e30
Q_BLOCK = 128

MLA_HEADS = 4
MLA_Q_RANK = 192
MLA_KV_RANK = 128
MLA_NOPE_DIM = 64
MLA_ROPE_DIM = 32
MLA_V_DIM = 64
DIFF_HEADS = 4
DIFF_QK_DIM = 32
DIFF_V_DIM = 64
SWA_Q_HEADS = 4
SWA_KV_HEADS = 2
SWA_GROUP = SWA_Q_HEADS // SWA_KV_HEADS
SWA_HEAD_DIM = 64
WINDOW = 128
SWA_BLOCK = 128
NA_HEADS = 4
NA_HEAD_DIM = 64
NA_ROWS_MAX = 8
NA_COLS = 16
D_FF = 4 * D_MODEL

A_OUT = MLA_HEADS * MLA_V_DIM
B_OUT = DIFF_HEADS * DIFF_V_DIM
C_OUT = SWA_Q_HEADS * SWA_HEAD_DIM
D_OUT = NA_HEADS * NA_HEAD_DIM
MIX_WIDTH = A_OUT + B_OUT + C_OUT + D_OUT

IN_SPLIT_WIDTHS = (
    MLA_Q_RANK, MLA_KV_RANK, MLA_ROPE_DIM,
    DIFF_HEADS * 2 * DIFF_QK_DIM, DIFF_HEADS * 2 * DIFF_QK_DIM, B_OUT,
    SWA_Q_HEADS * SWA_HEAD_DIM, SWA_KV_HEADS * SWA_HEAD_DIM, SWA_KV_HEADS * SWA_HEAD_DIM,
    NA_HEADS * NA_HEAD_DIM, NA_HEADS * NA_HEAD_DIM, NA_HEADS * NA_HEAD_DIM,
)
IN_COLS = sum(IN_SPLIT_WIDTHS)

kernel_name = 'hybrid_parallel_head_group_encoder'


def _split_points():
    pts, acc = [], 0
    for w in IN_SPLIT_WIDTHS[:-1]:
        acc += w
        pts.append(acc)
    return pts


def rms_norm(x, g):
    xf = x.astype(jnp.float32)
    y = xf * lax.rsqrt(jnp.mean(xf * xf, axis=-1, keepdims=True) + EPS)
    return (y * g.astype(jnp.float32)).astype(x.dtype)


def rope_table(seq_len, dim):
    inv = 1.0 / (ROPE_THETA ** (jnp.arange(0, dim, 2, dtype=jnp.float32) / dim))
    ang = jnp.arange(seq_len, dtype=jnp.float32)[:, None] * inv[None, :]
    return jnp.cos(ang), jnp.sin(ang)


def apply_rope(x, cos, sin):
    shp = (1, x.shape[1]) + (1,) * (x.ndim - 3) + (cos.shape[-1],)
    c, s = cos.reshape(shp), sin.reshape(shp)
    xf = x.astype(jnp.float32)
    half = x.shape[-1] // 2
    x1, x2 = xf[..., :half], xf[..., half:]
    return jnp.concatenate([x1 * c - x2 * s, x2 * c + x1 * s], axis=-1).astype(x.dtype)


def dense_block_attention(q, k, v, scale):
    B, S, H, dq = q.shape
    nb = S // Q_BLOCK
    qb = jnp.moveaxis(q.reshape(B, nb, Q_BLOCK, H, dq), 1, 0)

    def one_block(qi):
        s = jnp.einsum('bqhd,bkhd->bhqk', qi, k, preferred_element_type=jnp.float32) * scale
        p = jax.nn.softmax(s, axis=-1)
        return jnp.einsum('bhqk,bkhd->bqhd', p.astype(v.dtype), v)

    o = lax.map(one_block, qb)
    return jnp.moveaxis(o, 0, 1).reshape(B, S, H, v.shape[-1])


def mla_mixer(cq, ckv, kr, q_norm_g, w_uq, kv_norm_g, w_uk, w_uv, cos, sin):
    B, S, _ = cq.shape
    q = (rms_norm(cq, q_norm_g) @ w_uq).reshape(B, S, MLA_HEADS, MLA_NOPE_DIM + MLA_ROPE_DIM)
    q = jnp.concatenate([q[..., :MLA_NOPE_DIM], apply_rope(q[..., MLA_NOPE_DIM:], cos, sin)], axis=-1)
    c = rms_norm(ckv, kv_norm_g)
    k_nope = (c @ w_uk).reshape(B, S, MLA_HEADS, MLA_NOPE_DIM)
    v = (c @ w_uv).reshape(B, S, MLA_HEADS, MLA_V_DIM)
    k_pe = apply_rope(kr[:, :, None, :], cos, sin)
    k = jnp.concatenate([k_nope, jnp.broadcast_to(k_pe, (B, S, MLA_HEADS, MLA_ROPE_DIM))], axis=-1)
    o = dense_block_attention(q, k, v, (MLA_NOPE_DIM + MLA_ROPE_DIM) ** -0.5)
    return o.reshape(B, S, A_OUT)


def diff_mixer(q, k, v, lq1, lk1, lq2, lk2, subln_g, lambda_init, cos, sin):
    B, S, _ = q.shape
    q = apply_rope(q.reshape(B, S, DIFF_HEADS, 2, DIFF_QK_DIM), cos, sin)
    k = apply_rope(k.reshape(B, S, DIFF_HEADS, 2, DIFF_QK_DIM), cos, sin)
    v = v.reshape(B, S, DIFF_HEADS, DIFF_V_DIM)
    f32 = jnp.float32
    lam = (jnp.exp(jnp.sum(lq1.astype(f32) * lk1.astype(f32)))
           - jnp.exp(jnp.sum(lq2.astype(f32) * lk2.astype(f32))) + lambda_init)
    scale = DIFF_QK_DIM ** -0.5
    nb = S // Q_BLOCK
    qb = jnp.moveaxis(q.reshape(B, nb, Q_BLOCK, DIFF_HEADS, 2, DIFF_QK_DIM), 1, 0)

    def one_block(qi):
        s = jnp.einsum('bqhcd,bkhcd->bhcqk', qi, k, preferred_element_type=f32) * scale
        p = jax.nn.softmax(s, axis=-1)
        w = p[:, :, 0] - lam * p[:, :, 1]
        return jnp.einsum('bhqk,bkhd->bqhd', w.astype(v.dtype), v)

    o = jnp.moveaxis(lax.map(one_block, qb), 0, 1).reshape(B, S, DIFF_HEADS, DIFF_V_DIM)
    o = rms_norm(o, subln_g) * (1.0 - lambda_init)
    return o.reshape(B, S, B_OUT)


def swa_mixer(q, k, v, sinks, cos, sin):
    B, S, _ = q.shape
    q = apply_rope(q.reshape(B, S, SWA_KV_HEADS, SWA_GROUP, SWA_HEAD_DIM), cos, sin)
    k = apply_rope(k.reshape(B, S, SWA_KV_HEADS, SWA_HEAD_DIM), cos, sin)
    v = v.reshape(B, S, SWA_KV_HEADS, SWA_HEAD_DIM)
    nb = S // SWA_BLOCK
    qb = q.reshape(B, nb, SWA_BLOCK, SWA_KV_HEADS, SWA_GROUP, SWA_HEAD_DIM)

    def band(t):
        tp = jnp.pad(t, ((0, 0), (SWA_BLOCK, SWA_BLOCK), (0, 0), (0, 0)))
        tp = tp.reshape(B, nb + 2, SWA_BLOCK, SWA_KV_HEADS, SWA_HEAD_DIM)
        return jnp.concatenate([tp[:, :-2], tp[:, 1:-1], tp[:, 2:]], axis=2)

    kb, vb = band(k), band(v)
    s = jnp.einsum('bnqkgd,bnjkd->bnkgqj', qb, kb,
                   preferred_element_type=jnp.float32) * (SWA_HEAD_DIM ** -0.5)
    qi = jnp.arange(SWA_BLOCK)[:, None]
    kj = jnp.arange(3 * SWA_BLOCK)[None, :]
    rel = kj - SWA_BLOCK - qi
    kabs = jnp.arange(nb)[:, None] * SWA_BLOCK - SWA_BLOCK + jnp.arange(3 * SWA_BLOCK)[None, :]
    valid = (jnp.abs(rel) <= WINDOW)[None] & ((kabs >= 0) & (kabs < S))[:, None, :]
    s = jnp.where(valid[None, :, None, None], s, NEG_INF)
    sink = jnp.broadcast_to(sinks.astype(jnp.float32).reshape(1, 1, SWA_KV_HEADS, SWA_GROUP, 1, 1),
                            s.shape[:-1] + (1,))
    p = jax.nn.softmax(jnp.concatenate([s, sink], axis=-1), axis=-1)[..., :-1]
    o = jnp.einsum('bnkgqj,bnjkd->bnqkgd', p.astype(v.dtype), vb)
    return o.reshape(B, S, C_OUT)


def na_mixer(q, k, v, rpb):
    B, S, _ = q.shape
    rows = S // GRID_W
    kh = min(NA_ROWS_MAX, rows)
    shp = (B, rows, GRID_W, NA_HEADS, NA_HEAD_DIM)
    q, k, v = q.reshape(shp), k.reshape(shp), v.reshape(shp)
    row_start = jnp.clip(jnp.arange(rows) - kh // 2, 0, rows - kh)
    col = np.arange(GRID_W)
    col_start = np.clip(col - NA_COLS // 2, 0, GRID_W - NA_COLS)
    col_idx = col_start[:, None] + np.arange(NA_COLS)[None, :]
    col_off = col_idx - col[:, None]
    rpb_cols = rpb[:, :, col_off + NA_COLS - 1]
    scale = NA_HEAD_DIM ** -0.5

    def one_row(args):
        q_r, start, r = args
        k_r = lax.dynamic_slice_in_dim(k, start, kh, axis=1)[:, :, col_idx]
        v_r = lax.dynamic_slice_in_dim(v, start, kh, axis=1)[:, :, col_idx]
        bias = jnp.take(rpb_cols, start + jnp.arange(kh) - r + NA_ROWS_MAX - 1, axis=1)
        s = jnp.einsum('bwhd,bawchd->bhwac', q_r, k_r, preferred_element_type=jnp.float32) * scale
        s = s + jnp.transpose(bias, (0, 2, 1, 3)).astype(jnp.float32)[None]
        p = jax.nn.softmax(s.reshape(B, NA_HEADS, GRID_W, kh * NA_COLS), axis=-1).reshape(s.shape)
        return jnp.einsum('bhwac,bawchd->bwhd', p.astype(v.dtype), v_r)

    o = lax.map(one_row, (jnp.moveaxis(q, 1, 0), row_start, jnp.arange(rows)))
    return jnp.moveaxis(o, 0, 1).reshape(B, S, D_OUT)


def setup_inputs(seed: int = 0) -> dict:
    key = jax.random.key(seed)
    ks = jax.random.split(key, 24)
    f32 = jnp.float32
    L = DEPTH

    def nrm(k, shape, scale):
        return jax.random.normal(k, shape, f32) * scale

    def gain(k, shape):
        return 1.0 + 0.05 * jax.random.normal(k, shape, f32)

    return {
        'x': nrm(ks[0], (BATCH, SEQ, D_MODEL), 1.0),
        'norm1_g': gain(ks[1], (L, D_MODEL)),
        'w_in': nrm(ks[2], (L, D_MODEL, IN_COLS), D_MODEL ** -0.5),
        'mla_q_norm_g': gain(ks[3], (L, MLA_Q_RANK)),
        'mla_w_uq': nrm(ks[4], (L, MLA_Q_RANK, MLA_HEADS * (MLA_NOPE_DIM + MLA_ROPE_DIM)), MLA_Q_RANK ** -0.5),
        'mla_kv_norm_g': gain(ks[5], (L, MLA_KV_RANK)),
        'mla_w_uk': nrm(ks[6], (L, MLA_KV_RANK, MLA_HEADS * MLA_NOPE_DIM), MLA_KV_RANK ** -0.5),
        'mla_w_uv': nrm(ks[7], (L, MLA_KV_RANK, MLA_HEADS * MLA_V_DIM), MLA_KV_RANK ** -0.5),
        'diff_lambda_q1': nrm(ks[8], (L, DIFF_QK_DIM), 0.1),
        'diff_lambda_k1': nrm(ks[9], (L, DIFF_QK_DIM), 0.1),
        'diff_lambda_q2': nrm(ks[10], (L, DIFF_QK_DIM), 0.1),
        'diff_lambda_k2': nrm(ks[11], (L, DIFF_QK_DIM), 0.1),
        'diff_subln_g': gain(ks[12], (L, DIFF_V_DIM)),
        'swa_sinks': nrm(ks[13], (L, SWA_Q_HEADS), 0.5),
        'na_rpb': nrm(ks[14], (L, NA_HEADS, 2 * NA_ROWS_MAX - 1, 2 * NA_COLS - 1), 0.1),
        'out_g_mla': gain(ks[15], (L, A_OUT)),
        'out_g_swa': gain(ks[16], (L, C_OUT)),
        'out_g_na': gain(ks[17], (L, D_OUT)),
        'w_out': nrm(ks[18], (L, MIX_WIDTH, D_MODEL), MIX_WIDTH ** -0.5),
        'norm2_g': gain(ks[19], (L, D_MODEL)),
        'w_up': nrm(ks[20], (L, D_MODEL, D_FF), D_MODEL ** -0.5),
        'w_down': nrm(ks[21], (L, D_FF, D_MODEL), D_FF ** -0.5),
        'final_norm_g': gain(ks[22], (D_MODEL,)),
    }


def reference(x, norm1_g, w_in, mla_q_norm_g, mla_w_uq, mla_kv_norm_g, mla_w_uk, mla_w_uv,
              diff_lambda_q1, diff_lambda_k1, diff_lambda_q2, diff_lambda_k2, diff_subln_g,
              swa_sinks, na_rpb, out_g_mla, out_g_swa, out_g_na, w_out, norm2_g, w_up, w_down,
              final_norm_g):
    S = x.shape[1]
    cos32, sin32 = rope_table(S, MLA_ROPE_DIM)
    cos64, sin64 = rope_table(S, SWA_HEAD_DIM)
    splits = _split_points()
    for l in range(DEPTH):
        h = rms_norm(x, norm1_g[l])
        proj = h @ w_in[l]
        (a_cq, a_ckv, a_kr, b_q, b_k, b_v, c_q, c_k, c_v, d_q, d_k, d_v) = jnp.split(proj, splits, axis=-1)
        y_a = mla_mixer(a_cq, a_ckv, a_kr, mla_q_norm_g[l], mla_w_uq[l], mla_kv_norm_g[l],
                        mla_w_uk[l], mla_w_uv[l], cos32, sin32)
        lambda_init = 0.8 - 0.6 * math.exp(-0.3 * l)
        y_b = diff_mixer(b_q, b_k, b_v, diff_lambda_q1[l], diff_lambda_k1[l], diff_lambda_q2[l],
                         diff_lambda_k2[l], diff_subln_g[l], lambda_init, cos32, sin32)
        y_c = swa_mixer(c_q, c_k, c_v, swa_sinks[l], cos64, sin64)
        y_d = na_mixer(d_q, d_k, d_v, na_rpb[l])
        mix = jnp.concatenate([rms_norm(y_a, out_g_mla[l]), y_b,
                               rms_norm(y_c, out_g_swa[l]), rms_norm(y_d, out_g_na[l])], axis=-1)
        x = x + mix @ w_out[l]
        h = rms_norm(x, norm2_g[l])
        x = x + jnp.square(jax.nn.relu(h @ w_up[l])) @ w_down[l]
    return rms_norm(x, final_norm_g)
```

```cpp
#include <hip/hip_runtime.h>
#include <hip/hip_cooperative_groups.h>
#include <cstdio>
#include <cmath>
namespace cg = cooperative_groups;

typedef unsigned short bf16_t;
typedef short bf16x8 __attribute__((ext_vector_type(8)));
typedef float f32x16 __attribute__((ext_vector_type(16)));
typedef float f32x4 __attribute__((ext_vector_type(4)));
typedef float f32x2 __attribute__((ext_vector_type(2)));
typedef unsigned u32x2 __attribute__((ext_vector_type(2)));
typedef unsigned u32x4 __attribute__((ext_vector_type(4)));
typedef __bf16 bf2_t __attribute__((ext_vector_type(2)));

constexpr int S = 16384, NP = 2432;
constexpr float EPS = 1e-6f, LOG2E = 1.4426950408889634f;

constexpr size_t OFF_WIN = 0;
constexpr size_t OFF_WOUT = OFF_WIN + (size_t)NP * 1024 * 2;
constexpr size_t OFF_WUP = OFF_WOUT + (size_t)1024 * 1024 * 2;
constexpr size_t OFF_WDN = OFF_WUP + (size_t)4096 * 1024 * 2;
constexpr size_t OFF_WUQ = OFF_WDN + (size_t)4096 * 1024 * 2;
constexpr size_t OFF_WKV = OFF_WUQ + (size_t)384 * 192 * 2;
constexpr size_t OFF_XB = OFF_WKV + (size_t)512 * 128 * 2;
constexpr size_t OFF_MIX = OFF_XB + (size_t)S * 1024 * 2;
constexpr size_t OFF_R1 = OFF_MIX + (size_t)S * 1024 * 2;
constexpr size_t OFF_P = OFF_R1;
constexpr size_t OFF_VT = OFF_P + (size_t)S * NP * 2;
constexpr size_t OFF_QA = OFF_VT + (size_t)640 * S * 2;
constexpr size_t OFF_KN = OFF_QA + (size_t)S * 384 * 2;
constexpr size_t OFF_VTA = OFF_KN + (size_t)S * 256 * 2;
constexpr size_t OFF_H = OFF_R1;
constexpr size_t OFF_TAB = OFF_R1 + (size_t)S * 4096 * 2;
constexpr size_t OFF_SSX = OFF_TAB + (size_t)S * 96 * 4;
constexpr size_t OFF_SSA = OFF_SSX + (size_t)S * 16 * 4;
constexpr size_t OFF_SSM = OFF_SSA + (size_t)S * 8 * 4;
constexpr size_t OFF_CTRL = OFF_SSM + (size_t)12 * S * 4;
static_assert(OFF_VTA + (size_t)256 * S * 2 <= OFF_TAB, "overlay");

struct Params {
  const float *x, *norm1_g, *w_in, *qn_g, *w_uq, *kvn_g, *w_uk, *w_uv, *lq1, *lk1, *lq2, *lk2, *subln_g, *sinks, *rpb,
      *g_mla, *g_swa, *g_na, *w_out, *norm2_g, *w_up, *w_down, *fin_g;
  float* out; char* ws; float lam_init[4];
};

__device__ __forceinline__ unsigned pk2(float a, float b) { bf2_t r = __builtin_convertvector((f32x2){a, b}, bf2_t); return __builtin_bit_cast(unsigned, r); }
__device__ __forceinline__ bf16_t f2bf(float a) { return (bf16_t)(pk2(a, 0.f) & 0xffffu); }
__device__ __forceinline__ float bf2f(unsigned v) { return __uint_as_float(v << 16); }
__device__ __forceinline__ int crow(int r, int h) { return (r & 3) + 8 * (r >> 2) + 4 * h; }
__device__ __forceinline__ int permtok(int t) { return (t & ~12) | ((t & 4) << 1) | ((t & 8) >> 1); }
__device__ __forceinline__ int remap8(int t, int T) { return (t & 7) * (T >> 3) + (t >> 3); }
#define MFMA(a, b, c) __builtin_amdgcn_mfma_f32_32x32x16_bf16((a), (b), (c), 0, 0, 0)

struct GemmArgs { const bf16_t* A; int lda; const bf16_t* Bt; int ldb; int K; const float* asc; };

template <bool ASC, class Epi>
__device__ __forceinline__ void gemm_tile(char* lds, const GemmArgs& g, int m0, int n0, const Epi& epi) {
  int tid_ = threadIdx.x; asm volatile("" : "+v"(tid_));
  const int tid = tid_, lane = tid & 63, wid = tid >> 6, wr = wid >> 1, wc = wid & 1, c = lane & 31, h = lane >> 5;
  f32x16 acc[2][2];
#pragma unroll
  for (int i = 0; i < 2; ++i)
#pragma unroll
    for (int j = 0; j < 2; ++j)
#pragma unroll
      for (int r = 0; r < 16; ++r) acc[i][j][r] = 0.f;
  const int prow = tid >> 3, pch = tid & 7;
  const bf16_t* Ap = g.A + (size_t)(m0 + prow) * g.lda + pch * 8;
  const bf16_t* Bp = g.Bt + (size_t)(n0 + prow) * g.ldb + pch * 8;
  const size_t astep = (size_t)32 * g.lda, bstep = (size_t)32 * g.ldb;
  u32x4 ra[4], rb[4];
  float sc[4] = {1.f, 1.f, 1.f, 1.f};
  const int nk = g.K >> 6;
  auto gload = [&](int kt) {
#pragma unroll
    for (int i = 0; i < 4; ++i) { ra[i] = *(const u32x4*)(Ap + i * astep + kt * 64); rb[i] = *(const u32x4*)(Bp + i * bstep + kt * 64); }
    if (ASC) {
      if ((kt & 3) == 0) {
        const int seg = kt >> 2;
#pragma unroll
        for (int i = 0; i < 4; ++i) {
          if (seg == 1) sc[i] = 1.f;
          else {
            const int idx = seg == 0 ? 0 : (seg == 2 ? 1 : 2);
            const float* sp = g.asc + (size_t)idx * 4 * S + (m0 + prow + 32 * i);
            const float t = sp[0] + sp[S] + sp[2 * S] + sp[3 * S];
            sc[i] = rsqrtf(t * (1.f / 256.f) + EPS);
          }
        }
      }
    }
  };
  auto lstore = [&](int buf) {
    char* a = lds + buf * 36864 + prow * 144 + pch * 16;
#pragma unroll
    for (int i = 0; i < 4; ++i) {
      u32x4 v = ra[i];
      if (ASC) {
#pragma unroll
        for (int j = 0; j < 4; ++j) { const unsigned u = v[j]; v[j] = pk2(bf2f(u & 0xffffu) * sc[i], __uint_as_float(u & 0xffff0000u) * sc[i]); }
      }
      *(u32x4*)(a + i * 32 * 144) = v;
      *(u32x4*)(a + 18432 + i * 32 * 144) = rb[i];
    }
  };
  gload(0); lstore(0); __syncthreads();
  for (int kt = 0; kt < nk; ++kt) {
    if (kt + 1 < nk) gload(kt + 1);
    const char* As = lds + (kt & 1) * 36864; const char* Bs = As + 18432;
#pragma unroll
    for (int ks = 0; ks < 4; ++ks) {
      bf16x8 af[2], bfr[2];
#pragma unroll
      for (int mt = 0; mt < 2; ++mt) af[mt] = *(const bf16x8*)(As + (wr * 64 + mt * 32 + c) * 144 + ks * 32 + h * 16);
#pragma unroll
      for (int nt = 0; nt < 2; ++nt) bfr[nt] = *(const bf16x8*)(Bs + (wc * 64 + nt * 32 + c) * 144 + ks * 32 + h * 16);
#pragma unroll
      for (int mt = 0; mt < 2; ++mt)
#pragma unroll
        for (int nt = 0; nt < 2; ++nt) acc[mt][nt] = MFMA(bfr[nt], af[mt], acc[mt][nt]);
    }
    if (kt + 1 < nk) lstore((kt + 1) & 1);
    __syncthreads();
  }
  epi(acc, m0, n0, wr, wc, c, h);
}

__device__ __forceinline__ void store_plain(bf16_t* dst, const f32x16& v, int h) {
#pragma unroll
  for (int g = 0; g < 4; ++g) { u32x2 w; w.x = pk2(v[4 * g], v[4 * g + 1]); w.y = pk2(v[4 * g + 2], v[4 * g + 3]); *(u32x2*)(dst + 8 * g + 4 * h) = w; }
}
__device__ __forceinline__ void store_vt(bf16_t* vt, int featbase, int tok, const f32x16& v, int h) {
  const int pt = permtok(tok);
#pragma unroll
  for (int r = 0; r < 16; ++r) vt[(size_t)(featbase + crow(r, h)) * S + pt] = f2bf(v[r]);
}
__device__ __forceinline__ void rope32(f32x16& v, const float* c32, const float* s32, int tok, int h) {
  const f32x4 ca = *(const f32x4*)(c32 + tok * 16 + 4 * h), cb = *(const f32x4*)(c32 + tok * 16 + 8 + 4 * h);
  const f32x4 sa = *(const f32x4*)(s32 + tok * 16 + 4 * h), sb = *(const f32x4*)(s32 + tok * 16 + 8 + 4 * h);
#pragma unroll
  for (int i = 0; i < 4; ++i) {
    float x1 = v[i], x2 = v[i + 8]; v[i] = x1 * ca[i] - x2 * sa[i]; v[i + 8] = x2 * ca[i] + x1 * sa[i];
    x1 = v[4 + i]; x2 = v[12 + i]; v[4 + i] = x1 * cb[i] - x2 * sb[i]; v[12 + i] = x2 * cb[i] + x1 * sb[i];
  }
}
__device__ __forceinline__ void rope64(f32x16& v0, f32x16& v1, const float* c64, const float* s64, int tok, int h) {
#pragma unroll
  for (int g = 0; g < 4; ++g) {
    const f32x4 cg4 = *(const f32x4*)(c64 + tok * 32 + 8 * g + 4 * h), sg4 = *(const f32x4*)(s64 + tok * 32 + 8 * g + 4 * h);
#pragma unroll
    for (int i = 0; i < 4; ++i) { const float x1 = v0[4 * g + i], x2 = v1[4 * g + i]; v0[4 * g + i] = x1 * cg4[i] - x2 * sg4[i]; v1[4 * g + i] = x2 * cg4[i] + x1 * sg4[i]; }
  }
}
__device__ __forceinline__ float sumsq16(const f32x16& v) { float s = 0.f;
#pragma unroll
  for (int r = 0; r < 16; ++r) s += v[r] * v[r];
  return s; }
__device__ __forceinline__ void kmax_update(unsigned* slot, float s) {
  s += __shfl_xor(s, 32);
#pragma unroll
  for (int o = 16; o; o >>= 1) s = fmaxf(s, __shfl_xor(s, o));
  if ((threadIdx.x & 63) == 0) atomicMax(slot, __float_as_uint(s));
}
__device__ __forceinline__ float rowscale_ssx(const float* ssx, int tok) {
  const f32x4* sp = (const f32x4*)(ssx + (size_t)tok * 16); const f32x4 a = sp[0], b = sp[1], c = sp[2], d = sp[3];
  const float t = ((a[0] + a[1]) + (a[2] + a[3])) + ((b[0] + b[1]) + (b[2] + b[3])) + ((c[0] + c[1]) + (c[2] + c[3])) + ((d[0] + d[1]) + (d[2] + d[3]));
  return rsqrtf(t * (1.f / 1024.f) + EPS);
}

struct EpiIn {
  bf16_t* P; bf16_t* Vt; const float* ssx; float* ssa; const float *c32, *s32, *c64, *s64; unsigned* kmax;
  __device__ __forceinline__ void operator()(f32x16 (&acc)[2][2], int m0, int n0, int wr, int wc, int c, int h) const {
    const int g64 = (n0 >> 6) + wc;
    int vtb = -1, kslot = -1, ssl = -1; bool r32 = false, r64 = false;
    if (g64 <= 5) { if (g64 == 3) { r32 = true; kslot = 4; } else ssl = g64; }
    else if (g64 <= 13) { r32 = true; if (g64 >= 10) kslot = 5 + (g64 - 10); }
    else if (g64 <= 17) vtb = (g64 - 14) * 64;
    else if (g64 <= 23) { r64 = true; if (g64 >= 22) kslot = 9 + (g64 - 22); }
    else if (g64 <= 25) vtb = 256 + (g64 - 24) * 64;
    else if (g64 <= 33) { if (g64 >= 30) kslot = 11 + (g64 - 30); }
    else vtb = 384 + (g64 - 34) * 64;
#pragma unroll
    for (int mt = 0; mt < 2; ++mt) {
      const int tok = m0 + wr * 64 + mt * 32 + c;
      const float rr = rowscale_ssx(ssx, tok);
      f32x16 v0 = acc[mt][0] * rr, v1 = acc[mt][1] * rr;
      if (vtb >= 0) { store_vt(Vt, vtb, tok, v0, h); store_vt(Vt, vtb + 32, tok, v1, h); continue; }
      if (r32) { rope32(v0, c32, s32, tok, h); if (g64 != 3) rope32(v1, c32, s32, tok, h); }
      if (r64) rope64(v0, v1, c64, s64, tok, h);
      bf16_t* dst = P + (size_t)tok * NP + g64 * 64;
      store_plain(dst, v0, h); store_plain(dst + 32, v1, h);
      if (kslot >= 0) kmax_update(kmax + kslot, sumsq16(v0) + (g64 == 3 ? 0.f : sumsq16(v1)));
      if (ssl >= 0) { float s = sumsq16(v0) + sumsq16(v1); s += __shfl_xor(s, 32); if (h == 0) ssa[(size_t)tok * 8 + ssl] = s; }
    }
  }
};
struct EpiUq {
  bf16_t* Qa; const float* ssa; const float *c32, *s32;
  __device__ __forceinline__ void operator()(f32x16 (&acc)[2][2], int m0, int n0, int wr, int wc, int c, int h) const {
    const int g32 = ((n0 >> 6) + wc) * 2;
#pragma unroll
    for (int mt = 0; mt < 2; ++mt) {
      const int tok = m0 + wr * 64 + mt * 32 + c;
      const float* sp = ssa + (size_t)tok * 8; const float rr = rsqrtf((sp[0] + sp[1] + sp[2]) * (1.f / 192.f) + EPS);
#pragma unroll
      for (int nt = 0; nt < 2; ++nt) {
        f32x16 v = acc[mt][nt] * rr;
        if ((g32 + nt) % 3 == 2) rope32(v, c32, s32, tok, h);
        store_plain(Qa + (size_t)tok * 384 + (g32 + nt) * 32, v, h);
      }
    }
  }
};
struct EpiKv {
  bf16_t* KN; bf16_t* VtA; const float* ssa; unsigned* kmax;
  __device__ __forceinline__ void operator()(f32x16 (&acc)[2][2], int m0, int n0, int wr, int wc, int c, int h) const {
    const int g64 = (n0 >> 6) + wc;
#pragma unroll
    for (int mt = 0; mt < 2; ++mt) {
      const int tok = m0 + wr * 64 + mt * 32 + c;
      const float* sp = ssa + (size_t)tok * 8; const float rr = rsqrtf((sp[4] + sp[5]) * (1.f / 128.f) + EPS);
      const f32x16 v0 = acc[mt][0] * rr, v1 = acc[mt][1] * rr;
      if (g64 < 4) {
        bf16_t* dst = KN + (size_t)tok * 256 + g64 * 64; store_plain(dst, v0, h); store_plain(dst + 32, v1, h);
        kmax_update(kmax + g64, sumsq16(v0) + sumsq16(v1));
      } else { store_vt(VtA, (g64 - 4) * 64, tok, v0, h); store_vt(VtA, (g64 - 4) * 64 + 32, tok, v1, h); }
    }
  }
};
struct EpiRes {
  const float* xold; float* xnew; bf16_t* xb; float* ssx;
  __device__ __forceinline__ void operator()(f32x16 (&acc)[2][2], int m0, int n0, int wr, int wc, int c, int h) const {
#pragma unroll
    for (int mt = 0; mt < 2; ++mt) {
      const int tok = m0 + wr * 64 + mt * 32 + c; float s = 0.f;
#pragma unroll
      for (int nt = 0; nt < 2; ++nt)
#pragma unroll
        for (int g = 0; g < 4; ++g) {
          const size_t off = (size_t)tok * 1024 + n0 + wc * 64 + nt * 32 + 8 * g + 4 * h;
          f32x4 xo = *(const f32x4*)(xold + off);
#pragma unroll
          for (int i = 0; i < 4; ++i) { xo[i] += acc[mt][nt][4 * g + i]; s += xo[i] * xo[i]; }
          *(f32x4*)(xnew + off) = xo;
          u32x2 w; w.x = pk2(xo[0], xo[1]); w.y = pk2(xo[2], xo[3]); *(u32x2*)(xb + off) = w;
        }
      s += __shfl_xor(s, 32);
      if (h == 0) ssx[(size_t)tok * 16 + (n0 >> 7) * 2 + wc] = s;
    }
  }
};
struct EpiUp {
  bf16_t* H; const float* ssx;
  __device__ __forceinline__ void operator()(f32x16 (&acc)[2][2], int m0, int n0, int wr, int wc, int c, int h) const {
#pragma unroll
    for (int mt = 0; mt < 2; ++mt) {
      const int tok = m0 + wr * 64 + mt * 32 + c; const float rr = rowscale_ssx(ssx, tok);
#pragma unroll
      for (int nt = 0; nt < 2; ++nt) {
        f32x16 v;
#pragma unroll
        for (int r = 0; r < 16; ++r) { const float t = fmaxf(acc[mt][nt][r] * rr, 0.f); v[r] = t * t; }
        store_plain(H + (size_t)tok * 4096 + n0 + wc * 64 + nt * 32, v, h);
      }
    }
  }
};

struct AttnArgs { const bf16_t *P, *Vt, *Qa, *KN, *VtA; bf16_t* mix; float* ssm; const unsigned* kmax;
  const float *lq1, *lk1, *lq2, *lk2, *subln, *sinks, *rpb; float lam_init; };

constexpr int ABUF = 22528, AKOFF = 13312, ATAB = 2 * ABUF;

template <int MODE>
__device__ __forceinline__ void attn_item(char* lds, const AttnArgs& a, int item) {
  constexpr int KSTR = MODE == 0 ? 208 : 144;
  constexpr int NKS = MODE == 0 ? 6 : (MODE == 1 ? 2 : 4);
  constexpr int NKP = MODE == 0 ? 3 : 2;
  constexpr int NQT = MODE <= 1 ? 2 : 1;
  int tid_ = threadIdx.x; asm volatile("" : "+v"(tid_));
  const int tid = tid_, lane = tid & 63, wid = tid >> 6, c = lane & 31, h = lane >> 5;
  int hd, sb, se; int qtok[NQT]; const bf16_t* qptr[NQT]; const bf16_t* kbase; const bf16_t* vbase; int k2slot;
  int narow = 0, nars = 0, nahalf = 0, kvh = 0;
  if constexpr (MODE == 0) { hd = item & 3; const int qb = item >> 2; sb = 0; se = 256;
#pragma unroll
    for (int qt = 0; qt < 2; ++qt) { qtok[qt] = qb * 256 + wid * 64 + qt * 32 + c; qptr[qt] = a.Qa + (size_t)qtok[qt] * 384 + hd * 96; }
    kbase = a.KN + hd * 64; vbase = a.VtA + (size_t)hd * 64 * S; k2slot = hd; }
  else if constexpr (MODE == 1) { hd = item & 3; const int qb = item >> 2; sb = 0; se = 256;
#pragma unroll
    for (int qt = 0; qt < 2; ++qt) { qtok[qt] = qb * 128 + wid * 32 + c; qptr[qt] = a.P + (size_t)qtok[qt] * NP + 384 + hd * 64 + qt * 32; }
    kbase = a.P + 640 + hd * 64; vbase = a.Vt + (size_t)hd * 64 * S; k2slot = 5 + hd; }
  else if constexpr (MODE == 2) { hd = item & 3; kvh = hd >> 1; const int qb = item >> 2; sb = max(0, 2 * qb - 2); se = min(256, 2 * qb + 4);
    qtok[0] = qb * 128 + wid * 32 + c; qptr[0] = a.P + (size_t)qtok[0] * NP + 1152 + hd * 64;
    kbase = a.P + 1408 + kvh * 64; vbase = a.Vt + (size_t)(256 + kvh * 64) * S; k2slot = 9 + kvh; }
  else { hd = item & 3; const int rg = item >> 2; narow = rg * 2 + (wid >> 1); nahalf = wid & 1; nars = min(max(narow - 4, 0), 248);
    sb = min(max(rg * 2 - 4, 0), 248); se = min(max(rg * 2 - 3, 0), 248) + 8;
    qtok[0] = narow * 64 + nahalf * 32 + c; qptr[0] = a.P + (size_t)qtok[0] * NP + 1664 + hd * 64;
    kbase = a.P + 1920 + hd * 64; vbase = a.Vt + (size_t)(384 + hd * 64) * S; k2slot = 11 + hd; }

  bf16x8 qf[NQT][NKS]; float q2max = 0.f;
#pragma unroll
  for (int qt = 0; qt < NQT; ++qt) { float s = 0.f;
#pragma unroll
    for (int ks = 0; ks < NKS; ++ks) { qf[qt][ks] = *(const bf16x8*)(qptr[qt] + ks * 16 + h * 8);
#pragma unroll
      for (int j = 0; j < 8; ++j) { const float f = bf2f((unsigned short)qf[qt][ks][j]); s += f * f; } }
    s += __shfl_xor(s, 32); q2max = fmaxf(q2max, s); }
#pragma unroll
  for (int o = 16; o; o >>= 1) q2max = fmaxf(q2max, __shfl_xor(q2max, o));
  float k2 = __uint_as_float(a.kmax[k2slot]); if (MODE == 0) k2 += __uint_as_float(a.kmax[4]);
  float cb = sqrtf(q2max * k2) * 1.01f + 0.01f;
  if (MODE == 3) {
    float* tab = (float*)(lds + ATAB); const float* rp = a.rpb + hd * 465; float bm = 0.f;
    for (int i = lane; i < 465; i += 64) bm = fmaxf(bm, fabsf(rp[i]));
#pragma unroll
    for (int o = 32; o; o >>= 1) bm = fmaxf(bm, __shfl_xor(bm, o));
    cb += bm * LOG2E;
    for (int i = tid; i < 480; i += 256) { const int dr = i >> 5, dc = i & 31; tab[i] = dc < 31 ? rp[dr * 31 + dc] * LOG2E : 0.f; }
  }
  f32x16 negc;
#pragma unroll
  for (int r = 0; r < 16; ++r) negc[r] = -cb;

  f32x16 O[NQT][2]; float l[NQT];
#pragma unroll
  for (int i = 0; i < NQT; ++i) l[i] = 0.f;
#pragma unroll
  for (int i = 0; i < NQT; ++i)
#pragma unroll
    for (int j = 0; j < 2; ++j)
#pragma unroll
      for (int r = 0; r < 16; ++r) O[i][j][r] = 0.f;

  u32x4 rk[NKP], rv[2];
  auto gload = [&](int st) {
    const int kb = st * 64;
#pragma unroll
    for (int i = 0; i < NKP; ++i) { const int p = tid + 256 * i;
      if (MODE == 0) { const int row = p / 12, ch = p - row * 12;
        const bf16_t* src = ch < 8 ? kbase + (size_t)(kb + row) * 256 + ch * 8 : a.P + (size_t)(kb + row) * NP + 192 + (ch - 8) * 8;
        rk[i] = *(const u32x4*)src; }
      else { const int row = p >> 3, ch = p & 7; rk[i] = *(const u32x4*)(kbase + (size_t)(kb + row) * NP + ch * 8); } }
#pragma unroll
    for (int i = 0; i < 2; ++i) { const int p = tid + 256 * i, dv = p >> 3, ch = p & 7; rv[i] = *(const u32x4*)(vbase + (size_t)dv * S + kb + ch * 8); }
  };
  auto lstore = [&](int buf) {
    char* b = lds + buf * ABUF;
#pragma unroll
    for (int i = 0; i < NKP; ++i) { const int p = tid + 256 * i;
      if (MODE == 0) { const int row = p / 12, ch = p - row * 12; *(u32x4*)(b + row * 208 + ch * 16) = rk[i]; }
      else { const int row = p >> 3, ch = p & 7; *(u32x4*)(b + row * 144 + ch * 16) = rk[i]; } }
#pragma unroll
    for (int i = 0; i < 2; ++i) { const int p = tid + 256 * i, dv = p >> 3, ch = p & 7; *(u32x4*)(b + AKOFF + dv * 144 + ch * 16) = rv[i]; }
  };

  gload(sb); lstore(0); __syncthreads();
  for (int st = sb; st < se; ++st) {
    const int buf = (st - sb) & 1;
    if (st + 1 < se) gload(st + 1);
    const bool active = MODE != 3 || (st >= nars && st < nars + 8);
    if (active) {
      const char* Kb = lds + buf * ABUF; const char* Vb = Kb + AKOFF;
#pragma unroll
      for (int kt2 = 0; kt2 < 2; ++kt2) {
        f32x16 sc[NQT];
#pragma unroll
        for (int qt = 0; qt < NQT; ++qt) sc[qt] = negc;
        if (MODE != 1) {
#pragma unroll
          for (int ks = 0; ks < NKS; ++ks) { const bf16x8 kf = *(const bf16x8*)(Kb + (kt2 * 32 + c) * KSTR + ks * 32 + h * 16);
#pragma unroll
            for (int qt = 0; qt < NQT; ++qt) sc[qt] = MFMA(kf, qf[qt][ks], sc[qt]); }
        } else {
#pragma unroll
          for (int qt = 0; qt < NQT; ++qt)
#pragma unroll
            for (int ks = 0; ks < NKS; ++ks) { const bf16x8 kf = *(const bf16x8*)(Kb + (kt2 * 32 + c) * KSTR + qt * 64 + ks * 32 + h * 16);
              sc[qt] = MFMA(kf, qf[qt][ks], sc[qt]); }
        }
        if (MODE == 2) {
          const int kb0 = st * 64 + kt2 * 32 - qtok[0];
#pragma unroll
          for (int i = 0; i < 16; ++i) { const int d = kb0 + crow(i, h); const bool ok = d <= 128 && d >= -128;
            sc[0][i] = ok ? sc[0][i] : -INFINITY; }
        }
        if (MODE == 3) {
          const float* trow = (const float*)(lds + ATAB) + (st - narow + 7) * 32;
#pragma unroll
          for (int qt = 0; qt < NQT; ++qt) { const int w = nahalf * 32 + c, cs = min(max(w - 8, 0), 48);
#pragma unroll
            for (int i = 0; i < 16; ++i) { const int kc = kt2 * 32 + crow(i, h); const bool ok = kc >= cs && kc < cs + 16;
              const float bv = trow[(kc - w + 15) & 31]; sc[qt][i] = ok ? sc[qt][i] + bv : -INFINITY; } }
        }
        bf16x8 pf[NQT][2];
#pragma unroll
        for (int qt = 0; qt < NQT; ++qt) {
          float p[16];
#pragma unroll
          for (int i = 0; i < 16; ++i) { p[i] = __builtin_amdgcn_exp2f(sc[qt][i]); l[qt] += p[i]; }
#pragma unroll
          for (int s2 = 0; s2 < 2; ++s2) { u32x4 w; w.x = pk2(p[8 * s2], p[8 * s2 + 1]); w.y = pk2(p[8 * s2 + 2], p[8 * s2 + 3]);
            w.z = pk2(p[8 * s2 + 4], p[8 * s2 + 5]); w.w = pk2(p[8 * s2 + 6], p[8 * s2 + 7]); pf[qt][s2] = __builtin_bit_cast(bf16x8, w); }
        }
#pragma unroll
        for (int dt = 0; dt < 2; ++dt)
#pragma unroll
          for (int s2 = 0; s2 < 2; ++s2) { const bf16x8 vf = *(const bf16x8*)(Vb + (dt * 32 + c) * 144 + kt2 * 64 + s2 * 32 + h * 16);
#pragma unroll
            for (int qt = 0; qt < NQT; ++qt) O[qt][dt] = MFMA(vf, pf[qt][s2], O[qt][dt]); }
      }
    }
    if (st + 1 < se) lstore(buf ^ 1);
    __syncthreads();
  }

#pragma unroll
  for (int qt = 0; qt < NQT; ++qt) l[qt] += __shfl_xor(l[qt], 32);
  if (MODE == 1) {
    float pa = 0.f, pb = 0.f;
    if (lane < 32) { pa = a.lq1[lane] * a.lk1[lane]; pb = a.lq2[lane] * a.lk2[lane]; }
#pragma unroll
    for (int o = 32; o; o >>= 1) { pa += __shfl_xor(pa, o); pb += __shfl_xor(pb, o); }
    const float lam = expf(pa) - expf(pb) + a.lam_init;
    const float i0 = 1.f / l[0], i1 = lam / l[NQT - 1];
    f32x16 o[2]; float ss = 0.f;
#pragma unroll
    for (int dt = 0; dt < 2; ++dt)
#pragma unroll
      for (int r = 0; r < 16; ++r) { o[dt][r] = O[0][dt][r] * i0 - O[NQT - 1][dt][r] * i1; ss += o[dt][r] * o[dt][r]; }
    ss += __shfl_xor(ss, 32);
    const float rn = rsqrtf(ss * (1.f / 64.f) + EPS) * (1.f - a.lam_init);
#pragma unroll
    for (int dt = 0; dt < 2; ++dt) {
#pragma unroll
      for (int g = 0; g < 4; ++g) { const f32x4 gg = *(const f32x4*)(a.subln + dt * 32 + 8 * g + 4 * h);
#pragma unroll
        for (int i = 0; i < 4; ++i) o[dt][4 * g + i] *= rn * gg[i]; }
      store_plain(a.mix + (size_t)qtok[0] * 1024 + 256 + hd * 64 + dt * 32, o[dt], h);
    }
  } else {
#pragma unroll
    for (int qt = 0; qt < NQT; ++qt) {
      int head, colb, seg;
      if (MODE == 0) { head = hd; colb = hd * 64; seg = 0; }
      else if (MODE == 2) { head = hd; colb = 512 + head * 64; seg = 1; l[qt] += __builtin_amdgcn_exp2f(a.sinks[head] * LOG2E - cb); }
      else { head = hd; colb = 768 + hd * 64; seg = 2; }
      const float inv = 1.f / l[qt]; float ss = 0.f;
#pragma unroll
      for (int dt = 0; dt < 2; ++dt) { f32x16 o = O[qt][dt] * inv; ss += sumsq16(o); store_plain(a.mix + (size_t)qtok[qt] * 1024 + colb + dt * 32, o, h); }
      ss += __shfl_xor(ss, 32);
      if (h == 0) a.ssm[(size_t)(seg * 4 + head) * S + qtok[qt]] = ss;
    }
  }
}

template <class F>
__device__ __forceinline__ void conv_tile(float* tl, bf16_t* out, int K, int n0, int k0, const F& f) {
  int tid_ = threadIdx.x; asm volatile("" : "+v"(tid_));
  const int tid = tid_, tx = tid & 63, ty = tid >> 6;
#pragma unroll 4
  for (int i = 0; i < 16; ++i) { const int k = ty + 4 * i; tl[k * 65 + tx] = f(k0 + k, n0 + tx); }
  __syncthreads();
  const int kx2 = (tid & 31) * 2, ny = tid >> 5;
#pragma unroll 4
  for (int i = 0; i < 8; ++i) { const int n = ny + 8 * i; *(unsigned*)(out + (size_t)(n0 + n) * K + k0 + kx2) = pk2(tl[kx2 * 65 + n], tl[(kx2 + 1) * 65 + n]); }
  __syncthreads();
}

__device__ void conv_layer(char* lds, const Params& p, int l) {
  float* tl = (float*)lds; char* ws = p.ws;
  const float* w_in = p.w_in + (size_t)l * 1024 * 2400; const float* g1 = p.norm1_g + l * 1024;
  const float* w_out = p.w_out + (size_t)l * 1024 * 1024; const float* gm = p.g_mla + l * 256; const float* gs = p.g_swa + l * 256; const float* gn = p.g_na + l * 256;
  const float* w_up = p.w_up + (size_t)l * 1024 * 4096; const float* g2 = p.norm2_g + l * 1024;
  const float* w_dn = p.w_down + (size_t)l * 4096 * 1024;
  const float* w_uq = p.w_uq + (size_t)l * 192 * 384; const float* qg = p.qn_g + l * 192;
  const float* w_uk = p.w_uk + (size_t)l * 128 * 256; const float* w_uv = p.w_uv + (size_t)l * 128 * 256; const float* kg = p.kvn_g + l * 128;
  const float sB = 0.17677669529663687f * LOG2E, sC = 0.125f * LOG2E, sA = 0.10206207261596577f * LOG2E;
  for (int t = blockIdx.x; t < 2946; t += gridDim.x) {
    if (t < 608) { const int nt = t >> 4, kt = t & 15;
      conv_tile(tl, (bf16_t*)(ws + OFF_WIN), 1024, nt * 64, kt * 64, [&](int k, int n) -> float {
        int src; if (n < 192) src = n; else if (n < 224) src = 320 + n - 192; else if (n < 256) src = -1; else if (n < 384) src = 192 + n - 256; else src = 352 + n - 384;
        if (src < 0) return 0.f;
        float sc = 1.f; if (n >= 384 && n < 640) sc = sB; else if ((n >= 1152 && n < 1408) || (n >= 1664 && n < 1920)) sc = sC;
        return w_in[(size_t)k * 2400 + src] * g1[k] * sc; });
    } else if (t < 864) { const int u = t - 608, nt = u >> 4, kt = u & 15;
      conv_tile(tl, (bf16_t*)(ws + OFF_WOUT), 1024, nt * 64, kt * 64, [&](int k, int n) -> float {
        const float g = k < 256 ? gm[k] : (k < 512 ? 1.f : (k < 768 ? gs[k - 512] : gn[k - 768]));
        return w_out[(size_t)k * 1024 + n] * g; });
    } else if (t < 1888) { const int u = t - 864, nt = u >> 4, kt = u & 15;
      conv_tile(tl, (bf16_t*)(ws + OFF_WUP), 1024, nt * 64, kt * 64, [&](int k, int n) -> float { return w_up[(size_t)k * 4096 + n] * g2[k]; });
    } else if (t < 2912) { const int u = t - 1888, nt = u >> 6, kt = u & 63;
      conv_tile(tl, (bf16_t*)(ws + OFF_WDN), 4096, nt * 64, kt * 64, [&](int k, int n) -> float { return w_dn[(size_t)k * 1024 + n]; });
    } else if (t < 2930) { const int u = t - 2912, nt = u / 3, kt = u % 3;
      conv_tile(tl, (bf16_t*)(ws + OFF_WUQ), 192, nt * 64, kt * 64, [&](int k, int n) -> float { return w_uq[(size_t)k * 384 + n] * qg[k] * sA; });
    } else { const int u = t - 2930, nt = u >> 1, kt = u & 1;
      conv_tile(tl, (bf16_t*)(ws + OFF_WKV), 128, nt * 64, kt * 64, [&](int k, int n) -> float {
        return (n < 256 ? w_uk[(size_t)k * 256 + n] : w_uv[(size_t)k * 256 + n - 256]) * kg[k]; });
    }
  }
}

__device__ __forceinline__ void sincos_acc(float ang, float& sn, float& cs) {
  const double a = (double)ang; const double n = rint(a * 0.15915494309189535);
  const double r = a - n * 6.283185307179586476925; const double r2 = r * r;
  double s = -1.0 / 51090942171709440000.0;
  s = s * r2 + 1.0 / 121645100408832000.0; s = s * r2 - 1.0 / 355687428096000.0; s = s * r2 + 1.0 / 1307674368000.0; s = s * r2 - 1.0 / 6227020800.0;
  s = s * r2 + 1.0 / 39916800.0; s = s * r2 - 1.0 / 362880.0; s = s * r2 + 1.0 / 5040.0; s = s * r2 - 1.0 / 120.0; s = s * r2 + 1.0 / 6.0; s = s * r2 - 1.0; s = -s * r;
  double c = 1.0 / 1124000727777607680000.0;
  c = c * r2 - 1.0 / 2432902008176640000.0; c = c * r2 + 1.0 / 6402373705728000.0; c = c * r2 - 1.0 / 20922789888000.0; c = c * r2 + 1.0 / 87178291200.0;
  c = c * r2 - 1.0 / 479001600.0; c = c * r2 + 1.0 / 3628800.0; c = c * r2 - 1.0 / 40320.0; c = c * r2 + 1.0 / 720.0; c = c * r2 - 1.0 / 24.0; c = c * r2 + 0.5; c = 1.0 - c * r2;
  sn = (float)s; cs = (float)c;
}

__global__ void __launch_bounds__(256, 2) mega(Params p) {
  cg::grid_group grid = cg::this_grid();
  __shared__ __attribute__((aligned(16))) char lds[73728];
  __shared__ int s_item;
  char* ws = p.ws;
  bf16_t* XB = (bf16_t*)(ws + OFF_XB); bf16_t* MIX = (bf16_t*)(ws + OFF_MIX); bf16_t* P = (bf16_t*)(ws + OFF_P); bf16_t* VT = (bf16_t*)(ws + OFF_VT);
  bf16_t* QA = (bf16_t*)(ws + OFF_QA); bf16_t* KN = (bf16_t*)(ws + OFF_KN); bf16_t* VTA = (bf16_t*)(ws + OFF_VTA); bf16_t* H = (bf16_t*)(ws + OFF_H);
  float* C32 = (float*)(ws + OFF_TAB); float* S32 = C32 + S * 16; float* C64 = S32 + S * 16; float* S64 = C64 + S * 32;
  float* SSX = (float*)(ws + OFF_SSX); float* SSA = (float*)(ws + OFF_SSA); float* SSM = (float*)(ws + OFF_SSM);
  unsigned* CTRL = (unsigned*)(ws + OFF_CTRL);

  { int tid_ = threadIdx.x; asm volatile("" : "+v"(tid_));
  const int tid = tid_, lane = tid & 63, wid = tid >> 6, gw = blockIdx.x * 4 + wid, nw = gridDim.x * 4;
  if (blockIdx.x == 0 && tid < 128) CTRL[tid] = 0u;
  for (int row = gw; row < S; row += nw) {
    const f32x4* xr = (const f32x4*)(p.x + (size_t)row * 1024); float s = 0.f;
#pragma unroll
    for (int i = 0; i < 4; ++i) { const f32x4 v = xr[lane + 64 * i]; s += v[0] * v[0] + v[1] * v[1] + v[2] * v[2] + v[3] * v[3];
      u32x2 w; w.x = pk2(v[0], v[1]); w.y = pk2(v[2], v[3]); *(u32x2*)(XB + (size_t)row * 1024 + (lane + 64 * i) * 4) = w; }
#pragma unroll
    for (int o = 32; o; o >>= 1) s += __shfl_xor(s, o);
    if (lane < 16) SSX[(size_t)row * 16 + lane] = lane == 0 ? s : 0.f;
  }
  for (int idx = blockIdx.x * 256 + tid; idx < S * 48; idx += gridDim.x * 256) {
    const int pos = idx / 48, i = idx - pos * 48; float sn, cs;
    if (i < 16) { const float inv = 1.0f / powf(10000.f, (float)(2 * i) / 32.f); sincos_acc((float)pos * inv, sn, cs); C32[pos * 16 + i] = cs; S32[pos * 16 + i] = sn; }
    else { const int j = i - 16; const float inv = 1.0f / powf(10000.f, (float)(2 * j) / 64.f); sincos_acc((float)pos * inv, sn, cs); C64[pos * 32 + j] = cs; S64[pos * 32 + j] = sn; }
  }
  }

#pragma unroll 1
  for (int l = 0; l < 4; ++l) {
    conv_layer(lds, p, l);
    grid.sync();
    unsigned* kmax = CTRL + 16 + 16 * l;
    { GemmArgs g{XB, 1024, (const bf16_t*)(ws + OFF_WIN), 1024, 1024, nullptr};
      EpiIn e{P, VT, SSX, SSA, C32, S32, C64, S64, kmax};
      for (int t = blockIdx.x; t < 128 * 19; t += gridDim.x) { const int u = remap8(t, 128 * 19); gemm_tile<false>(lds, g, (u / 19) * 128, (u % 19) * 128, e); } }
    grid.sync();
    { GemmArgs gq{P, NP, (const bf16_t*)(ws + OFF_WUQ), 192, 192, nullptr}; EpiUq eq{QA, SSA, C32, S32};
      GemmArgs gk{P + 256, NP, (const bf16_t*)(ws + OFF_WKV), 128, 128, nullptr}; EpiKv ek{KN, VTA, SSA, kmax};
      for (int t = blockIdx.x; t < 896; t += gridDim.x) { const int u = remap8(t, 896);
        if (u < 384) gemm_tile<false>(lds, gq, (u / 3) * 128, (u % 3) * 128, eq);
        else { const int v = u - 384; gemm_tile<false>(lds, gk, (v >> 2) * 128, (v & 3) * 128, ek); } } }
    grid.sync();
    { AttnArgs a{P, VT, QA, KN, VTA, MIX, SSM, kmax, p.lq1 + l * 32, p.lk1 + l * 32, p.lq2 + l * 32, p.lk2 + l * 32, p.subln_g + l * 64, p.sinks + l * 4,
                 p.rpb + l * 4 * 465, p.lam_init[l]};
      for (;;) {
        if (threadIdx.x == 0) s_item = (int)atomicAdd(CTRL + l, 1u);
        __syncthreads(); const int item = s_item; __syncthreads();
        if (item >= 1792) break;
        if (item < 256) attn_item<0>(lds, a, item);
        else if (item < 768) attn_item<1>(lds, a, item - 256);
        else if (item < 1280) attn_item<2>(lds, a, item - 768);
        else attn_item<3>(lds, a, item - 1280);
      } }
    grid.sync();
    { GemmArgs g{MIX, 1024, (const bf16_t*)(ws + OFF_WOUT), 1024, 1024, SSM};
      EpiRes e{l == 0 ? p.x : p.out, p.out, XB, SSX};
      for (int t = blockIdx.x; t < 1024; t += gridDim.x) { const int u = remap8(t, 1024); gemm_tile<true>(lds, g, (u >> 3) * 128, (u & 7) * 128, e); } }
    grid.sync();
    { GemmArgs g{XB, 1024, (const bf16_t*)(ws + OFF_WUP), 1024, 1024, nullptr}; EpiUp e{H, SSX};
      for (int t = blockIdx.x; t < 4096; t += gridDim.x) { const int u = remap8(t, 4096); gemm_tile<false>(lds, g, (u >> 5) * 128, (u & 31) * 128, e); } }
    grid.sync();
    { GemmArgs g{H, 4096, (const bf16_t*)(ws + OFF_WDN), 4096, 4096, nullptr}; EpiRes e{p.out, p.out, XB, SSX};
      for (int t = blockIdx.x; t < 1024; t += gridDim.x) { const int u = remap8(t, 1024); gemm_tile<false>(lds, g, (u >> 3) * 128, (u & 7) * 128, e); } }
    grid.sync();
  }
  int tid_ = threadIdx.x; asm volatile("" : "+v"(tid_));
  const int lane = tid_ & 63, gw = blockIdx.x * 4 + (tid_ >> 6), nw = gridDim.x * 4;
  for (int row = gw; row < S; row += nw) {
    const float rr = rowscale_ssx(SSX, row);
    f32x4* xr = (f32x4*)(p.out + (size_t)row * 1024);
#pragma unroll
    for (int i = 0; i < 4; ++i) { f32x4 v = xr[lane + 64 * i]; const f32x4 g = ((const f32x4*)p.fin_g)[lane + 64 * i]; v = v * rr * g; xr[lane + 64 * i] = v; }
  }
}

extern "C" void kernel_launch(void* const* d_in, const int* in_sizes, int n_in, void* d_out, int out_size,
                              void* d_ws, size_t ws_size, hipStream_t stream) {
  static int grid_blocks = 0;
  if (!grid_blocks) {
    int dev = 0, cus = 0, per_cu = 0;
    (void)hipGetDevice(&dev);
    (void)hipDeviceGetAttribute(&cus, hipDeviceAttributeMultiprocessorCount, dev);
    (void)hipOccupancyMaxActiveBlocksPerMultiprocessor(&per_cu, mega, 256, 0);
    if (per_cu > 2) per_cu = 2;
    if (per_cu < 1) per_cu = 1;
    grid_blocks = cus * per_cu;
  }
  Params p{};
  const float** pp = (const float**)&p;
  for (int i = 0; i < 23; ++i) pp[i] = (const float*)d_in[i];
  p.out = (float*)d_out; p.ws = (char*)d_ws;
  for (int l = 0; l < 4; ++l) p.lam_init[l] = (float)(0.8 - 0.6 * exp(-0.3 * (double)l));
  void* args[] = {&p};
  hipError_t e = hipLaunchCooperativeKernel((void*)mega, dim3(grid_blocks), dim3(256), args, 0, stream);
  if (e != hipSuccess) fprintf(stderr, "cooperative launch failed: %s (grid %d)\n", hipGetErrorString(e), grid_blocks);
}
```

```cpp
#include <hip/hip_runtime.h>
#include <hip/hip_cooperative_groups.h>
#include <cstdio>
#include <cmath>
namespace cg = cooperative_groups;

typedef unsigned short bf16_t;
typedef short bf16x8 __attribute__((ext_vector_type(8)));
typedef float f32x16 __attribute__((ext_vector_type(16)));
typedef float f32x4 __attribute__((ext_vector_type(4)));
typedef float f32x2 __attribute__((ext_vector_type(2)));
typedef unsigned u32x2 __attribute__((ext_vector_type(2)));
typedef unsigned u32x4 __attribute__((ext_vector_type(4)));
typedef __bf16 bf2_t __attribute__((ext_vector_type(2)));

constexpr int S = 16384, NP = 2432, VLD = S + 128;
constexpr float EPS = 1e-6f, LOG2E = 1.4426950408889634f;

constexpr size_t OFF_WIN = 0;
constexpr size_t OFF_WOUT = OFF_WIN + (size_t)NP * 1024 * 2;
constexpr size_t OFF_WUP = OFF_WOUT + (size_t)1024 * 1024 * 2;
constexpr size_t OFF_WDN = OFF_WUP + (size_t)4096 * 1024 * 2;
constexpr size_t OFF_WUQ = OFF_WDN + (size_t)4096 * 1024 * 2;
constexpr size_t OFF_WKV = OFF_WUQ + (size_t)384 * 192 * 2;
constexpr size_t OFF_XB = OFF_WKV + (size_t)512 * 128 * 2;
constexpr size_t OFF_MIX = OFF_XB + (size_t)S * 1024 * 2;
constexpr size_t OFF_R1 = OFF_MIX + (size_t)S * 1024 * 2;
constexpr size_t OFF_P = OFF_R1;
constexpr size_t OFF_VT = OFF_P + (size_t)S * NP * 2;
constexpr size_t OFF_QA = OFF_VT + (size_t)640 * VLD * 2;
constexpr size_t OFF_KN = OFF_QA + (size_t)S * 384 * 2;
constexpr size_t OFF_VTA = OFF_KN + (size_t)S * 256 * 2;
constexpr size_t OFF_H = OFF_R1;
constexpr size_t OFF_TAB = OFF_R1 + (size_t)S * 4096 * 2;
constexpr size_t OFF_SSX = OFF_TAB + (size_t)S * 96 * 4;
constexpr size_t OFF_SSA = OFF_SSX + (size_t)S * 16 * 4;
constexpr size_t OFF_SSM = OFF_SSA + (size_t)S * 8 * 4;
constexpr size_t OFF_CTRL = OFF_SSM + (size_t)12 * S * 4;
static_assert(OFF_VTA + (size_t)256 * VLD * 2 <= OFF_TAB, "overlay");

struct Params {
  const float *x, *norm1_g, *w_in, *qn_g, *w_uq, *kvn_g, *w_uk, *w_uv, *lq1, *lk1, *lq2, *lk2, *subln_g, *sinks, *rpb,
      *g_mla, *g_swa, *g_na, *w_out, *norm2_g, *w_up, *w_down, *fin_g;
  float* out; char* ws; float lam_init[4];
};

__device__ __forceinline__ unsigned pk2(float a, float b) { bf2_t r = __builtin_convertvector((f32x2){a, b}, bf2_t); return __builtin_bit_cast(unsigned, r); }
__device__ __forceinline__ bf16_t f2bf(float a) { return (bf16_t)(pk2(a, 0.f) & 0xffffu); }
__device__ __forceinline__ float bf2f(unsigned v) { return __uint_as_float(v << 16); }
__device__ __forceinline__ int crow(int r, int h) { return (r & 3) + 8 * (r >> 2) + 4 * h; }
__device__ __forceinline__ int permtok(int t) { return (t & ~12) | ((t & 4) << 1) | ((t & 8) >> 1); }
__device__ __forceinline__ int remap8(int t, int T) { return (t & 7) * (T >> 3) + (t >> 3); }
__device__ __forceinline__ int bid_() { int b = blockIdx.x; asm volatile("" : "+s"(b)); return b; }
#define MFMA(a, b, c) __builtin_amdgcn_mfma_f32_32x32x16_bf16((a), (b), (c), 0, 0, 0)

struct GemmArgs { const bf16_t* A; int lda; const bf16_t* Bt; int ldb; int K; const float* asc; };

#define LAS3 __attribute__((address_space(3)))
template <int V> struct IntC { static constexpr int value = V; };
__device__ __forceinline__ float seg_rscale(const float* asc, int seg, int tok) {
  if (seg == 1) return 1.f;
  const int idx = seg == 0 ? 0 : (seg == 2 ? 1 : 2);
  const float* sp = asc + (size_t)idx * 4 * S + tok;
  return rsqrtf((sp[0] + sp[S] + sp[2 * S] + sp[3 * S]) * (1.f / 256.f) + EPS);
}
template <bool ASC, class Epi>
__device__ __forceinline__ void gemm_tile(char* lds, const GemmArgs& g, int m0, int n0, const Epi& epi, bool staged = false, int nm0 = -1, int nn0 = 0) {
  int tid_ = threadIdx.x; asm volatile("" : "+v"(tid_));
  const int tid = tid_, lane = tid & 63, wid = __builtin_amdgcn_readfirstlane(tid >> 6), wr = wid >> 1, wc = wid & 1, c = lane & 31, h = lane >> 5;
  f32x16 acc[2][2];
#pragma unroll
  for (int i = 0; i < 2; ++i)
#pragma unroll
    for (int j = 0; j < 2; ++j)
#pragma unroll
      for (int r = 0; r < 16; ++r) acc[i][j][r] = 0.f;
  const int prow = tid >> 3, gch = (tid & 7) ^ ((prow >> 1) & 7);
  const bf16_t* Ap; Ap = g.A + (size_t)(m0 + prow) * g.lda + gch * 8;
  const bf16_t* Bp; Bp = g.Bt + (size_t)(n0 + prow) * g.ldb + gch * 8;
  (void)0;
  const size_t astep = (size_t)32 * g.lda, bstep = (size_t)32 * g.ldb;
  LAS3 char* l3 = (LAS3 char*)lds;
  const int nk = g.K >> 6;
  auto stage = [&](int kt, auto BUFC) {
    constexpr int buf = decltype(BUFC)::value;
#pragma unroll
    for (int i = 0; i < 4; ++i) {
      __builtin_amdgcn_global_load_lds((const unsigned*)(Ap + i * astep + kt * 64), (LAS3 unsigned*)(l3 + buf * 32768 + (256 * i + 64 * wid) * 16), 16, 0, 0);
      __builtin_amdgcn_global_load_lds((const unsigned*)(Bp + i * bstep + kt * 64), (LAS3 unsigned*)(l3 + buf * 32768 + 16384 + (256 * i + 64 * wid) * 16), 16, 0, 0);
    }
  };
  const int swz = (c >> 1) & 7;
  const unsigned lbase = (unsigned)(size_t)l3;
  const unsigned aoff = (wr * 64 + c) * 128, boff = 16384 + (wc * 64 + c) * 128;
  unsigned kofs[4];
#pragma unroll
  for (int ks = 0; ks < 4; ++ks) kofs[ks] = ((2 * ks + h) ^ swz) << 4;
  float rcur[2] = {1.f, 1.f};
  if (ASC) { rcur[0] = seg_rscale(g.asc, 0, m0 + wr * 64 + c); rcur[1] = seg_rscale(g.asc, 0, m0 + wr * 64 + 32 + c); }
  if (!staged) stage(0, IntC<0>{});
  asm volatile("s_waitcnt vmcnt(0)" ::: "memory"); __syncthreads();
  auto body = [&](int kt, auto BUFC) {
    constexpr int buf = decltype(BUFC)::value;
    if (kt + 1 < nk) stage(kt + 1, IntC<1 - buf>{});
    if (ASC) { if (kt > 0 && (kt & 3) == 0) {
#pragma unroll
      for (int mt = 0; mt < 2; ++mt) { const float rn = seg_rscale(g.asc, kt >> 2, m0 + wr * 64 + mt * 32 + c); const float f = rcur[mt] / rn; rcur[mt] = rn;
        acc[mt][0] = acc[mt][0] * f; acc[mt][1] = acc[mt][1] * f; } } }
    bf16x8 fr[2][4];
#define GRD(set, ks) { const unsigned aa_ = lbase + buf * 32768 + aoff + kofs[ks], bb_ = lbase + buf * 32768 + boff + kofs[ks]; \
      asm volatile("ds_read_b128 %0, %1" : "=v"(fr[set][0]) : "v"(aa_)); asm volatile("ds_read_b128 %0, %1 offset:4096" : "=v"(fr[set][1]) : "v"(aa_)); \
      asm volatile("ds_read_b128 %0, %1" : "=v"(fr[set][2]) : "v"(bb_)); asm volatile("ds_read_b128 %0, %1 offset:4096" : "=v"(fr[set][3]) : "v"(bb_)); }
    GRD(0, 0);
#pragma unroll
    for (int ks = 0; ks < 4; ++ks) {
      if (ks < 3) { GRD((ks + 1) & 1, ks + 1); asm volatile("s_waitcnt lgkmcnt(4)" : "+v"(fr[ks & 1][0]), "+v"(fr[ks & 1][1]), "+v"(fr[ks & 1][2]), "+v"(fr[ks & 1][3])); }
      else asm volatile("s_waitcnt lgkmcnt(0)" : "+v"(fr[ks & 1][0]), "+v"(fr[ks & 1][1]), "+v"(fr[ks & 1][2]), "+v"(fr[ks & 1][3]));
      __builtin_amdgcn_s_setprio(1);
#pragma unroll
      for (int mt = 0; mt < 2; ++mt)
#pragma unroll
        for (int nt = 0; nt < 2; ++nt) acc[mt][nt] = MFMA(fr[ks & 1][2 + nt], fr[ks & 1][mt], acc[mt][nt]);
      __builtin_amdgcn_s_setprio(0);
    }
#undef GRD
    asm volatile("s_waitcnt vmcnt(0)" ::: "memory"); __builtin_amdgcn_s_barrier(); asm volatile("" ::: "memory");
  };
  for (int kt = 0; kt < nk; kt += 2) { body(kt, IntC<0>{}); if (kt + 1 < nk) body(kt + 1, IntC<1>{}); }
  if (nm0 >= 0) {
    Ap = g.A + (size_t)(nm0 + prow) * g.lda + gch * 8; Bp = g.Bt + (size_t)(nn0 + prow) * g.ldb + gch * 8;
    stage(0, IntC<0>{});
  }
  if (ASC) {
#pragma unroll
    for (int mt = 0; mt < 2; ++mt) { acc[mt][0] = acc[mt][0] * rcur[mt]; acc[mt][1] = acc[mt][1] * rcur[mt]; } }
  epi(acc, m0, n0, wr, wc, c, h);
}

__device__ __forceinline__ void store_plain(bf16_t* dst, const f32x16& v, int h) {
#pragma unroll
  for (int g = 0; g < 4; ++g) { u32x2 w; w.x = pk2(v[4 * g], v[4 * g + 1]); w.y = pk2(v[4 * g + 2], v[4 * g + 3]); *(u32x2*)(dst + 8 * g + 4 * h) = w; }
}
__device__ __forceinline__ void store_vt(bf16_t* vt, int featbase, int tok, const f32x16& v, int h) {
  const int pt = permtok(tok);
#pragma unroll
  for (int r = 0; r < 16; ++r) vt[(size_t)(featbase + crow(r, h)) * VLD + pt] = f2bf(v[r]);
}
__device__ __forceinline__ void rope32(f32x16& v, const float* c32, const float* s32, int tok, int h) {
  const f32x4 ca = *(const f32x4*)(c32 + tok * 16 + 4 * h), cb = *(const f32x4*)(c32 + tok * 16 + 8 + 4 * h);
  const f32x4 sa = *(const f32x4*)(s32 + tok * 16 + 4 * h), sb = *(const f32x4*)(s32 + tok * 16 + 8 + 4 * h);
#pragma unroll
  for (int i = 0; i < 4; ++i) {
    float x1 = v[i], x2 = v[i + 8]; v[i] = x1 * ca[i] - x2 * sa[i]; v[i + 8] = x2 * ca[i] + x1 * sa[i];
    x1 = v[4 + i]; x2 = v[12 + i]; v[4 + i] = x1 * cb[i] - x2 * sb[i]; v[12 + i] = x2 * cb[i] + x1 * sb[i];
  }
}
__device__ __forceinline__ void rope64(f32x16& v0, f32x16& v1, const float* c64, const float* s64, int tok, int h) {
#pragma unroll
  for (int g = 0; g < 4; ++g) {
    const f32x4 cg4 = *(const f32x4*)(c64 + tok * 32 + 8 * g + 4 * h), sg4 = *(const f32x4*)(s64 + tok * 32 + 8 * g + 4 * h);
#pragma unroll
    for (int i = 0; i < 4; ++i) { const float x1 = v0[4 * g + i], x2 = v1[4 * g + i]; v0[4 * g + i] = x1 * cg4[i] - x2 * sg4[i]; v1[4 * g + i] = x2 * cg4[i] + x1 * sg4[i]; }
  }
}
__device__ __forceinline__ float sumsq16(const f32x16& v) { float s = 0.f;
#pragma unroll
  for (int r = 0; r < 16; ++r) s += v[r] * v[r];
  return s; }
__device__ __forceinline__ void kmax_update(unsigned* slot, float s) {
  s += __shfl_xor(s, 32);
#pragma unroll
  for (int o = 16; o; o >>= 1) s = fmaxf(s, __shfl_xor(s, o));
  if ((threadIdx.x & 63) == 0) atomicMax(slot, __float_as_uint(s));
}
__device__ __forceinline__ float rowscale_ssx(const float* ssx, int tok) {
  const f32x4* sp = (const f32x4*)(ssx + (size_t)tok * 16); const f32x4 a = sp[0], b = sp[1], c = sp[2], d = sp[3];
  const float t = ((a[0] + a[1]) + (a[2] + a[3])) + ((b[0] + b[1]) + (b[2] + b[3])) + ((c[0] + c[1]) + (c[2] + c[3])) + ((d[0] + d[1]) + (d[2] + d[3]));
  return rsqrtf(t * (1.f / 1024.f) + EPS);
}

struct EpiIn {
  bf16_t* P; bf16_t* Vt; const float* ssx; float* ssa; const float *c32, *s32, *c64, *s64; unsigned* kmax;
  __device__ __forceinline__ void operator()(f32x16 (&acc)[2][2], int m0, int n0, int wr, int wc, int c, int h) const {
    const int g64 = (n0 >> 6) + wc;
    int vtb = -1, kslot = -1, ssl = -1; bool r32 = false, r64 = false;
    if (g64 <= 5) { if (g64 == 3) { r32 = true; kslot = 4; } else ssl = g64; }
    else if (g64 <= 13) { r32 = true; if (g64 >= 10) kslot = 5 + (g64 - 10); }
    else if (g64 <= 17) vtb = (g64 - 14) * 64;
    else if (g64 <= 23) { r64 = true; if (g64 >= 22) kslot = 9 + (g64 - 22); }
    else if (g64 <= 25) vtb = 256 + (g64 - 24) * 64;
    else if (g64 <= 33) { if (g64 >= 30) kslot = 11 + (g64 - 30); }
    else vtb = 384 + (g64 - 34) * 64;
#pragma unroll
    for (int mt = 0; mt < 2; ++mt) {
      const int tok = m0 + wr * 64 + mt * 32 + c;
      const float rr = rowscale_ssx(ssx, tok);
      f32x16 v0 = acc[mt][0] * rr, v1 = acc[mt][1] * rr;
      if (vtb >= 0) { store_vt(Vt, vtb, tok, v0, h); store_vt(Vt, vtb + 32, tok, v1, h); continue; }
      if (r32) { rope32(v0, c32, s32, tok, h); if (g64 != 3) rope32(v1, c32, s32, tok, h); }
      if (r64) rope64(v0, v1, c64, s64, tok, h);
      bf16_t* dst = P + (size_t)tok * NP + g64 * 64;
      store_plain(dst, v0, h); store_plain(dst + 32, v1, h);
      if (kslot >= 0) kmax_update(kmax + kslot, sumsq16(v0) + (g64 == 3 ? 0.f : sumsq16(v1)));
      if (ssl >= 0) { float s = sumsq16(v0) + sumsq16(v1); s += __shfl_xor(s, 32); if (h == 0) ssa[(size_t)tok * 8 + ssl] = s; }
    }
  }
};
struct EpiUq {
  bf16_t* Qa; const float* ssa; const float *c32, *s32;
  __device__ __forceinline__ void operator()(f32x16 (&acc)[2][2], int m0, int n0, int wr, int wc, int c, int h) const {
    const int g32 = ((n0 >> 6) + wc) * 2;
#pragma unroll
    for (int mt = 0; mt < 2; ++mt) {
      const int tok = m0 + wr * 64 + mt * 32 + c;
      const float* sp = ssa + (size_t)tok * 8; const float rr = rsqrtf((sp[0] + sp[1] + sp[2]) * (1.f / 192.f) + EPS);
#pragma unroll
      for (int nt = 0; nt < 2; ++nt) {
        f32x16 v = acc[mt][nt] * rr;
        if ((g32 + nt) % 3 == 2) rope32(v, c32, s32, tok, h);
        store_plain(Qa + (size_t)tok * 384 + (g32 + nt) * 32, v, h);
      }
    }
  }
};
struct EpiKv {
  bf16_t* KN; bf16_t* VtA; const float* ssa; unsigned* kmax;
  __device__ __forceinline__ void operator()(f32x16 (&acc)[2][2], int m0, int n0, int wr, int wc, int c, int h) const {
    const int g64 = (n0 >> 6) + wc;
#pragma unroll
    for (int mt = 0; mt < 2; ++mt) {
      const int tok = m0 + wr * 64 + mt * 32 + c;
      const float* sp = ssa + (size_t)tok * 8; const float rr = rsqrtf((sp[4] + sp[5]) * (1.f / 128.f) + EPS);
      const f32x16 v0 = acc[mt][0] * rr, v1 = acc[mt][1] * rr;
      if (g64 < 4) {
        bf16_t* dst = KN + (size_t)tok * 256 + g64 * 64; store_plain(dst, v0, h); store_plain(dst + 32, v1, h);
        kmax_update(kmax + g64, sumsq16(v0) + sumsq16(v1));
      } else { store_vt(VtA, (g64 - 4) * 64, tok, v0, h); store_vt(VtA, (g64 - 4) * 64 + 32, tok, v1, h); }
    }
  }
};
struct EpiRes {
  const float* xold; float* xnew; bf16_t* xb; float* ssx;
  __device__ __forceinline__ void operator()(f32x16 (&acc)[2][2], int m0, int n0, int wr, int wc, int c, int h) const {
#pragma unroll
    for (int mt = 0; mt < 2; ++mt) {
      const int tok = m0 + wr * 64 + mt * 32 + c; float s = 0.f;
#pragma unroll
      for (int nt = 0; nt < 2; ++nt)
#pragma unroll
        for (int g = 0; g < 4; ++g) {
          const size_t off = (size_t)tok * 1024 + n0 + wc * 64 + nt * 32 + 8 * g + 4 * h;
          f32x4 xo = *(const f32x4*)(xold + off);
#pragma unroll
          for (int i = 0; i < 4; ++i) { xo[i] += acc[mt][nt][4 * g + i]; s += xo[i] * xo[i]; }
          *(f32x4*)(xnew + off) = xo;
          u32x2 w; w.x = pk2(xo[0], xo[1]); w.y = pk2(xo[2], xo[3]); *(u32x2*)(xb + off) = w;
        }
      s += __shfl_xor(s, 32);
      if (h == 0) ssx[(size_t)tok * 16 + (n0 >> 7) * 2 + wc] = s;
    }
  }
};
struct EpiUp {
  bf16_t* H; const float* ssx;
  __device__ __forceinline__ void operator()(f32x16 (&acc)[2][2], int m0, int n0, int wr, int wc, int c, int h) const {
#pragma unroll
    for (int mt = 0; mt < 2; ++mt) {
      const int tok = m0 + wr * 64 + mt * 32 + c; const float rr = rowscale_ssx(ssx, tok);
#pragma unroll
      for (int nt = 0; nt < 2; ++nt) {
        f32x16 v;
#pragma unroll
        for (int r = 0; r < 16; ++r) { const float t = fmaxf(acc[mt][nt][r] * rr, 0.f); v[r] = t * t; }
        store_plain(H + (size_t)tok * 4096 + n0 + wc * 64 + nt * 32, v, h);
      }
    }
  }
};

struct AttnArgs { const bf16_t *P, *Vt, *Qa, *KN, *VtA; bf16_t* mix; float* ssm; const unsigned* kmax;
  const float *lq1, *lk1, *lq2, *lk2, *subln, *sinks, *rpb; float lam_init; };

constexpr int ABUF = 22528, AKOFF = 13312, ATAB = 2 * ABUF;

template <int MODE>
__device__ __forceinline__ void attn_item(char* lds, const AttnArgs& a, int item) {
  constexpr int KSTR = MODE == 0 ? 208 : 144;
  constexpr int NKS = MODE == 0 ? 6 : (MODE == 1 ? 2 : 4);
  constexpr int NKP = MODE == 0 ? 3 : 2;
  constexpr int NQT = MODE == 1 ? 2 : 1;
  int tid_ = threadIdx.x; asm volatile("" : "+v"(tid_));
  const int tid = tid_, lane = tid & 63, wid = tid >> 6, c = lane & 31, h = lane >> 5;
  int hd, sb, se; int qtok[NQT]; const bf16_t* qptr[NQT]; const bf16_t* kbase; const bf16_t* vbase; int k2slot;
  int narow = 0, nars = 0, nahalf = 0, kvh = 0;
  if constexpr (MODE == 0) { hd = item & 3; const int qb = item >> 2; sb = 0; se = 256;
    qtok[0] = qb * 128 + wid * 32 + c; qptr[0] = a.Qa + (size_t)qtok[0] * 384 + hd * 96;
    kbase = a.KN + hd * 64; vbase = a.VtA + (size_t)hd * 64 * VLD; k2slot = hd; }
  else if constexpr (MODE == 1) { hd = item & 3; const int qb = item >> 2; sb = 0; se = 256;
#pragma unroll
    for (int qt = 0; qt < 2; ++qt) { qtok[qt] = qb * 128 + wid * 32 + c; qptr[qt] = a.P + (size_t)qtok[qt] * NP + 384 + hd * 64 + qt * 32; }
    kbase = a.P + 640 + hd * 64; vbase = a.Vt + (size_t)hd * 64 * VLD; k2slot = 5 + hd; }
  else if constexpr (MODE == 2) { hd = item & 3; kvh = hd >> 1; const int qb = item >> 2; sb = max(0, 2 * qb - 2); se = min(256, 2 * qb + 4);
    qtok[0] = qb * 128 + wid * 32 + c; qptr[0] = a.P + (size_t)qtok[0] * NP + 1152 + hd * 64;
    kbase = a.P + 1408 + kvh * 64; vbase = a.Vt + (size_t)(256 + kvh * 64) * VLD; k2slot = 9 + kvh; }
  else { hd = item & 3; const int rg = item >> 2; narow = rg * 2 + (wid >> 1); nahalf = wid & 1; nars = min(max(narow - 4, 0), 248);
    sb = min(max(rg * 2 - 4, 0), 248); se = min(max(rg * 2 - 3, 0), 248) + 8;
    qtok[0] = narow * 64 + nahalf * 32 + c; qptr[0] = a.P + (size_t)qtok[0] * NP + 1664 + hd * 64;
    kbase = a.P + 1920 + hd * 64; vbase = a.Vt + (size_t)(384 + hd * 64) * VLD; k2slot = 11 + hd; }

  bf16x8 qf[NQT][NKS]; float q2max = 0.f;
#pragma unroll
  for (int qt = 0; qt < NQT; ++qt) { float s = 0.f;
#pragma unroll
    for (int ks = 0; ks < NKS; ++ks) { qf[qt][ks] = *(const bf16x8*)(qptr[qt] + ks * 16 + h * 8);
#pragma unroll
      for (int j = 0; j < 8; ++j) { const float f = bf2f((unsigned short)qf[qt][ks][j]); s += f * f; } }
    s += __shfl_xor(s, 32); q2max = fmaxf(q2max, s); }
#pragma unroll
  for (int o = 16; o; o >>= 1) q2max = fmaxf(q2max, __shfl_xor(q2max, o));
  float k2 = __uint_as_float(a.kmax[k2slot]); if (MODE == 0) k2 += __uint_as_float(a.kmax[4]);
  float cb = sqrtf(q2max * k2) * 1.01f + 0.01f;
  if (MODE == 3) {
    float* tab = (float*)(lds + ATAB); const float* rp = a.rpb + hd * 465; float bm = 0.f;
    for (int i = lane; i < 465; i += 64) bm = fmaxf(bm, fabsf(rp[i]));
#pragma unroll
    for (int o = 32; o; o >>= 1) bm = fmaxf(bm, __shfl_xor(bm, o));
    cb += bm * LOG2E;
    for (int i = tid; i < 480; i += 256) { const int dr = i >> 5, dc = i & 31; tab[i] = dc < 31 ? rp[dr * 31 + dc] * LOG2E : 0.f; }
  }
  f32x16 negc;
#pragma unroll
  for (int r = 0; r < 16; ++r) negc[r] = -cb;

  f32x16 O[NQT][2]; float l[NQT];
#pragma unroll
  for (int i = 0; i < NQT; ++i) l[i] = 0.f;
#pragma unroll
  for (int i = 0; i < NQT; ++i)
#pragma unroll
    for (int j = 0; j < 2; ++j)
#pragma unroll
      for (int r = 0; r < 16; ++r) O[i][j][r] = 0.f;

  u32x4 rk[NKP], rv[2];
  auto gload = [&](int st) {
    const int kb = st * 64;
#pragma unroll
    for (int i = 0; i < NKP; ++i) { const int p = tid + 256 * i;
      if (MODE == 0) {
        if (i < 2) { const int row = p >> 3, ch = p & 7; rk[i] = *(const u32x4*)(kbase + (size_t)(kb + row) * 256 + ch * 8); }
        else { const int row = tid >> 2, ch = tid & 3; rk[i] = *(const u32x4*)(a.P + (size_t)(kb + row) * NP + 192 + ch * 8); } }
      else { const int row = p >> 3, ch = p & 7; rk[i] = *(const u32x4*)(kbase + (size_t)(kb + row) * NP + ch * 8); } }
#pragma unroll
    for (int i = 0; i < 2; ++i) { const int p = tid + 256 * i, dv = p >> 3, ch = p & 7; rv[i] = *(const u32x4*)(vbase + (size_t)dv * VLD + kb + ch * 8); }
  };
  auto lstore = [&](int buf) {
    char* b = lds + buf * ABUF;
#pragma unroll
    for (int i = 0; i < NKP; ++i) { const int p = tid + 256 * i;
      if (MODE == 0) { if (i < 2) { const int row = p >> 3, ch = p & 7; *(u32x4*)(b + row * 208 + ch * 16) = rk[i]; } else { const int row = tid >> 2, ch = tid & 3; *(u32x4*)(b + row * 208 + 128 + ch * 16) = rk[i]; } }
      else { const int row = p >> 3, ch = p & 7; *(u32x4*)(b + row * 144 + ch * 16) = rk[i]; } }
#pragma unroll
    for (int i = 0; i < 2; ++i) { const int p = tid + 256 * i, dv = p >> 3, ch = p & 7; *(u32x4*)(b + AKOFF + dv * 144 + ch * 16) = rv[i]; }
  };

  gload(sb); lstore(0); __syncthreads();
  for (int st = sb; st < se; ++st) {
    const int buf = (st - sb) & 1;
    if (st + 1 < se) gload(st + 1);
    __builtin_amdgcn_sched_barrier(0);
    const bool active = MODE != 3 || (st >= nars && st < nars + 8);
    if (active) {
      const char* Kb = lds + buf * ABUF; const char* Vb = Kb + AKOFF;
#pragma unroll
      for (int kt2 = 0; kt2 < 2; ++kt2) {
        f32x16 sc[NQT];
#pragma unroll
        for (int qt = 0; qt < NQT; ++qt) sc[qt] = negc;
        if (MODE != 1) {
#pragma unroll
          for (int ks = 0; ks < NKS; ++ks) { const bf16x8 kf = *(const bf16x8*)(Kb + (kt2 * 32 + c) * KSTR + ks * 32 + h * 16);
#pragma unroll
            for (int qt = 0; qt < NQT; ++qt) sc[qt] = MFMA(kf, qf[qt][ks], sc[qt]); }
        } else {
#pragma unroll
          for (int qt = 0; qt < NQT; ++qt)
#pragma unroll
            for (int ks = 0; ks < NKS; ++ks) { const bf16x8 kf = *(const bf16x8*)(Kb + (kt2 * 32 + c) * KSTR + qt * 64 + ks * 32 + h * 16);
              sc[qt] = MFMA(kf, qf[qt][ks], sc[qt]); }
        }
        if (MODE == 2) {
          const int kb0 = st * 64 + kt2 * 32 - qtok[0];
#pragma unroll
          for (int i = 0; i < 16; ++i) { const int d = kb0 + crow(i, h); const bool ok = d <= 128 && d >= -128;
            sc[0][i] = ok ? sc[0][i] : -INFINITY; }
        }
        if (MODE == 3) {
          const float* trow = (const float*)(lds + ATAB) + (st - narow + 7) * 32;
#pragma unroll
          for (int qt = 0; qt < NQT; ++qt) { const int w = nahalf * 32 + c, cs = min(max(w - 8, 0), 48);
#pragma unroll
            for (int i = 0; i < 16; ++i) { const int kc = kt2 * 32 + crow(i, h); const bool ok = kc >= cs && kc < cs + 16;
              const float bv = trow[(kc - w + 15) & 31]; sc[qt][i] = ok ? sc[qt][i] + bv : -INFINITY; } }
        }
        bf16x8 pf[NQT][2];
#pragma unroll
        for (int qt = 0; qt < NQT; ++qt) {
          float p[16];
#pragma unroll
          for (int i = 0; i < 16; ++i) { p[i] = __builtin_amdgcn_exp2f(sc[qt][i]); l[qt] += p[i]; }
#pragma unroll
          for (int s2 = 0; s2 < 2; ++s2) { u32x4 w; w.x = pk2(p[8 * s2], p[8 * s2 + 1]); w.y = pk2(p[8 * s2 + 2], p[8 * s2 + 3]);
            w.z = pk2(p[8 * s2 + 4], p[8 * s2 + 5]); w.w = pk2(p[8 * s2 + 6], p[8 * s2 + 7]); pf[qt][s2] = __builtin_bit_cast(bf16x8, w); }
        }
#pragma unroll
        for (int dt = 0; dt < 2; ++dt)
#pragma unroll
          for (int s2 = 0; s2 < 2; ++s2) { const bf16x8 vf = *(const bf16x8*)(Vb + (dt * 32 + c) * 144 + kt2 * 64 + s2 * 32 + h * 16);
#pragma unroll
            for (int qt = 0; qt < NQT; ++qt) O[qt][dt] = MFMA(vf, pf[qt][s2], O[qt][dt]); }
      }
    }
    __builtin_amdgcn_sched_barrier(0);
    if (st + 1 < se) lstore(buf ^ 1);
    __syncthreads();
  }

#pragma unroll
  for (int qt = 0; qt < NQT; ++qt) l[qt] += __shfl_xor(l[qt], 32);
  if (MODE == 1) {
    float pa = 0.f, pb = 0.f;
    if (lane < 32) { pa = a.lq1[lane] * a.lk1[lane]; pb = a.lq2[lane] * a.lk2[lane]; }
#pragma unroll
    for (int o = 32; o; o >>= 1) { pa += __shfl_xor(pa, o); pb += __shfl_xor(pb, o); }
    const float lam = expf(pa) - expf(pb) + a.lam_init;
    const float i0 = 1.f / l[0], i1 = lam / l[NQT - 1];
    f32x16 o[2]; float ss = 0.f;
#pragma unroll
    for (int dt = 0; dt < 2; ++dt)
#pragma unroll
      for (int r = 0; r < 16; ++r) { o[dt][r] = O[0][dt][r] * i0 - O[NQT - 1][dt][r] * i1; ss += o[dt][r] * o[dt][r]; }
    ss += __shfl_xor(ss, 32);
    const float rn = rsqrtf(ss * (1.f / 64.f) + EPS) * (1.f - a.lam_init);
#pragma unroll
    for (int dt = 0; dt < 2; ++dt) {
#pragma unroll
      for (int g = 0; g < 4; ++g) { const f32x4 gg = *(const f32x4*)(a.subln + dt * 32 + 8 * g + 4 * h);
#pragma unroll
        for (int i = 0; i < 4; ++i) o[dt][4 * g + i] *= rn * gg[i]; }
      store_plain(a.mix + (size_t)qtok[0] * 1024 + 256 + hd * 64 + dt * 32, o[dt], h);
    }
  } else {
#pragma unroll
    for (int qt = 0; qt < NQT; ++qt) {
      int head, colb, seg;
      if (MODE == 0) { head = hd; colb = hd * 64; seg = 0; }
      else if (MODE == 2) { head = hd; colb = 512 + head * 64; seg = 1; l[qt] += __builtin_amdgcn_exp2f(a.sinks[head] * LOG2E - cb); }
      else { head = hd; colb = 768 + hd * 64; seg = 2; }
      const float inv = 1.f / l[qt]; float ss = 0.f;
#pragma unroll
      for (int dt = 0; dt < 2; ++dt) { f32x16 o = O[qt][dt] * inv; ss += sumsq16(o); store_plain(a.mix + (size_t)qtok[qt] * 1024 + colb + dt * 32, o, h); }
      ss += __shfl_xor(ss, 32);
      if (h == 0) a.ssm[(size_t)(seg * 4 + head) * S + qtok[qt]] = ss;
    }
  }
}


template <bool B> struct BoolC { static constexpr bool value = B; };
#define SGB(mask, n) __builtin_amdgcn_sched_group_barrier((mask), (n), 0)
template <int MODE>
__device__ __forceinline__ bool attn_pipe(char* lds, const AttnArgs& a, int item) {
  constexpr int KSTR = MODE == 0 ? 208 : 144;
  constexpr int NKS = MODE == 0 ? 6 : 2;
  constexpr int NKP = MODE == 0 ? 3 : 2;
  constexpr int NST = 256;
  constexpr int NQT = MODE == 0 ? 1 : 2;
  int tid_ = threadIdx.x; asm volatile("" : "+v"(tid_));
  const int tid = tid_, lane = tid & 63, wid = tid >> 6, c = lane & 31, h = lane >> 5;
  const int hd = item & 3, qb = item >> 2;
  int qtok[NQT]; const bf16_t* qptr[NQT]; const bf16_t* kbase; const bf16_t* vbase; int k2slot;
  if constexpr (MODE == 0) {
    qtok[0] = qb * 128 + wid * 32 + c; qptr[0] = a.Qa + (size_t)qtok[0] * 384 + hd * 96;
    kbase = a.KN + hd * 64; vbase = a.VtA + (size_t)hd * 64 * VLD; k2slot = hd;
  } else {
#pragma unroll
    for (int qt = 0; qt < 2; ++qt) { qtok[qt] = qb * 128 + wid * 32 + c; qptr[qt] = a.P + (size_t)qtok[qt] * NP + 384 + hd * 64 + qt * 32; }
    kbase = a.P + 640 + hd * 64; vbase = a.Vt + (size_t)hd * 64 * VLD; k2slot = 5 + hd;
  }
  bf16x8 qf[NQT][NKS]; float q2max = 0.f;
#pragma unroll
  for (int qt = 0; qt < NQT; ++qt) { float s = 0.f;
#pragma unroll
    for (int ks = 0; ks < NKS; ++ks) { qf[qt][ks] = *(const bf16x8*)(qptr[qt] + ks * 16 + h * 8);
#pragma unroll
      for (int j = 0; j < 8; ++j) { const float f = bf2f((unsigned short)qf[qt][ks][j]); s += f * f; } }
    s += __shfl_xor(s, 32); q2max = fmaxf(q2max, s); }
#pragma unroll
  for (int o = 16; o; o >>= 1) q2max = fmaxf(q2max, __shfl_xor(q2max, o));
  float k2 = __uint_as_float(a.kmax[k2slot]); if (MODE == 0) k2 += __uint_as_float(a.kmax[4]);
  const float cb = sqrtf(q2max * k2) * 1.01f + 0.01f;
  { volatile int* flag = (volatile int*)(lds + 3 * ABUF);
    if (tid == 0) *flag = 0;
    __syncthreads();
    if (cb > 96.f && lane == 0) *flag = 1;
    __syncthreads();
    if (*flag) return false; }
  f32x16 O[NQT][2]; float l[NQT];
#pragma unroll
  for (int i = 0; i < NQT; ++i) { l[i] = 0.f;
#pragma unroll
    for (int j = 0; j < 2; ++j)
#pragma unroll
      for (int r = 0; r < 16; ++r) O[i][j][r] = 0.f; }

  u32x4 rk[NKP], rv[2];
  auto gload = [&](int st) {
    const int kb = st * 64;
#pragma unroll
    for (int i = 0; i < NKP; ++i) { const int p = tid + 256 * i;
      if (MODE == 0) {
        if (i < 2) { const int row = p >> 3, ch = p & 7; rk[i] = *(const u32x4*)(kbase + (size_t)(kb + row) * 256 + ch * 8); }
        else { const int row = tid >> 2, ch = tid & 3; rk[i] = *(const u32x4*)(a.P + (size_t)(kb + row) * NP + 192 + ch * 8); } }
      else { const int row = p >> 3, ch = p & 7; rk[i] = *(const u32x4*)(kbase + (size_t)(kb + row) * NP + ch * 8); } }
#pragma unroll
    for (int i = 0; i < 2; ++i) { const int p = tid + 256 * i, dv = p >> 3, ch = p & 7; rv[i] = *(const u32x4*)(vbase + (size_t)dv * VLD + kb + ch * 8); }
  };
  auto lstore = [&](int buf) {
    char* b = lds + buf * ABUF;
#pragma unroll
    for (int i = 0; i < NKP; ++i) { const int p = tid + 256 * i;
      if (MODE == 0) { if (i < 2) { const int row = p >> 3, ch = p & 7; *(u32x4*)(b + row * 208 + ch * 16) = rk[i]; } else { const int row = tid >> 2, ch = tid & 3; *(u32x4*)(b + row * 208 + 128 + ch * 16) = rk[i]; } }
      else { const int row = p >> 3, ch = p & 7; *(u32x4*)(b + row * 144 + ch * 16) = rk[i]; } }
#pragma unroll
    for (int i = 0; i < 2; ++i) { const int p = tid + 256 * i, dv = p >> 3, ch = p & 7; *(u32x4*)(b + AKOFF + dv * 144 + ch * 16) = rv[i]; }
  };
  const int koff = c * KSTR + h * 16, voff = AKOFF + c * 144 + h * 16;
#define QK_UNIT(dst, Kb, u) { _Pragma("unroll") for (int r_ = 0; r_ < 16; ++r_) dst[r_] = 0.f; \
    _Pragma("unroll") for (int ks = 0; ks < NKS; ++ks) { \
      const bf16x8 kf = *(const bf16x8*)((Kb) + koff + ((u) / NQT) * 32 * KSTR + (MODE == 1 ? ((u) % NQT) * 64 : 0) + ks * 32); \
      dst = MFMA(kf, qf[(u) % NQT][ks], dst); } }
#define EXP_UNIT(src, u, pf) { float p_[16]; \
    _Pragma("unroll") for (int i = 0; i < 16; ++i) { p_[i] = __builtin_amdgcn_exp2f(src[i]); l[(u) % NQT] += p_[i]; } \
    _Pragma("unroll") for (int s2 = 0; s2 < 2; ++s2) { u32x4 w_; w_.x = pk2(p_[8 * s2], p_[8 * s2 + 1]); w_.y = pk2(p_[8 * s2 + 2], p_[8 * s2 + 3]); \
      w_.z = pk2(p_[8 * s2 + 4], p_[8 * s2 + 5]); w_.w = pk2(p_[8 * s2 + 6], p_[8 * s2 + 7]); pf[s2] = __builtin_bit_cast(bf16x8, w_); } }
#define PV_UNIT(Vb, u, pf) { \
    _Pragma("unroll") for (int dt = 0; dt < 2; ++dt) \
    _Pragma("unroll") for (int s2 = 0; s2 < 2; ++s2) { \
      const bf16x8 vf = *(const bf16x8*)((Vb) + voff + dt * 32 * 144 + ((u) / NQT) * 64 + s2 * 32); \
      O[(u) % NQT][dt] = MFMA(vf, pf[s2], O[(u) % NQT][dt]); } }
#define SCHED_ITER(NM) { SGB(0x100, 2); \
    _Pragma("unroll") for (int i_ = 0; i_ < (NM); ++i_) { SGB(0x008, 1); SGB(0x002, (40 + (NM) - 1) / (NM)); if (i_ + 2 < (NM)) SGB(0x100, 1); } }

  gload(0); lstore(0); gload(1); lstore(1); __syncthreads();
  if (MODE == 1) __builtin_amdgcn_s_setprio(1);
  f32x16 sc, sn;
  QK_UNIT(sc, lds, 0);
  int cur = 0;
  for (int st = 0; st < NST; ++st) {
    const int nxt = cur == 2 ? 0 : cur + 1, wr = nxt == 2 ? 0 : nxt + 1;
    if (st + 2 < NST) gload(st + 2);
    const char* Kc = lds + cur * ABUF; const char* Kn = lds + nxt * ABUF;
    bf16x8 pa[2], pb[2];
    __builtin_amdgcn_sched_barrier(0);
    if constexpr (NQT == 2) {
      QK_UNIT(sn, Kc, 1); EXP_UNIT(sc, 0, pa); SCHED_ITER(NKS); sc = sn;
      __builtin_amdgcn_sched_barrier(0);
      QK_UNIT(sn, Kc, 2); EXP_UNIT(sc, 1, pb); PV_UNIT(Kc, 0, pa); SCHED_ITER(NKS + 4); sc = sn;
      __builtin_amdgcn_sched_barrier(0);
      QK_UNIT(sn, Kc, 3); EXP_UNIT(sc, 2, pa); PV_UNIT(Kc, 1, pb); SCHED_ITER(NKS + 4); sc = sn;
      __builtin_amdgcn_sched_barrier(0);
      QK_UNIT(sn, Kn, 0); EXP_UNIT(sc, 3, pb); PV_UNIT(Kc, 2, pa); SCHED_ITER(NKS + 4); sc = sn;
      __builtin_amdgcn_sched_barrier(0);
      PV_UNIT(Kc, 3, pb);
    } else {
      QK_UNIT(sn, Kc, 1); EXP_UNIT(sc, 0, pa); SCHED_ITER(NKS); sc = sn;
      __builtin_amdgcn_sched_barrier(0);
      QK_UNIT(sn, Kn, 0); EXP_UNIT(sc, 1, pb); PV_UNIT(Kc, 0, pa); SCHED_ITER(NKS + 4); sc = sn;
      __builtin_amdgcn_sched_barrier(0);
      PV_UNIT(Kc, 1, pb);
    }
    __builtin_amdgcn_sched_barrier(0);
    if (st + 2 < NST) lstore(wr);
    __syncthreads();
    cur = nxt;
  }
  if (MODE == 1) __builtin_amdgcn_s_setprio(0);
#undef QK_UNIT
#undef EXP_UNIT
#undef PV_UNIT
#undef SCHED_ITER

#pragma unroll
  for (int qt = 0; qt < NQT; ++qt) l[qt] += __shfl_xor(l[qt], 32);
  if constexpr (MODE == 1) {
    float pa = 0.f, pb = 0.f;
    if (lane < 32) { pa = a.lq1[lane] * a.lk1[lane]; pb = a.lq2[lane] * a.lk2[lane]; }
#pragma unroll
    for (int o = 32; o; o >>= 1) { pa += __shfl_xor(pa, o); pb += __shfl_xor(pb, o); }
    const float lam = expf(pa) - expf(pb) + a.lam_init;
    const float i0 = 1.f / l[0], i1 = lam / l[1];
    f32x16 o[2]; float ss = 0.f;
#pragma unroll
    for (int dt = 0; dt < 2; ++dt)
#pragma unroll
      for (int r = 0; r < 16; ++r) { o[dt][r] = O[0][dt][r] * i0 - O[1][dt][r] * i1; ss += o[dt][r] * o[dt][r]; }
    ss += __shfl_xor(ss, 32);
    const float rn = rsqrtf(ss * (1.f / 64.f) + EPS) * (1.f - a.lam_init);
#pragma unroll
    for (int dt = 0; dt < 2; ++dt) {
#pragma unroll
      for (int g = 0; g < 4; ++g) { const f32x4 gg = *(const f32x4*)(a.subln + dt * 32 + 8 * g + 4 * h);
#pragma unroll
        for (int i = 0; i < 4; ++i) o[dt][4 * g + i] *= rn * gg[i]; }
      store_plain(a.mix + (size_t)qtok[0] * 1024 + 256 + hd * 64 + dt * 32, o[dt], h);
    }
  } else {
#pragma unroll
    for (int qt = 0; qt < NQT; ++qt) {
      const float inv = 1.f / l[qt]; float ss = 0.f;
#pragma unroll
      for (int dt = 0; dt < 2; ++dt) { f32x16 o = O[qt][dt] * inv; ss += sumsq16(o); store_plain(a.mix + (size_t)qtok[qt] * 1024 + hd * 64 + dt * 32, o, h); }
      ss += __shfl_xor(ss, 32);
      if (h == 0) a.ssm[(size_t)hd * S + qtok[qt]] = ss;
    }
  }
  return true;
}

template <class F>
__device__ __forceinline__ void conv_tile(float* tl, bf16_t* out, int K, int n0, int k0, const F& f) {
  int tid_ = threadIdx.x; asm volatile("" : "+v"(tid_));
  const int tid = tid_, tx = tid & 63, ty = tid >> 6;
#pragma unroll 4
  for (int i = 0; i < 16; ++i) { const int k = ty + 4 * i; tl[k * 65 + tx] = f(k0 + k, n0 + tx); }
  __syncthreads();
  const int kx2 = (tid & 31) * 2, ny = tid >> 5;
#pragma unroll 4
  for (int i = 0; i < 8; ++i) { const int n = ny + 8 * i; *(unsigned*)(out + (size_t)(n0 + n) * K + k0 + kx2) = pk2(tl[kx2 * 65 + n], tl[(kx2 + 1) * 65 + n]); }
  __syncthreads();
}

__device__ void conv_layer(char* lds, const Params& p, int l) {
  float* tl = (float*)lds; char* ws = p.ws;
  const float* w_in = p.w_in + (size_t)l * 1024 * 2400; const float* g1 = p.norm1_g + l * 1024;
  const float* w_out = p.w_out + (size_t)l * 1024 * 1024; const float* gm = p.g_mla + l * 256; const float* gs = p.g_swa + l * 256; const float* gn = p.g_na + l * 256;
  const float* w_up = p.w_up + (size_t)l * 1024 * 4096; const float* g2 = p.norm2_g + l * 1024;
  const float* w_dn = p.w_down + (size_t)l * 4096 * 1024;
  const float* w_uq = p.w_uq + (size_t)l * 192 * 384; const float* qg = p.qn_g + l * 192;
  const float* w_uk = p.w_uk + (size_t)l * 128 * 256; const float* w_uv = p.w_uv + (size_t)l * 128 * 256; const float* kg = p.kvn_g + l * 128;
  const float sB = 0.17677669529663687f * LOG2E, sC = 0.125f * LOG2E, sA = 0.10206207261596577f * LOG2E;
  for (int t = bid_(); t < 2946; t += gridDim.x) {
    if (t < 608) { const int nt = t >> 4, kt = t & 15;
      conv_tile(tl, (bf16_t*)(ws + OFF_WIN), 1024, nt * 64, kt * 64, [&](int k, int n) -> float {
        int src; if (n < 192) src = n; else if (n < 224) src = 320 + n - 192; else if (n < 256) src = -1; else if (n < 384) src = 192 + n - 256; else src = 352 + n - 384;
        if (src < 0) return 0.f;
        float sc = 1.f; if (n >= 384 && n < 640) sc = sB; else if ((n >= 1152 && n < 1408) || (n >= 1664 && n < 1920)) sc = sC;
        return w_in[(size_t)k * 2400 + src] * g1[k] * sc; });
    } else if (t < 864) { const int u = t - 608, nt = u >> 4, kt = u & 15;
      conv_tile(tl, (bf16_t*)(ws + OFF_WOUT), 1024, nt * 64, kt * 64, [&](int k, int n) -> float {
        const float g = k < 256 ? gm[k] : (k < 512 ? 1.f : (k < 768 ? gs[k - 512] : gn[k - 768]));
        return w_out[(size_t)k * 1024 + n] * g; });
    } else if (t < 1888) { const int u = t - 864, nt = u >> 4, kt = u & 15;
      conv_tile(tl, (bf16_t*)(ws + OFF_WUP), 1024, nt * 64, kt * 64, [&](int k, int n) -> float { return w_up[(size_t)k * 4096 + n] * g2[k]; });
    } else if (t < 2912) { const int u = t - 1888, nt = u >> 6, kt = u & 63;
      conv_tile(tl, (bf16_t*)(ws + OFF_WDN), 4096, nt * 64, kt * 64, [&](int k, int n) -> float { return w_dn[(size_t)k * 1024 + n]; });
    } else if (t < 2930) { const int u = t - 2912, nt = u / 3, kt = u % 3;
      conv_tile(tl, (bf16_t*)(ws + OFF_WUQ), 192, nt * 64, kt * 64, [&](int k, int n) -> float { return w_uq[(size_t)k * 384 + n] * qg[k] * sA; });
    } else { const int u = t - 2930, nt = u >> 1, kt = u & 1;
      conv_tile(tl, (bf16_t*)(ws + OFF_WKV), 128, nt * 64, kt * 64, [&](int k, int n) -> float {
        return (n < 256 ? w_uk[(size_t)k * 256 + n] : w_uv[(size_t)k * 256 + n - 256]) * kg[k]; });
    }
  }
}

__device__ __forceinline__ void gbar(unsigned* base) {
  __syncthreads();
  if (threadIdx.x == 0) {
    __builtin_amdgcn_fence(__ATOMIC_RELEASE, "agent");
    const unsigned g = blockIdx.x & 15u, ng = gridDim.x >> 4;
    unsigned* cnt = base + g * 32; unsigned* root = base + 16 * 32; unsigned* gen = base + (17 + g) * 32;
    const unsigned old = __hip_atomic_load(gen, __ATOMIC_RELAXED, __HIP_MEMORY_SCOPE_AGENT);
    if (__hip_atomic_fetch_add(cnt, 1u, __ATOMIC_RELAXED, __HIP_MEMORY_SCOPE_AGENT) == ng - 1u) {
      __hip_atomic_store(cnt, 0u, __ATOMIC_RELAXED, __HIP_MEMORY_SCOPE_AGENT);
      __builtin_amdgcn_fence(__ATOMIC_RELEASE, "agent");
      if (__hip_atomic_fetch_add(root, 1u, __ATOMIC_RELAXED, __HIP_MEMORY_SCOPE_AGENT) == 15u) {
        __hip_atomic_store(root, 0u, __ATOMIC_RELAXED, __HIP_MEMORY_SCOPE_AGENT);
        __builtin_amdgcn_fence(__ATOMIC_RELEASE, "agent");
        for (unsigned k = 0; k < 16; ++k) __hip_atomic_fetch_add(base + (17 + k) * 32, 1u, __ATOMIC_RELAXED, __HIP_MEMORY_SCOPE_AGENT);
      }
    }
    while (__hip_atomic_load(gen, __ATOMIC_RELAXED, __HIP_MEMORY_SCOPE_AGENT) == old) __builtin_amdgcn_s_sleep(2);
    __builtin_amdgcn_fence(__ATOMIC_ACQUIRE, "agent");
  }
  __syncthreads();
}

__device__ __forceinline__ void sincos_acc(float ang, float& sn, float& cs) {
  const double a = (double)ang; const double n = rint(a * 0.15915494309189535);
  const double r = a - n * 6.283185307179586476925; const double r2 = r * r;
  double s = -1.0 / 51090942171709440000.0;
  s = s * r2 + 1.0 / 121645100408832000.0; s = s * r2 - 1.0 / 355687428096000.0; s = s * r2 + 1.0 / 1307674368000.0; s = s * r2 - 1.0 / 6227020800.0;
  s = s * r2 + 1.0 / 39916800.0; s = s * r2 - 1.0 / 362880.0; s = s * r2 + 1.0 / 5040.0; s = s * r2 - 1.0 / 120.0; s = s * r2 + 1.0 / 6.0; s = s * r2 - 1.0; s = -s * r;
  double c = 1.0 / 1124000727777607680000.0;
  c = c * r2 - 1.0 / 2432902008176640000.0; c = c * r2 + 1.0 / 6402373705728000.0; c = c * r2 - 1.0 / 20922789888000.0; c = c * r2 + 1.0 / 87178291200.0;
  c = c * r2 - 1.0 / 479001600.0; c = c * r2 + 1.0 / 3628800.0; c = c * r2 - 1.0 / 40320.0; c = c * r2 + 1.0 / 720.0; c = c * r2 - 1.0 / 24.0; c = c * r2 + 0.5; c = 1.0 - c * r2;
  sn = (float)s; cs = (float)c;
}

__global__ void __launch_bounds__(256, 2) mega(Params p) {
  cg::grid_group grid = cg::this_grid();
  __shared__ __attribute__((aligned(16))) char lds[73728];
  __shared__ int s_item; __shared__ int s_q[2];
#ifdef PROBE_SEL
  __shared__ unsigned long long s_t[10];
  if (threadIdx.x == 0) { for (int i = 0; i < 9; ++i) s_t[i] = 0; s_t[9] = __builtin_amdgcn_s_memrealtime(); }
#define TSTAMP(k) { if (blockIdx.x == 0 && threadIdx.x == 0) { const unsigned long long t_ = __builtin_amdgcn_s_memrealtime(); s_t[k] += t_ - s_t[9]; s_t[9] = t_; } }
#else
#define TSTAMP(k)
#endif
#define GBAR { size_t wz2_ = 0; asm volatile("" : "+s"(wz2_)); gbar((unsigned*)(p.ws + OFF_CTRL + wz2_) + 1024); }
#define WSPTRS \
  size_t wz_ = 0; asm volatile("" : "+s"(wz_)); char* ws = p.ws + wz_; \
  bf16_t* XB = (bf16_t*)(ws + OFF_XB); bf16_t* MIX = (bf16_t*)(ws + OFF_MIX); bf16_t* P = (bf16_t*)(ws + OFF_P); bf16_t* VT = (bf16_t*)(ws + OFF_VT); \
  bf16_t* QA = (bf16_t*)(ws + OFF_QA); bf16_t* KN = (bf16_t*)(ws + OFF_KN); bf16_t* VTA = (bf16_t*)(ws + OFF_VTA); bf16_t* H = (bf16_t*)(ws + OFF_H); \
  float* C32 = (float*)(ws + OFF_TAB); float* S32 = C32 + S * 16; float* C64 = S32 + S * 16; float* S64 = C64 + S * 32; \
  float* SSX = (float*)(ws + OFF_SSX); float* SSA = (float*)(ws + OFF_SSA); float* SSM = (float*)(ws + OFF_SSM); \
  unsigned* CTRL = (unsigned*)(ws + OFF_CTRL); unsigned* kmax = CTRL + 16 + 16 * l; \
  (void)XB; (void)MIX; (void)P; (void)VT; (void)QA; (void)KN; (void)VTA; (void)H; (void)C32; (void)S32; (void)C64; (void)S64; (void)SSX; (void)SSA; (void)SSM; (void)CTRL; (void)kmax;

  { const int l = 0; WSPTRS
  int tid_ = threadIdx.x; asm volatile("" : "+v"(tid_));
  const int tid = tid_, lane = tid & 63, wid = tid >> 6, gw = bid_() * 4 + wid, nw = gridDim.x * 4;
  if (blockIdx.x == 0) { for (int i = tid; i < 4096; i += 256) CTRL[i] = 0u; }
  for (int row = gw; row < S; row += nw) {
    const f32x4* xr = (const f32x4*)(p.x + (size_t)row * 1024); float s = 0.f;
#pragma unroll
    for (int i = 0; i < 4; ++i) { const f32x4 v = xr[lane + 64 * i]; s += v[0] * v[0] + v[1] * v[1] + v[2] * v[2] + v[3] * v[3];
      u32x2 w; w.x = pk2(v[0], v[1]); w.y = pk2(v[2], v[3]); *(u32x2*)(XB + (size_t)row * 1024 + (lane + 64 * i) * 4) = w; }
#pragma unroll
    for (int o = 32; o; o >>= 1) s += __shfl_xor(s, o);
    if (lane < 16) SSX[(size_t)row * 16 + lane] = lane == 0 ? s : 0.f;
  }
  for (int idx = bid_() * 256 + tid; idx < S * 48; idx += gridDim.x * 256) {
    const int pos = idx / 48, i = idx - pos * 48; float sn, cs;
    if (i < 16) { const float inv = 1.0f / powf(10000.f, (float)(2 * i) / 32.f); sincos_acc((float)pos * inv, sn, cs); C32[pos * 16 + i] = cs; S32[pos * 16 + i] = sn; }
    else { const int j = i - 16; const float inv = 1.0f / powf(10000.f, (float)(2 * j) / 64.f); sincos_acc((float)pos * inv, sn, cs); C64[pos * 32 + j] = cs; S64[pos * 32 + j] = sn; }
  }
  }

#pragma unroll 1
  for (int l = 0; l < 4; ++l) {
    conv_layer(lds, p, l);
    if (l == 0) grid.sync(); else GBAR;
    TSTAMP(0)
    { WSPTRS GemmArgs g{XB, 1024, (const bf16_t*)(ws + OFF_WIN), 1024, 1024, nullptr};
      EpiIn e{P, VT, SSX, SSA, C32, S32, C64, S64, kmax};
      bool st_ = false;
      for (int t = bid_(); t < 128 * 19; t += gridDim.x) { const int u = remap8(t, 128 * 19); const int tn = t + (int)gridDim.x; const bool hn = tn < 128 * 19; const int un = hn ? remap8(tn, 128 * 19) : 0;
        gemm_tile<false>(lds, g, (u / 19) * 128, (u % 19) * 128, e, st_, hn ? (un / 19) * 128 : -1, (un % 19) * 128); st_ = hn; } }
    GBAR; TSTAMP(1)
    { WSPTRS GemmArgs gq{P, NP, (const bf16_t*)(ws + OFF_WUQ), 192, 192, nullptr}; EpiUq eq{QA, SSA, C32, S32};
      GemmArgs gk{P + 256, NP, (const bf16_t*)(ws + OFF_WKV), 128, 128, nullptr}; EpiKv ek{KN, VTA, SSA, kmax};
      for (int t = bid_(); t < 896; t += gridDim.x) { const int u = remap8(t, 896);
        if (u < 384) gemm_tile<false>(lds, gq, (u / 3) * 128, (u % 3) * 128, eq);
        else { const int v = u - 384; gemm_tile<false>(lds, gk, (v >> 2) * 128, (v & 3) * 128, ek); } } }
    GBAR; TSTAMP(2)
    { WSPTRS AttnArgs a{P, VT, QA, KN, VTA, MIX, SSM, kmax, p.lq1 + l * 32, p.lk1 + l * 32, p.lq2 + l * 32, p.lk2 + l * 32, p.subln_g + l * 64, p.sinks + l * 4,
                 p.rpb + l * 4 * 465, p.lam_init[l]};
      unsigned* ctr = CTRL + 128 + 32 * l;
      if (threadIdx.x == 0) { int z_ = 0; asm volatile("" : "+v"(z_)); s_q[0] = z_; }
      for (;;) {
        if (threadIdx.x == 0) {
          const int xcc = (int)(__builtin_amdgcn_s_getreg((3 << 11) | 20) & 7u);
          const int pq_ = s_q[0]; int pass = pq_ >> 3, dq = pq_ & 7;
          int it = -1;
          while (pass < 2) {
            const int ep = pass ^ (int)((blockIdx.x >> 8) & 1u);
            const int q = (xcc + dq) & 7; const int idx = (int)atomicAdd(ctr + ep * 8 + q, 1u);
            if (idx < 64) { it = ep * 1024 + (((((q >> 2) * 64 + idx) << 2)) | (q & 3)); break; }
            if (++dq == 8) { dq = 0; ++pass; }
          }
          if (it < 0) { const int idx = (int)atomicAdd(ctr + 16, 1u); it = idx < 1024 ? 2048 + idx : -1; }
          s_item = it; s_q[0] = pass * 8 + dq;
        }
        __syncthreads(); const int item = s_item; __syncthreads();
        if (item < 0) break;
        if (item < 1024) { if (!attn_pipe<1>(lds, a, item)) attn_item<1>(lds, a, item); }
        else if (item < 2048) { if (!attn_pipe<0>(lds, a, item - 1024)) attn_item<0>(lds, a, item - 1024); }
        else if (item < 2560) attn_item<2>(lds, a, item - 2048);
        else attn_item<3>(lds, a, item - 2560);
      } }
    TSTAMP(7)
    GBAR; TSTAMP(3)
    { WSPTRS GemmArgs g{MIX, 1024, (const bf16_t*)(ws + OFF_WOUT), 1024, 1024, SSM};
      EpiRes e{l == 0 ? p.x : p.out, p.out, XB, SSX};
      bool st_ = false;
      for (int t = bid_(); t < 1024; t += gridDim.x) { const int u = remap8(t, 1024); const int tn = t + (int)gridDim.x; const bool hn = tn < 1024; const int un = hn ? remap8(tn, 1024) : 0;
        gemm_tile<true>(lds, g, (u >> 3) * 128, (u & 7) * 128, e, st_, hn ? (un >> 3) * 128 : -1, (un & 7) * 128); st_ = hn; } }
    GBAR; TSTAMP(4)
    { WSPTRS GemmArgs g{XB, 1024, (const bf16_t*)(ws + OFF_WUP), 1024, 1024, nullptr}; EpiUp e{H, SSX};
      bool st_ = false;
      for (int t = bid_(); t < 4096; t += gridDim.x) { const int u = remap8(t, 4096); const int tn = t + (int)gridDim.x; const bool hn = tn < 4096; const int un = hn ? remap8(tn, 4096) : 0;
        gemm_tile<false>(lds, g, (u >> 5) * 128, (u & 31) * 128, e, st_, hn ? (un >> 5) * 128 : -1, (un & 31) * 128); st_ = hn; } }
    GBAR; TSTAMP(5)
    { WSPTRS GemmArgs g{H, 4096, (const bf16_t*)(ws + OFF_WDN), 4096, 4096, nullptr}; EpiRes e{p.out, p.out, XB, SSX};
      bool st_ = false;
      for (int t = bid_(); t < 1024; t += gridDim.x) { const int u = remap8(t, 1024); const int tn = t + (int)gridDim.x; const bool hn = tn < 1024; const int un = hn ? remap8(tn, 1024) : 0;
        gemm_tile<false>(lds, g, (u >> 3) * 128, (u & 7) * 128, e, st_, hn ? (un >> 3) * 128 : -1, (un & 7) * 128); st_ = hn; } }
    GBAR; TSTAMP(6)
  }
  const int l = 0; WSPTRS
  int tid_ = threadIdx.x; asm volatile("" : "+v"(tid_));
  const int lane = tid_ & 63, gw = bid_() * 4 + (tid_ >> 6), nw = gridDim.x * 4;
  for (int row = gw; row < S; row += nw) {
    const float rr = rowscale_ssx(SSX, row);
    f32x4* xr = (f32x4*)(p.out + (size_t)row * 1024);
#pragma unroll
    for (int i = 0; i < 4; ++i) { f32x4 v = xr[lane + 64 * i]; const f32x4 g = ((const f32x4*)p.fin_g)[lane + 64 * i]; v = v * rr * g; xr[lane + 64 * i] = v; }
  }
#ifdef PROBE_SEL
  { const int l = 0; WSPTRS
    if (blockIdx.x == 0 && threadIdx.x == 0) {
      unsigned long long tot = 0, sel = 0;
      for (int i = 0; i < 9; ++i) { tot += s_t[i]; if ((PROBE_SEL >> i) & 1) sel += s_t[i]; }
      ((float*)CTRL)[500] = (float)((double)sel / (double)tot);
    }
    grid.sync();
    const float fr = ((const float*)CTRL)[500];
    for (int row = gw; row < 64; row += nw) {
      f32x4* xr = (f32x4*)(p.out + (size_t)row * 1024);
      for (int i = 0; i < 4; ++i) { f32x4 v = xr[lane + 64 * i]; const float d = 0.05f * fr; v[0] += d; v[1] -= d; v[2] += d; v[3] -= d; xr[lane + 64 * i] = v; }
    }
  }
#endif
}

extern "C" void kernel_launch(void* const* d_in, const int* in_sizes, int n_in, void* d_out, int out_size,
                              void* d_ws, size_t ws_size, hipStream_t stream) {
  static int grid_blocks = 0;
  if (!grid_blocks) {
    int dev = 0, cus = 0, per_cu = 0;
    (void)hipGetDevice(&dev);
    (void)hipDeviceGetAttribute(&cus, hipDeviceAttributeMultiprocessorCount, dev);
    (void)hipOccupancyMaxActiveBlocksPerMultiprocessor(&per_cu, mega, 256, 0);
    per_cu = 2;
    grid_blocks = cus * per_cu;
  }
  Params p{};
  const float** pp = (const float**)&p;
  for (int i = 0; i < 23; ++i) pp[i] = (const float*)d_in[i];
  p.out = (float*)d_out; p.ws = (char*)d_ws;
  for (int l = 0; l < 4; ++l) p.lam_init[l] = (float)(0.8 - 0.6 * exp(-0.3 * (double)l));
  void* args[] = {&p};
  hipError_t e = hipLaunchCooperativeKernel((void*)mega, dim3(grid_blocks), dim3(256), args, 0, stream);
  if (e != hipSuccess) fprintf(stderr, "cooperative launch failed: %s (grid %d)\n", hipGetErrorString(e), grid_blocks);
}
```

```cpp
#include <hip/hip_runtime.h>
#include <hip/hip_cooperative_groups.h>
#include <cstdio>
#include <cmath>
namespace cg = cooperative_groups;

typedef unsigned short bf16_t;
typedef short bf16x8 __attribute__((ext_vector_type(8)));
typedef float f32x16 __attribute__((ext_vector_type(16)));
typedef float f32x4 __attribute__((ext_vector_type(4)));
typedef float f32x2 __attribute__((ext_vector_type(2)));
typedef unsigned u32x2 __attribute__((ext_vector_type(2)));
typedef unsigned u32x4 __attribute__((ext_vector_type(4)));
typedef __bf16 bf2_t __attribute__((ext_vector_type(2)));

constexpr int S = 16384, NP = 2432, VLD = S + 128;
constexpr float EPS = 1e-6f, LOG2E = 1.4426950408889634f;

constexpr size_t OFF_WIN = 0;
constexpr size_t OFF_WOUT = OFF_WIN + (size_t)NP * 1024 * 2;
constexpr size_t OFF_WUP = OFF_WOUT + (size_t)1024 * 1024 * 2;
constexpr size_t OFF_WDN = OFF_WUP + (size_t)4096 * 1024 * 2;
constexpr size_t OFF_WUQ = OFF_WDN + (size_t)4096 * 1024 * 2;
constexpr size_t OFF_WKV = OFF_WUQ + (size_t)384 * 192 * 2;
constexpr size_t OFF_XB = OFF_WKV + (size_t)512 * 128 * 2;
constexpr size_t OFF_MIX = OFF_XB + (size_t)S * 1024 * 2;
constexpr size_t OFF_R1 = OFF_MIX + (size_t)S * 1024 * 2;
constexpr size_t OFF_P = OFF_R1;
constexpr size_t OFF_VT = OFF_P + (size_t)S * NP * 2;
constexpr size_t OFF_QA = OFF_VT + (size_t)640 * VLD * 2;
constexpr size_t OFF_KN = OFF_QA + (size_t)S * 384 * 2;
constexpr size_t OFF_VTA = OFF_KN + (size_t)S * 256 * 2;
constexpr size_t OFF_H = OFF_R1;
constexpr size_t OFF_TAB = OFF_R1 + (size_t)S * 4096 * 2;
constexpr size_t OFF_SSX = OFF_TAB + (size_t)S * 96 * 4;
constexpr size_t OFF_SSA = OFF_SSX + (size_t)S * 16 * 4;
constexpr size_t OFF_SSM = OFF_SSA + (size_t)S * 8 * 4;
constexpr size_t OFF_CTRL = OFF_SSM + (size_t)12 * S * 4;
static_assert(OFF_VTA + (size_t)256 * VLD * 2 <= OFF_TAB, "overlay");

struct Params {
  const float *x, *norm1_g, *w_in, *qn_g, *w_uq, *kvn_g, *w_uk, *w_uv, *lq1, *lk1, *lq2, *lk2, *subln_g, *sinks, *rpb,
      *g_mla, *g_swa, *g_na, *w_out, *norm2_g, *w_up, *w_down, *fin_g;
  float* out; char* ws; float lam_init[4];
};

__device__ __forceinline__ unsigned pk2(float a, float b) { bf2_t r = __builtin_convertvector((f32x2){a, b}, bf2_t); return __builtin_bit_cast(unsigned, r); }
__device__ __forceinline__ bf16_t f2bf(float a) { return (bf16_t)(pk2(a, 0.f) & 0xffffu); }
__device__ __forceinline__ float bf2f(unsigned v) { return __uint_as_float(v << 16); }
__device__ __forceinline__ int crow(int r, int h) { return (r & 3) + 8 * (r >> 2) + 4 * h; }
__device__ __forceinline__ int permtok(int t) { return (t & ~12) | ((t & 4) << 1) | ((t & 8) >> 1); }
__device__ __forceinline__ int remap8(int t, int T) { return (t & 7) * (T >> 3) + (t >> 3); }
__device__ __forceinline__ int bid_() { int b = blockIdx.x; asm volatile("" : "+s"(b)); return b; }
#define MFMA(a, b, c) __builtin_amdgcn_mfma_f32_32x32x16_bf16((a), (b), (c), 0, 0, 0)

struct GemmArgs { const bf16_t* A; int lda; const bf16_t* Bt; int ldb; int K; const float* asc; };

#define LAS3 __attribute__((address_space(3)))
template <int V> struct IntC { static constexpr int value = V; };
__device__ __forceinline__ float seg_rscale(const float* asc, int seg, int tok) {
  if (seg == 1) return 1.f;
  const int idx = seg == 0 ? 0 : (seg == 2 ? 1 : 2);
  const float* sp = asc + (size_t)idx * 4 * S + tok;
  return rsqrtf((sp[0] + sp[S] + sp[2 * S] + sp[3 * S]) * (1.f / 256.f) + EPS);
}
template <bool ASC, class Epi>
__device__ __forceinline__ void gemm_tile(char* lds, const GemmArgs& g, int m0, int n0, const Epi& epi, bool staged = false, int nm0 = -1, int nn0 = 0) {
  int tid_ = threadIdx.x; asm volatile("" : "+v"(tid_));
  const int tid = tid_, lane = tid & 63, wid = __builtin_amdgcn_readfirstlane(tid >> 6), wr = wid >> 1, wc = wid & 1, c = lane & 31, h = lane >> 5;
  f32x16 acc[2][2];
#pragma unroll
  for (int i = 0; i < 2; ++i)
#pragma unroll
    for (int j = 0; j < 2; ++j)
#pragma unroll
      for (int r = 0; r < 16; ++r) acc[i][j][r] = 0.f;
  const int prow = tid >> 3, gch = (tid & 7) ^ ((prow >> 1) & 7);
  const bf16_t* Ap; Ap = g.A + (size_t)(m0 + prow) * g.lda + gch * 8;
  const bf16_t* Bp; Bp = g.Bt + (size_t)(n0 + prow) * g.ldb + gch * 8;
  (void)0;
  const size_t astep = (size_t)32 * g.lda, bstep = (size_t)32 * g.ldb;
  LAS3 char* l3 = (LAS3 char*)lds;
  const int nk = g.K >> 6;
  auto stage = [&](int kt, auto BUFC) {
    constexpr int buf = decltype(BUFC)::value;
#pragma unroll
    for (int i = 0; i < 4; ++i) {
      __builtin_amdgcn_global_load_lds((const unsigned*)(Ap + i * astep + kt * 64), (LAS3 unsigned*)(l3 + buf * 32768 + (256 * i + 64 * wid) * 16), 16, 0, 0);
      __builtin_amdgcn_global_load_lds((const unsigned*)(Bp + i * bstep + kt * 64), (LAS3 unsigned*)(l3 + buf * 32768 + 16384 + (256 * i + 64 * wid) * 16), 16, 0, 0);
    }
  };
  const int swz = (c >> 1) & 7;
  const unsigned lbase = (unsigned)(size_t)l3;
  const unsigned aoff = (wr * 64 + c) * 128, boff = 16384 + (wc * 64 + c) * 128;
  unsigned kofs[4];
#pragma unroll
  for (int ks = 0; ks < 4; ++ks) kofs[ks] = ((2 * ks + h) ^ swz) << 4;
  float rcur[2] = {1.f, 1.f};
  if (ASC) { rcur[0] = seg_rscale(g.asc, 0, m0 + wr * 64 + c); rcur[1] = seg_rscale(g.asc, 0, m0 + wr * 64 + 32 + c); }
  if (!staged) stage(0, IntC<0>{});
  asm volatile("s_waitcnt vmcnt(0)" ::: "memory"); __syncthreads();
  auto body = [&](int kt, auto BUFC) {
    constexpr int buf = decltype(BUFC)::value;
    if (kt + 1 < nk) stage(kt + 1, IntC<1 - buf>{});
    if (ASC) { if (kt > 0 && (kt & 3) == 0) {
#pragma unroll
      for (int mt = 0; mt < 2; ++mt) { const float rn = seg_rscale(g.asc, kt >> 2, m0 + wr * 64 + mt * 32 + c); const float f = rcur[mt] / rn; rcur[mt] = rn;
        acc[mt][0] = acc[mt][0] * f; acc[mt][1] = acc[mt][1] * f; } } }
    bf16x8 fr[2][4];
#define GRD(set, ks) { const unsigned aa_ = lbase + buf * 32768 + aoff + kofs[ks], bb_ = lbase + buf * 32768 + boff + kofs[ks]; \
      asm volatile("ds_read_b128 %0, %1" : "=v"(fr[set][0]) : "v"(aa_)); asm volatile("ds_read_b128 %0, %1 offset:4096" : "=v"(fr[set][1]) : "v"(aa_)); \
      asm volatile("ds_read_b128 %0, %1" : "=v"(fr[set][2]) : "v"(bb_)); asm volatile("ds_read_b128 %0, %1 offset:4096" : "=v"(fr[set][3]) : "v"(bb_)); }
    GRD(0, 0);
#pragma unroll
    for (int ks = 0; ks < 4; ++ks) {
      if (ks < 3) { GRD((ks + 1) & 1, ks + 1); asm volatile("s_waitcnt lgkmcnt(4)" : "+v"(fr[ks & 1][0]), "+v"(fr[ks & 1][1]), "+v"(fr[ks & 1][2]), "+v"(fr[ks & 1][3])); }
      else asm volatile("s_waitcnt lgkmcnt(0)" : "+v"(fr[ks & 1][0]), "+v"(fr[ks & 1][1]), "+v"(fr[ks & 1][2]), "+v"(fr[ks & 1][3]));
      __builtin_amdgcn_s_setprio(1);
#pragma unroll
      for (int mt = 0; mt < 2; ++mt)
#pragma unroll
        for (int nt = 0; nt < 2; ++nt) acc[mt][nt] = MFMA(fr[ks & 1][2 + nt], fr[ks & 1][mt], acc[mt][nt]);
      __builtin_amdgcn_s_setprio(0);
    }
#undef GRD
    asm volatile("s_waitcnt vmcnt(0)" ::: "memory"); __builtin_amdgcn_s_barrier(); asm volatile("" ::: "memory");
  };
  for (int kt = 0; kt < nk; kt += 2) { body(kt, IntC<0>{}); if (kt + 1 < nk) body(kt + 1, IntC<1>{}); }
  if (nm0 >= 0) {
    Ap = g.A + (size_t)(nm0 + prow) * g.lda + gch * 8; Bp = g.Bt + (size_t)(nn0 + prow) * g.ldb + gch * 8;
    stage(0, IntC<0>{});
  }
  if (ASC) {
#pragma unroll
    for (int mt = 0; mt < 2; ++mt) { acc[mt][0] = acc[mt][0] * rcur[mt]; acc[mt][1] = acc[mt][1] * rcur[mt]; } }
  epi(acc, m0, n0, wr, wc, c, h);
}

__device__ __forceinline__ void store_plain(bf16_t* dst, const f32x16& v, int h) {
#pragma unroll
  for (int g = 0; g < 4; ++g) { u32x2 w; w.x = pk2(v[4 * g], v[4 * g + 1]); w.y = pk2(v[4 * g + 2], v[4 * g + 3]); *(u32x2*)(dst + 8 * g + 4 * h) = w; }
}
__device__ __forceinline__ void store_vt(bf16_t* vt, int featbase, int tok, const f32x16& v, int h) {
  const int pt = permtok(tok);
#pragma unroll
  for (int r = 0; r < 16; ++r) vt[(size_t)(featbase + crow(r, h)) * VLD + pt] = f2bf(v[r]);
}
__device__ __forceinline__ void rope32(f32x16& v, const float* c32, const float* s32, int tok, int h) {
  const f32x4 ca = *(const f32x4*)(c32 + tok * 16 + 4 * h), cb = *(const f32x4*)(c32 + tok * 16 + 8 + 4 * h);
  const f32x4 sa = *(const f32x4*)(s32 + tok * 16 + 4 * h), sb = *(const f32x4*)(s32 + tok * 16 + 8 + 4 * h);
#pragma unroll
  for (int i = 0; i < 4; ++i) {
    float x1 = v[i], x2 = v[i + 8]; v[i] = x1 * ca[i] - x2 * sa[i]; v[i + 8] = x2 * ca[i] + x1 * sa[i];
    x1 = v[4 + i]; x2 = v[12 + i]; v[4 + i] = x1 * cb[i] - x2 * sb[i]; v[12 + i] = x2 * cb[i] + x1 * sb[i];
  }
}
__device__ __forceinline__ void rope64(f32x16& v0, f32x16& v1, const float* c64, const float* s64, int tok, int h) {
#pragma unroll
  for (int g = 0; g < 4; ++g) {
    const f32x4 cg4 = *(const f32x4*)(c64 + tok * 32 + 8 * g + 4 * h), sg4 = *(const f32x4*)(s64 + tok * 32 + 8 * g + 4 * h);
#pragma unroll
    for (int i = 0; i < 4; ++i) { const float x1 = v0[4 * g + i], x2 = v1[4 * g + i]; v0[4 * g + i] = x1 * cg4[i] - x2 * sg4[i]; v1[4 * g + i] = x2 * cg4[i] + x1 * sg4[i]; }
  }
}
__device__ __forceinline__ float sumsq16(const f32x16& v) { float s = 0.f;
#pragma unroll
  for (int r = 0; r < 16; ++r) s += v[r] * v[r];
  return s; }
__device__ __forceinline__ void kmax_update(unsigned* slot, float s) {
  s += __shfl_xor(s, 32);
#pragma unroll
  for (int o = 16; o; o >>= 1) s = fmaxf(s, __shfl_xor(s, o));
  if ((threadIdx.x & 63) == 0) atomicMax(slot, __float_as_uint(s));
}
__device__ __forceinline__ float rowscale_ssx(const float* ssx, int tok) {
  const f32x4* sp = (const f32x4*)(ssx + (size_t)tok * 16); const f32x4 a = sp[0], b = sp[1], c = sp[2], d = sp[3];
  const float t = ((a[0] + a[1]) + (a[2] + a[3])) + ((b[0] + b[1]) + (b[2] + b[3])) + ((c[0] + c[1]) + (c[2] + c[3])) + ((d[0] + d[1]) + (d[2] + d[3]));
  return rsqrtf(t * (1.f / 1024.f) + EPS);
}

struct EpiIn {
  bf16_t* P; bf16_t* Vt; const float* ssx; float* ssa; const float *c32, *s32, *c64, *s64; unsigned* kmax;
  __device__ __forceinline__ void operator()(f32x16 (&acc)[2][2], int m0, int n0, int wr, int wc, int c, int h) const {
    const int g64 = (n0 >> 6) + wc;
    int vtb = -1, kslot = -1, ssl = -1; bool r32 = false, r64 = false;
    if (g64 <= 5) { if (g64 == 3) { r32 = true; kslot = 4; } else ssl = g64; }
    else if (g64 <= 13) { r32 = true; if (g64 >= 10) kslot = 5 + (g64 - 10); }
    else if (g64 <= 17) vtb = (g64 - 14) * 64;
    else if (g64 <= 23) { r64 = true; if (g64 >= 22) kslot = 9 + (g64 - 22); }
    else if (g64 <= 25) vtb = 256 + (g64 - 24) * 64;
    else if (g64 <= 33) { if (g64 >= 30) kslot = 11 + (g64 - 30); }
    else vtb = 384 + (g64 - 34) * 64;
#pragma unroll
    for (int mt = 0; mt < 2; ++mt) {
      const int tok = m0 + wr * 64 + mt * 32 + c;
      const float rr = rowscale_ssx(ssx, tok);
      f32x16 v0 = acc[mt][0] * rr, v1 = acc[mt][1] * rr;
      if (vtb >= 0) { store_vt(Vt, vtb, tok, v0, h); store_vt(Vt, vtb + 32, tok, v1, h); continue; }
      if (r32) { rope32(v0, c32, s32, tok, h); if (g64 != 3) rope32(v1, c32, s32, tok, h); }
      if (r64) rope64(v0, v1, c64, s64, tok, h);
      bf16_t* dst = P + (size_t)tok * NP + g64 * 64;
      store_plain(dst, v0, h); store_plain(dst + 32, v1, h);
      if (kslot >= 0) kmax_update(kmax + kslot, sumsq16(v0) + (g64 == 3 ? 0.f : sumsq16(v1)));
      if (ssl >= 0) { float s = sumsq16(v0) + sumsq16(v1); s += __shfl_xor(s, 32); if (h == 0) ssa[(size_t)tok * 8 + ssl] = s; }
    }
  }
};
struct EpiUq {
  bf16_t* Qa; const float* ssa; const float *c32, *s32;
  __device__ __forceinline__ void operator()(f32x16 (&acc)[2][2], int m0, int n0, int wr, int wc, int c, int h) const {
    const int g32 = ((n0 >> 6) + wc) * 2;
#pragma unroll
    for (int mt = 0; mt < 2; ++mt) {
      const int tok = m0 + wr * 64 + mt * 32 + c;
      const float* sp = ssa + (size_t)tok * 8; const float rr = rsqrtf((sp[0] + sp[1] + sp[2]) * (1.f / 192.f) + EPS);
#pragma unroll
      for (int nt = 0; nt < 2; ++nt) {
        f32x16 v = acc[mt][nt] * rr;
        if ((g32 + nt) % 3 == 2) rope32(v, c32, s32, tok, h);
        store_plain(Qa + (size_t)tok * 384 + (g32 + nt) * 32, v, h);
      }
    }
  }
};
struct EpiKv {
  bf16_t* KN; bf16_t* VtA; const float* ssa; unsigned* kmax;
  __device__ __forceinline__ void operator()(f32x16 (&acc)[2][2], int m0, int n0, int wr, int wc, int c, int h) const {
    const int g64 = (n0 >> 6) + wc;
#pragma unroll
    for (int mt = 0; mt < 2; ++mt) {
      const int tok = m0 + wr * 64 + mt * 32 + c;
      const float* sp = ssa + (size_t)tok * 8; const float rr = rsqrtf((sp[4] + sp[5]) * (1.f / 128.f) + EPS);
      const f32x16 v0 = acc[mt][0] * rr, v1 = acc[mt][1] * rr;
      if (g64 < 4) {
        bf16_t* dst = KN + (size_t)tok * 256 + g64 * 64; store_plain(dst, v0, h); store_plain(dst + 32, v1, h);
        kmax_update(kmax + g64, sumsq16(v0) + sumsq16(v1));
      } else { store_vt(VtA, (g64 - 4) * 64, tok, v0, h); store_vt(VtA, (g64 - 4) * 64 + 32, tok, v1, h); }
    }
  }
};
struct EpiRes {
  const float* xold; float* xnew; bf16_t* xb; float* ssx;
  __device__ __forceinline__ void operator()(f32x16 (&acc)[2][2], int m0, int n0, int wr, int wc, int c, int h) const {
#pragma unroll
    for (int mt = 0; mt < 2; ++mt) {
      const int tok = m0 + wr * 64 + mt * 32 + c; float s = 0.f;
#pragma unroll
      for (int nt = 0; nt < 2; ++nt)
#pragma unroll
        for (int g = 0; g < 4; ++g) {
          const size_t off = (size_t)tok * 1024 + n0 + wc * 64 + nt * 32 + 8 * g + 4 * h;
          f32x4 xo = *(const f32x4*)(xold + off);
#pragma unroll
          for (int i = 0; i < 4; ++i) { xo[i] += acc[mt][nt][4 * g + i]; s += xo[i] * xo[i]; }
          *(f32x4*)(xnew + off) = xo;
          u32x2 w; w.x = pk2(xo[0], xo[1]); w.y = pk2(xo[2], xo[3]); *(u32x2*)(xb + off) = w;
        }
      s += __shfl_xor(s, 32);
      if (h == 0) ssx[(size_t)tok * 16 + (n0 >> 7) * 2 + wc] = s;
    }
  }
};
struct EpiUp {
  bf16_t* H; const float* ssx;
  __device__ __forceinline__ void operator()(f32x16 (&acc)[2][2], int m0, int n0, int wr, int wc, int c, int h) const {
#pragma unroll
    for (int mt = 0; mt < 2; ++mt) {
      const int tok = m0 + wr * 64 + mt * 32 + c; const float rr = rowscale_ssx(ssx, tok);
#pragma unroll
      for (int nt = 0; nt < 2; ++nt) {
        f32x16 v;
#pragma unroll
        for (int r = 0; r < 16; ++r) { const float t = fmaxf(acc[mt][nt][r] * rr, 0.f); v[r] = t * t; }
        store_plain(H + (size_t)tok * 4096 + n0 + wc * 64 + nt * 32, v, h);
      }
    }
  }
};

struct AttnArgs { const bf16_t *P, *Vt, *Qa, *KN, *VtA; bf16_t* mix; float* ssm; const unsigned* kmax;
  const float *lq1, *lk1, *lq2, *lk2, *subln, *sinks, *rpb; float lam_init; };

constexpr int ABUF = 22528, AKOFF = 13312, ATAB = 2 * ABUF;

template <int MODE>
__device__ __forceinline__ void attn_item(char* lds, const AttnArgs& a, int item) {
  constexpr int KSTR = MODE == 0 ? 208 : 144;
  constexpr int NKS = MODE == 0 ? 6 : (MODE == 1 ? 2 : 4);
  constexpr int NKP = MODE == 0 ? 3 : 2;
  constexpr int NQT = MODE == 1 ? 2 : 1;
  int tid_ = threadIdx.x; asm volatile("" : "+v"(tid_));
  const int tid = tid_, lane = tid & 63, wid = tid >> 6, c = lane & 31, h = lane >> 5;
  int hd, sb, se; int qtok[NQT]; const bf16_t* qptr[NQT]; const bf16_t* kbase; const bf16_t* vbase; int k2slot;
  int narow = 0, nars = 0, nahalf = 0, kvh = 0;
  if constexpr (MODE == 0) { hd = item & 3; const int qb = item >> 2; sb = 0; se = 256;
    qtok[0] = qb * 128 + wid * 32 + c; qptr[0] = a.Qa + (size_t)qtok[0] * 384 + hd * 96;
    kbase = a.KN + hd * 64; vbase = a.VtA + (size_t)hd * 64 * VLD; k2slot = hd; }
  else if constexpr (MODE == 1) { hd = item & 3; const int qb = item >> 2; sb = 0; se = 256;
#pragma unroll
    for (int qt = 0; qt < 2; ++qt) { qtok[qt] = qb * 128 + wid * 32 + c; qptr[qt] = a.P + (size_t)qtok[qt] * NP + 384 + hd * 64 + qt * 32; }
    kbase = a.P + 640 + hd * 64; vbase = a.Vt + (size_t)hd * 64 * VLD; k2slot = 5 + hd; }
  else if constexpr (MODE == 2) { hd = item & 3; kvh = hd >> 1; const int qb = item >> 2; sb = max(0, 2 * qb - 2); se = min(256, 2 * qb + 4);
    qtok[0] = qb * 128 + wid * 32 + c; qptr[0] = a.P + (size_t)qtok[0] * NP + 1152 + hd * 64;
    kbase = a.P + 1408 + kvh * 64; vbase = a.Vt + (size_t)(256 + kvh * 64) * VLD; k2slot = 9 + kvh; }
  else { hd = item & 3; const int rg = item >> 2; narow = rg * 2 + (wid >> 1); nahalf = wid & 1; nars = min(max(narow - 4, 0), 248);
    sb = min(max(rg * 2 - 4, 0), 248); se = min(max(rg * 2 - 3, 0), 248) + 8;
    qtok[0] = narow * 64 + nahalf * 32 + c; qptr[0] = a.P + (size_t)qtok[0] * NP + 1664 + hd * 64;
    kbase = a.P + 1920 + hd * 64; vbase = a.Vt + (size_t)(384 + hd * 64) * VLD; k2slot = 11 + hd; }

  bf16x8 qf[NQT][NKS]; float q2max = 0.f;
#pragma unroll
  for (int qt = 0; qt < NQT; ++qt) { float s = 0.f;
#pragma unroll
    for (int ks = 0; ks < NKS; ++ks) { qf[qt][ks] = *(const bf16x8*)(qptr[qt] + ks * 16 + h * 8);
#pragma unroll
      for (int j = 0; j < 8; ++j) { const float f = bf2f((unsigned short)qf[qt][ks][j]); s += f * f; } }
    s += __shfl_xor(s, 32); q2max = fmaxf(q2max, s); }
#pragma unroll
  for (int o = 16; o; o >>= 1) q2max = fmaxf(q2max, __shfl_xor(q2max, o));
  float k2 = __uint_as_float(a.kmax[k2slot]); if (MODE == 0) k2 += __uint_as_float(a.kmax[4]);
  float cb = sqrtf(q2max * k2) * 1.01f + 0.01f;
  if (MODE == 3) {
    float* tab = (float*)(lds + ATAB); const float* rp = a.rpb + hd * 465; float bm = 0.f;
    for (int i = lane; i < 465; i += 64) bm = fmaxf(bm, fabsf(rp[i]));
#pragma unroll
    for (int o = 32; o; o >>= 1) bm = fmaxf(bm, __shfl_xor(bm, o));
    cb += bm * LOG2E;
    for (int i = tid; i < 480; i += 256) { const int dr = i >> 5, dc = i & 31; tab[i] = dc < 31 ? rp[dr * 31 + dc] * LOG2E : 0.f; }
  }
  f32x16 negc;
#pragma unroll
  for (int r = 0; r < 16; ++r) negc[r] = -cb;

  f32x16 O[NQT][2]; float l[NQT];
#pragma unroll
  for (int i = 0; i < NQT; ++i) l[i] = 0.f;
#pragma unroll
  for (int i = 0; i < NQT; ++i)
#pragma unroll
    for (int j = 0; j < 2; ++j)
#pragma unroll
      for (int r = 0; r < 16; ++r) O[i][j][r] = 0.f;

  u32x4 rk[NKP], rv[2];
  auto gload = [&](int st) {
    const int kb = st * 64;
#pragma unroll
    for (int i = 0; i < NKP; ++i) { const int p = tid + 256 * i;
      if (MODE == 0) {
        if (i < 2) { const int row = p >> 3, ch = p & 7; rk[i] = *(const u32x4*)(kbase + (size_t)(kb + row) * 256 + ch * 8); }
        else { const int row = tid >> 2, ch = tid & 3; rk[i] = *(const u32x4*)(a.P + (size_t)(kb + row) * NP + 192 + ch * 8); } }
      else { const int row = p >> 3, ch = p & 7; rk[i] = *(const u32x4*)(kbase + (size_t)(kb + row) * NP + ch * 8); } }
#pragma unroll
    for (int i = 0; i < 2; ++i) { const int p = tid + 256 * i, dv = p >> 3, ch = p & 7; rv[i] = *(const u32x4*)(vbase + (size_t)dv * VLD + kb + ch * 8); }
  };
  auto lstore = [&](int buf) {
    char* b = lds + buf * ABUF;
#pragma unroll
    for (int i = 0; i < NKP; ++i) { const int p = tid + 256 * i;
      if (MODE == 0) { if (i < 2) { const int row = p >> 3, ch = p & 7; *(u32x4*)(b + row * 208 + ch * 16) = rk[i]; } else { const int row = tid >> 2, ch = tid & 3; *(u32x4*)(b + row * 208 + 128 + ch * 16) = rk[i]; } }
      else { const int row = p >> 3, ch = p & 7; *(u32x4*)(b + row * 144 + ch * 16) = rk[i]; } }
#pragma unroll
    for (int i = 0; i < 2; ++i) { const int p = tid + 256 * i, dv = p >> 3, ch = p & 7; *(u32x4*)(b + AKOFF + dv * 144 + ch * 16) = rv[i]; }
  };

  gload(sb); lstore(0); __syncthreads();
  for (int st = sb; st < se; ++st) {
    const int buf = (st - sb) & 1;
    if (st + 1 < se) gload(st + 1);
    __builtin_amdgcn_sched_barrier(0);
    const bool active = MODE != 3 || (st >= nars && st < nars + 8);
    if (active) {
      const char* Kb = lds + buf * ABUF; const char* Vb = Kb + AKOFF;
#pragma unroll
      for (int kt2 = 0; kt2 < 2; ++kt2) {
        f32x16 sc[NQT];
#pragma unroll
        for (int qt = 0; qt < NQT; ++qt) sc[qt] = negc;
        if (MODE != 1) {
#pragma unroll
          for (int ks = 0; ks < NKS; ++ks) { const bf16x8 kf = *(const bf16x8*)(Kb + (kt2 * 32 + c) * KSTR + ks * 32 + h * 16);
#pragma unroll
            for (int qt = 0; qt < NQT; ++qt) sc[qt] = MFMA(kf, qf[qt][ks], sc[qt]); }
        } else {
#pragma unroll
          for (int qt = 0; qt < NQT; ++qt)
#pragma unroll
            for (int ks = 0; ks < NKS; ++ks) { const bf16x8 kf = *(const bf16x8*)(Kb + (kt2 * 32 + c) * KSTR + qt * 64 + ks * 32 + h * 16);
              sc[qt] = MFMA(kf, qf[qt][ks], sc[qt]); }
        }
        if (MODE == 2) {
          const int kb0 = st * 64 + kt2 * 32 - qtok[0];
#pragma unroll
          for (int i = 0; i < 16; ++i) { const int d = kb0 + crow(i, h); const bool ok = d <= 128 && d >= -128;
            sc[0][i] = ok ? sc[0][i] : -INFINITY; }
        }
        if (MODE == 3) {
          const float* trow = (const float*)(lds + ATAB) + (st - narow + 7) * 32;
#pragma unroll
          for (int qt = 0; qt < NQT; ++qt) { const int w = nahalf * 32 + c, cs = min(max(w - 8, 0), 48);
#pragma unroll
            for (int i = 0; i < 16; ++i) { const int kc = kt2 * 32 + crow(i, h); const bool ok = kc >= cs && kc < cs + 16;
              const float bv = trow[(kc - w + 15) & 31]; sc[qt][i] = ok ? sc[qt][i] + bv : -INFINITY; } }
        }
        bf16x8 pf[NQT][2];
#pragma unroll
        for (int qt = 0; qt < NQT; ++qt) {
          float p[16];
#pragma unroll
          for (int i = 0; i < 16; ++i) { p[i] = __builtin_amdgcn_exp2f(sc[qt][i]); l[qt] += p[i]; }
#pragma unroll
          for (int s2 = 0; s2 < 2; ++s2) { u32x4 w; w.x = pk2(p[8 * s2], p[8 * s2 + 1]); w.y = pk2(p[8 * s2 + 2], p[8 * s2 + 3]);
            w.z = pk2(p[8 * s2 + 4], p[8 * s2 + 5]); w.w = pk2(p[8 * s2 + 6], p[8 * s2 + 7]); pf[qt][s2] = __builtin_bit_cast(bf16x8, w); }
        }
#pragma unroll
        for (int dt = 0; dt < 2; ++dt)
#pragma unroll
          for (int s2 = 0; s2 < 2; ++s2) { const bf16x8 vf = *(const bf16x8*)(Vb + (dt * 32 + c) * 144 + kt2 * 64 + s2 * 32 + h * 16);
#pragma unroll
            for (int qt = 0; qt < NQT; ++qt) O[qt][dt] = MFMA(vf, pf[qt][s2], O[qt][dt]); }
      }
    }
    __builtin_amdgcn_sched_barrier(0);
    if (st + 1 < se) lstore(buf ^ 1);
    __syncthreads();
  }

#pragma unroll
  for (int qt = 0; qt < NQT; ++qt) l[qt] += __shfl_xor(l[qt], 32);
  if (MODE == 1) {
    float pa = 0.f, pb = 0.f;
    if (lane < 32) { pa = a.lq1[lane] * a.lk1[lane]; pb = a.lq2[lane] * a.lk2[lane]; }
#pragma unroll
    for (int o = 32; o; o >>= 1) { pa += __shfl_xor(pa, o); pb += __shfl_xor(pb, o); }
    const float lam = expf(pa) - expf(pb) + a.lam_init;
    const float i0 = 1.f / l[0], i1 = lam / l[NQT - 1];
    f32x16 o[2]; float ss = 0.f;
#pragma unroll
    for (int dt = 0; dt < 2; ++dt)
#pragma unroll
      for (int r = 0; r < 16; ++r) { o[dt][r] = O[0][dt][r] * i0 - O[NQT - 1][dt][r] * i1; ss += o[dt][r] * o[dt][r]; }
    ss += __shfl_xor(ss, 32);
    const float rn = rsqrtf(ss * (1.f / 64.f) + EPS) * (1.f - a.lam_init);
#pragma unroll
    for (int dt = 0; dt < 2; ++dt) {
#pragma unroll
      for (int g = 0; g < 4; ++g) { const f32x4 gg = *(const f32x4*)(a.subln + dt * 32 + 8 * g + 4 * h);
#pragma unroll
        for (int i = 0; i < 4; ++i) o[dt][4 * g + i] *= rn * gg[i]; }
      store_plain(a.mix + (size_t)qtok[0] * 1024 + 256 + hd * 64 + dt * 32, o[dt], h);
    }
  } else {
#pragma unroll
    for (int qt = 0; qt < NQT; ++qt) {
      int head, colb, seg;
      if (MODE == 0) { head = hd; colb = hd * 64; seg = 0; }
      else if (MODE == 2) { head = hd; colb = 512 + head * 64; seg = 1; l[qt] += __builtin_amdgcn_exp2f(a.sinks[head] * LOG2E - cb); }
      else { head = hd; colb = 768 + hd * 64; seg = 2; }
      const float inv = 1.f / l[qt]; float ss = 0.f;
#pragma unroll
      for (int dt = 0; dt < 2; ++dt) { f32x16 o = O[qt][dt] * inv; ss += sumsq16(o); store_plain(a.mix + (size_t)qtok[qt] * 1024 + colb + dt * 32, o, h); }
      ss += __shfl_xor(ss, 32);
      if (h == 0) a.ssm[(size_t)(seg * 4 + head) * S + qtok[qt]] = ss;
    }
  }
}


template <bool B> struct BoolC { static constexpr bool value = B; };
#define SGB(mask, n) __builtin_amdgcn_sched_group_barrier((mask), (n), 0)
template <int MODE>
__device__ __forceinline__ bool attn_pipe(char* lds, const AttnArgs& a, int item) {
  constexpr int KSTR = MODE == 0 ? 208 : 144;
  constexpr int NKS = MODE == 0 ? 6 : 2;
  constexpr int NKP = MODE == 0 ? 3 : 2;
  constexpr int NST = 256;
  constexpr int NQT = MODE == 0 ? 1 : 2;
  int tid_ = threadIdx.x; asm volatile("" : "+v"(tid_));
  const int tid = tid_, lane = tid & 63, wid = tid >> 6, c = lane & 31, h = lane >> 5;
  const int hd = item & 3, qb = item >> 2;
  int qtok[NQT]; const bf16_t* qptr[NQT]; const bf16_t* kbase; const bf16_t* vbase; int k2slot;
  if constexpr (MODE == 0) {
    qtok[0] = qb * 128 + wid * 32 + c; qptr[0] = a.Qa + (size_t)qtok[0] * 384 + hd * 96;
    kbase = a.KN + hd * 64; vbase = a.VtA + (size_t)hd * 64 * VLD; k2slot = hd;
  } else {
#pragma unroll
    for (int qt = 0; qt < 2; ++qt) { qtok[qt] = qb * 128 + wid * 32 + c; qptr[qt] = a.P + (size_t)qtok[qt] * NP + 384 + hd * 64 + qt * 32; }
    kbase = a.P + 640 + hd * 64; vbase = a.Vt + (size_t)hd * 64 * VLD; k2slot = 5 + hd;
  }
  bf16x8 qf[NQT][NKS]; float q2max = 0.f;
#pragma unroll
  for (int qt = 0; qt < NQT; ++qt) { float s = 0.f;
#pragma unroll
    for (int ks = 0; ks < NKS; ++ks) { qf[qt][ks] = *(const bf16x8*)(qptr[qt] + ks * 16 + h * 8);
#pragma unroll
      for (int j = 0; j < 8; ++j) { const float f = bf2f((unsigned short)qf[qt][ks][j]); s += f * f; } }
    s += __shfl_xor(s, 32); q2max = fmaxf(q2max, s); }
#pragma unroll
  for (int o = 16; o; o >>= 1) q2max = fmaxf(q2max, __shfl_xor(q2max, o));
  float k2 = __uint_as_float(a.kmax[k2slot]); if (MODE == 0) k2 += __uint_as_float(a.kmax[4]);
  const float cb = sqrtf(q2max * k2) * 1.01f + 0.01f;
  { volatile int* flag = (volatile int*)(lds + 3 * ABUF);
    if (tid == 0) *flag = 0;
    __syncthreads();
    if (cb > 96.f && lane == 0) *flag = 1;
    __syncthreads();
    if (*flag) return false; }
  f32x16 O[NQT][2]; float l[NQT];
#pragma unroll
  for (int i = 0; i < NQT; ++i) { l[i] = 0.f;
#pragma unroll
    for (int j = 0; j < 2; ++j)
#pragma unroll
      for (int r = 0; r < 16; ++r) O[i][j][r] = 0.f; }

  u32x4 rk[NKP], rv[2];
  auto gload = [&](int st) {
    const int kb = st * 64;
#pragma unroll
    for (int i = 0; i < NKP; ++i) { const int p = tid + 256 * i;
      if (MODE == 0) {
        if (i < 2) { const int row = p >> 3, ch = p & 7; rk[i] = *(const u32x4*)(kbase + (size_t)(kb + row) * 256 + ch * 8); }
        else { const int row = tid >> 2, ch = tid & 3; rk[i] = *(const u32x4*)(a.P + (size_t)(kb + row) * NP + 192 + ch * 8); } }
      else { const int row = p >> 3, ch = p & 7; rk[i] = *(const u32x4*)(kbase + (size_t)(kb + row) * NP + ch * 8); } }
#pragma unroll
    for (int i = 0; i < 2; ++i) { const int p = tid + 256 * i, dv = p >> 3, ch = p & 7; rv[i] = *(const u32x4*)(vbase + (size_t)dv * VLD + kb + ch * 8); }
  };
  auto lstore = [&](int buf) {
    char* b = lds + buf * ABUF;
#pragma unroll
    for (int i = 0; i < NKP; ++i) { const int p = tid + 256 * i;
      if (MODE == 0) { if (i < 2) { const int row = p >> 3, ch = p & 7; *(u32x4*)(b + row * 208 + ch * 16) = rk[i]; } else { const int row = tid >> 2, ch = tid & 3; *(u32x4*)(b + row * 208 + 128 + ch * 16) = rk[i]; } }
      else { const int row = p >> 3, ch = p & 7; *(u32x4*)(b + row * 144 + ch * 16) = rk[i]; } }
#pragma unroll
    for (int i = 0; i < 2; ++i) { const int p = tid + 256 * i, dv = p >> 3, ch = p & 7; *(u32x4*)(b + AKOFF + dv * 144 + ch * 16) = rv[i]; }
  };
  const int koff = c * KSTR + h * 16, voff = AKOFF + c * 144 + h * 16;
#define QK_UNIT(dst, Kb, u) { _Pragma("unroll") for (int r_ = 0; r_ < 16; ++r_) dst[r_] = 0.f; \
    _Pragma("unroll") for (int ks = 0; ks < NKS; ++ks) { \
      const bf16x8 kf = *(const bf16x8*)((Kb) + koff + ((u) / NQT) * 32 * KSTR + (MODE == 1 ? ((u) % NQT) * 64 : 0) + ks * 32); \
      dst = MFMA(kf, qf[(u) % NQT][ks], dst); } }
#define EXP_UNIT(src, u, pf) { float p_[16]; \
    _Pragma("unroll") for (int i = 0; i < 16; ++i) { p_[i] = __builtin_amdgcn_exp2f(src[i]); l[(u) % NQT] += p_[i]; } \
    _Pragma("unroll") for (int s2 = 0; s2 < 2; ++s2) { u32x4 w_; w_.x = pk2(p_[8 * s2], p_[8 * s2 + 1]); w_.y = pk2(p_[8 * s2 + 2], p_[8 * s2 + 3]); \
      w_.z = pk2(p_[8 * s2 + 4], p_[8 * s2 + 5]); w_.w = pk2(p_[8 * s2 + 6], p_[8 * s2 + 7]); pf[s2] = __builtin_bit_cast(bf16x8, w_); } }
#define PV_UNIT(Vb, u, pf) { \
    _Pragma("unroll") for (int dt = 0; dt < 2; ++dt) \
    _Pragma("unroll") for (int s2 = 0; s2 < 2; ++s2) { \
      const bf16x8 vf = *(const bf16x8*)((Vb) + voff + dt * 32 * 144 + ((u) / NQT) * 64 + s2 * 32); \
      O[(u) % NQT][dt] = MFMA(vf, pf[s2], O[(u) % NQT][dt]); } }
#define SCHED_ITER(NM) { SGB(0x100, 2); \
    _Pragma("unroll") for (int i_ = 0; i_ < (NM); ++i_) { SGB(0x008, 1); SGB(0x002, (40 + (NM) - 1) / (NM)); if (i_ + 2 < (NM)) SGB(0x100, 1); } }

  gload(0); lstore(0); gload(1); lstore(1); __syncthreads();
  f32x16 sc, sn;
  QK_UNIT(sc, lds, 0);
  int cur = 0;
  for (int st = 0; st < NST; ++st) {
    const int nxt = cur == 2 ? 0 : cur + 1, wr = nxt == 2 ? 0 : nxt + 1;
    if (st + 2 < NST) gload(st + 2);
    const char* Kc = lds + cur * ABUF; const char* Kn = lds + nxt * ABUF;
    bf16x8 pa[2], pb[2];
    __builtin_amdgcn_sched_barrier(0);
    if constexpr (NQT == 2) {
      QK_UNIT(sn, Kc, 1); EXP_UNIT(sc, 0, pa); SCHED_ITER(NKS); sc = sn;
      __builtin_amdgcn_sched_barrier(0);
      QK_UNIT(sn, Kc, 2); EXP_UNIT(sc, 1, pb); PV_UNIT(Kc, 0, pa); SCHED_ITER(NKS + 4); sc = sn;
      __builtin_amdgcn_sched_barrier(0);
      QK_UNIT(sn, Kc, 3); EXP_UNIT(sc, 2, pa); PV_UNIT(Kc, 1, pb); SCHED_ITER(NKS + 4); sc = sn;
      __builtin_amdgcn_sched_barrier(0);
      QK_UNIT(sn, Kn, 0); EXP_UNIT(sc, 3, pb); PV_UNIT(Kc, 2, pa); SCHED_ITER(NKS + 4); sc = sn;
      __builtin_amdgcn_sched_barrier(0);
      PV_UNIT(Kc, 3, pb);
    } else {
      QK_UNIT(sn, Kc, 1); EXP_UNIT(sc, 0, pa); SCHED_ITER(NKS); sc = sn;
      __builtin_amdgcn_sched_barrier(0);
      QK_UNIT(sn, Kn, 0); EXP_UNIT(sc, 1, pb); PV_UNIT(Kc, 0, pa); SCHED_ITER(NKS + 4); sc = sn;
      __builtin_amdgcn_sched_barrier(0);
      PV_UNIT(Kc, 1, pb);
    }
    __builtin_amdgcn_sched_barrier(0);
    if (st + 2 < NST) lstore(wr);
    __syncthreads();
    cur = nxt;
  }
#undef QK_UNIT
#undef EXP_UNIT
#undef PV_UNIT
#undef SCHED_ITER

#pragma unroll
  for (int qt = 0; qt < NQT; ++qt) l[qt] += __shfl_xor(l[qt], 32);
  if constexpr (MODE == 1) {
    float pa = 0.f, pb = 0.f;
    if (lane < 32) { pa = a.lq1[lane] * a.lk1[lane]; pb = a.lq2[lane] * a.lk2[lane]; }
#pragma unroll
    for (int o = 32; o; o >>= 1) { pa += __shfl_xor(pa, o); pb += __shfl_xor(pb, o); }
    const float lam = expf(pa) - expf(pb) + a.lam_init;
    const float i0 = 1.f / l[0], i1 = lam / l[1];
    f32x16 o[2]; float ss = 0.f;
#pragma unroll
    for (int dt = 0; dt < 2; ++dt)
#pragma unroll
      for (int r = 0; r < 16; ++r) { o[dt][r] = O[0][dt][r] * i0 - O[1][dt][r] * i1; ss += o[dt][r] * o[dt][r]; }
    ss += __shfl_xor(ss, 32);
    const float rn = rsqrtf(ss * (1.f / 64.f) + EPS) * (1.f - a.lam_init);
#pragma unroll
    for (int dt = 0; dt < 2; ++dt) {
#pragma unroll
      for (int g = 0; g < 4; ++g) { const f32x4 gg = *(const f32x4*)(a.subln + dt * 32 + 8 * g + 4 * h);
#pragma unroll
        for (int i = 0; i < 4; ++i) o[dt][4 * g + i] *= rn * gg[i]; }
      store_plain(a.mix + (size_t)qtok[0] * 1024 + 256 + hd * 64 + dt * 32, o[dt], h);
    }
  } else {
#pragma unroll
    for (int qt = 0; qt < NQT; ++qt) {
      const float inv = 1.f / l[qt]; float ss = 0.f;
#pragma unroll
      for (int dt = 0; dt < 2; ++dt) { f32x16 o = O[qt][dt] * inv; ss += sumsq16(o); store_plain(a.mix + (size_t)qtok[qt] * 1024 + hd * 64 + dt * 32, o, h); }
      ss += __shfl_xor(ss, 32);
      if (h == 0) a.ssm[(size_t)hd * S + qtok[qt]] = ss;
    }
  }
  return true;
}

template <class F>
__device__ __forceinline__ void conv_tile(float* tl, bf16_t* out, int K, int n0, int k0, const F& f) {
  int tid_ = threadIdx.x; asm volatile("" : "+v"(tid_));
  const int tid = tid_, tx = tid & 63, ty = tid >> 6;
#pragma unroll 4
  for (int i = 0; i < 16; ++i) { const int k = ty + 4 * i; tl[k * 65 + tx] = f(k0 + k, n0 + tx); }
  __syncthreads();
  const int kx2 = (tid & 31) * 2, ny = tid >> 5;
#pragma unroll 4
  for (int i = 0; i < 8; ++i) { const int n = ny + 8 * i; *(unsigned*)(out + (size_t)(n0 + n) * K + k0 + kx2) = pk2(tl[kx2 * 65 + n], tl[(kx2 + 1) * 65 + n]); }
  __syncthreads();
}

__device__ void conv_layer(char* lds, const Params& p, int l) {
  float* tl = (float*)lds; char* ws = p.ws;
  const float* w_in = p.w_in + (size_t)l * 1024 * 2400; const float* g1 = p.norm1_g + l * 1024;
  const float* w_out = p.w_out + (size_t)l * 1024 * 1024; const float* gm = p.g_mla + l * 256; const float* gs = p.g_swa + l * 256; const float* gn = p.g_na + l * 256;
  const float* w_up = p.w_up + (size_t)l * 1024 * 4096; const float* g2 = p.norm2_g + l * 1024;
  const float* w_dn = p.w_down + (size_t)l * 4096 * 1024;
  const float* w_uq = p.w_uq + (size_t)l * 192 * 384; const float* qg = p.qn_g + l * 192;
  const float* w_uk = p.w_uk + (size_t)l * 128 * 256; const float* w_uv = p.w_uv + (size_t)l * 128 * 256; const float* kg = p.kvn_g + l * 128;
  const float sB = 0.17677669529663687f * LOG2E, sC = 0.125f * LOG2E, sA = 0.10206207261596577f * LOG2E;
  for (int t = bid_(); t < 2946; t += gridDim.x) {
    if (t < 608) { const int nt = t >> 4, kt = t & 15;
      conv_tile(tl, (bf16_t*)(ws + OFF_WIN), 1024, nt * 64, kt * 64, [&](int k, int n) -> float {
        int src; if (n < 192) src = n; else if (n < 224) src = 320 + n - 192; else if (n < 256) src = -1; else if (n < 384) src = 192 + n - 256; else src = 352 + n - 384;
        if (src < 0) return 0.f;
        float sc = 1.f; if (n >= 384 && n < 640) sc = sB; else if ((n >= 1152 && n < 1408) || (n >= 1664 && n < 1920)) sc = sC;
        return w_in[(size_t)k * 2400 + src] * g1[k] * sc; });
    } else if (t < 864) { const int u = t - 608, nt = u >> 4, kt = u & 15;
      conv_tile(tl, (bf16_t*)(ws + OFF_WOUT), 1024, nt * 64, kt * 64, [&](int k, int n) -> float {
        const float g = k < 256 ? gm[k] : (k < 512 ? 1.f : (k < 768 ? gs[k - 512] : gn[k - 768]));
        return w_out[(size_t)k * 1024 + n] * g; });
    } else if (t < 1888) { const int u = t - 864, nt = u >> 4, kt = u & 15;
      conv_tile(tl, (bf16_t*)(ws + OFF_WUP), 1024, nt * 64, kt * 64, [&](int k, int n) -> float { return w_up[(size_t)k * 4096 + n] * g2[k]; });
    } else if (t < 2912) { const int u = t - 1888, nt = u >> 6, kt = u & 63;
      conv_tile(tl, (bf16_t*)(ws + OFF_WDN), 4096, nt * 64, kt * 64, [&](int k, int n) -> float { return w_dn[(size_t)k * 1024 + n]; });
    } else if (t < 2930) { const int u = t - 2912, nt = u / 3, kt = u % 3;
      conv_tile(tl, (bf16_t*)(ws + OFF_WUQ), 192, nt * 64, kt * 64, [&](int k, int n) -> float { return w_uq[(size_t)k * 384 + n] * qg[k] * sA; });
    } else { const int u = t - 2930, nt = u >> 1, kt = u & 1;
      conv_tile(tl, (bf16_t*)(ws + OFF_WKV), 128, nt * 64, kt * 64, [&](int k, int n) -> float {
        return (n < 256 ? w_uk[(size_t)k * 256 + n] : w_uv[(size_t)k * 256 + n - 256]) * kg[k]; });
    }
  }
}

__device__ __forceinline__ void gbar(unsigned* base) {
  __syncthreads();
  if (threadIdx.x == 0) {
    __builtin_amdgcn_fence(__ATOMIC_RELEASE, "agent");
    const unsigned g = blockIdx.x & 15u, ng = gridDim.x >> 4;
    unsigned* cnt = base + g * 32; unsigned* root = base + 16 * 32; unsigned* gen = base + (17 + g) * 32;
    const unsigned old = __hip_atomic_load(gen, __ATOMIC_RELAXED, __HIP_MEMORY_SCOPE_AGENT);
    if (__hip_atomic_fetch_add(cnt, 1u, __ATOMIC_RELAXED, __HIP_MEMORY_SCOPE_AGENT) == ng - 1u) {
      __hip_atomic_store(cnt, 0u, __ATOMIC_RELAXED, __HIP_MEMORY_SCOPE_AGENT);
      __builtin_amdgcn_fence(__ATOMIC_RELEASE, "agent");
      if (__hip_atomic_fetch_add(root, 1u, __ATOMIC_RELAXED, __HIP_MEMORY_SCOPE_AGENT) == 15u) {
        __hip_atomic_store(root, 0u, __ATOMIC_RELAXED, __HIP_MEMORY_SCOPE_AGENT);
        __builtin_amdgcn_fence(__ATOMIC_RELEASE, "agent");
        for (unsigned k = 0; k < 16; ++k) __hip_atomic_fetch_add(base + (17 + k) * 32, 1u, __ATOMIC_RELAXED, __HIP_MEMORY_SCOPE_AGENT);
      }
    }
    while (__hip_atomic_load(gen, __ATOMIC_RELAXED, __HIP_MEMORY_SCOPE_AGENT) == old) __builtin_amdgcn_s_sleep(2);
    __builtin_amdgcn_fence(__ATOMIC_ACQUIRE, "agent");
  }
  __syncthreads();
}

__device__ __forceinline__ void sincos_acc(float ang, float& sn, float& cs) {
  const double a = (double)ang; const double n = rint(a * 0.15915494309189535);
  const double r = a - n * 6.283185307179586476925; const double r2 = r * r;
  double s = -1.0 / 51090942171709440000.0;
  s = s * r2 + 1.0 / 121645100408832000.0; s = s * r2 - 1.0 / 355687428096000.0; s = s * r2 + 1.0 / 1307674368000.0; s = s * r2 - 1.0 / 6227020800.0;
  s = s * r2 + 1.0 / 39916800.0; s = s * r2 - 1.0 / 362880.0; s = s * r2 + 1.0 / 5040.0; s = s * r2 - 1.0 / 120.0; s = s * r2 + 1.0 / 6.0; s = s * r2 - 1.0; s = -s * r;
  double c = 1.0 / 1124000727777607680000.0;
  c = c * r2 - 1.0 / 2432902008176640000.0; c = c * r2 + 1.0 / 6402373705728000.0; c = c * r2 - 1.0 / 20922789888000.0; c = c * r2 + 1.0 / 87178291200.0;
  c = c * r2 - 1.0 / 479001600.0; c = c * r2 + 1.0 / 3628800.0; c = c * r2 - 1.0 / 40320.0; c = c * r2 + 1.0 / 720.0; c = c * r2 - 1.0 / 24.0; c = c * r2 + 0.5; c = 1.0 - c * r2;
  sn = (float)s; cs = (float)c;
}

__global__ void __launch_bounds__(256, 2) mega(Params p) {
  cg::grid_group grid = cg::this_grid();
  __shared__ __attribute__((aligned(16))) char lds[73728];
  __shared__ int s_item; __shared__ int s_q[2];
#ifdef PROBE_SEL
  __shared__ unsigned long long s_t[10];
  if (threadIdx.x == 0) { for (int i = 0; i < 9; ++i) s_t[i] = 0; s_t[9] = __builtin_amdgcn_s_memrealtime(); }
#define TSTAMP(k) { if (blockIdx.x == 0 && threadIdx.x == 0) { const unsigned long long t_ = __builtin_amdgcn_s_memrealtime(); s_t[k] += t_ - s_t[9]; s_t[9] = t_; } }
#else
#define TSTAMP(k)
#endif
#define GBAR { size_t wz2_ = 0; asm volatile("" : "+s"(wz2_)); gbar((unsigned*)(p.ws + OFF_CTRL + wz2_) + 1024); }
#define WSPTRS \
  size_t wz_ = 0; asm volatile("" : "+s"(wz_)); char* ws = p.ws + wz_; \
  bf16_t* XB = (bf16_t*)(ws + OFF_XB); bf16_t* MIX = (bf16_t*)(ws + OFF_MIX); bf16_t* P = (bf16_t*)(ws + OFF_P); bf16_t* VT = (bf16_t*)(ws + OFF_VT); \
  bf16_t* QA = (bf16_t*)(ws + OFF_QA); bf16_t* KN = (bf16_t*)(ws + OFF_KN); bf16_t* VTA = (bf16_t*)(ws + OFF_VTA); bf16_t* H = (bf16_t*)(ws + OFF_H); \
  float* C32 = (float*)(ws + OFF_TAB); float* S32 = C32 + S * 16; float* C64 = S32 + S * 16; float* S64 = C64 + S * 32; \
  float* SSX = (float*)(ws + OFF_SSX); float* SSA = (float*)(ws + OFF_SSA); float* SSM = (float*)(ws + OFF_SSM); \
  unsigned* CTRL = (unsigned*)(ws + OFF_CTRL); unsigned* kmax = CTRL + 16 + 16 * l; \
  (void)XB; (void)MIX; (void)P; (void)VT; (void)QA; (void)KN; (void)VTA; (void)H; (void)C32; (void)S32; (void)C64; (void)S64; (void)SSX; (void)SSA; (void)SSM; (void)CTRL; (void)kmax;

  { const int l = 0; WSPTRS
  int tid_ = threadIdx.x; asm volatile("" : "+v"(tid_));
  const int tid = tid_, lane = tid & 63, wid = tid >> 6, gw = bid_() * 4 + wid, nw = gridDim.x * 4;
  if (blockIdx.x == 0) { for (int i = tid; i < 4096; i += 256) CTRL[i] = 0u; }
  for (int row = gw; row < S; row += nw) {
    const f32x4* xr = (const f32x4*)(p.x + (size_t)row * 1024); float s = 0.f;
#pragma unroll
    for (int i = 0; i < 4; ++i) { const f32x4 v = xr[lane + 64 * i]; s += v[0] * v[0] + v[1] * v[1] + v[2] * v[2] + v[3] * v[3];
      u32x2 w; w.x = pk2(v[0], v[1]); w.y = pk2(v[2], v[3]); *(u32x2*)(XB + (size_t)row * 1024 + (lane + 64 * i) * 4) = w; }
#pragma unroll
    for (int o = 32; o; o >>= 1) s += __shfl_xor(s, o);
    if (lane < 16) SSX[(size_t)row * 16 + lane] = lane == 0 ? s : 0.f;
  }
  for (int idx = bid_() * 256 + tid; idx < S * 48; idx += gridDim.x * 256) {
    const int pos = idx / 48, i = idx - pos * 48; float sn, cs;
    if (i < 16) { const float inv = 1.0f / powf(10000.f, (float)(2 * i) / 32.f); sincos_acc((float)pos * inv, sn, cs); C32[pos * 16 + i] = cs; S32[pos * 16 + i] = sn; }
    else { const int j = i - 16; const float inv = 1.0f / powf(10000.f, (float)(2 * j) / 64.f); sincos_acc((float)pos * inv, sn, cs); C64[pos * 32 + j] = cs; S64[pos * 32 + j] = sn; }
  }
  }

#pragma unroll 1
  for (int l = 0; l < 4; ++l) {
    conv_layer(lds, p, l);
    if (l == 0) grid.sync(); else GBAR;
    TSTAMP(0)
    { WSPTRS GemmArgs g{XB, 1024, (const bf16_t*)(ws + OFF_WIN), 1024, 1024, nullptr};
      EpiIn e{P, VT, SSX, SSA, C32, S32, C64, S64, kmax};
      bool st_ = false;
      for (int t = bid_(); t < 128 * 19; t += gridDim.x) { const int u = remap8(t, 128 * 19); const int tn = t + (int)gridDim.x; const bool hn = tn < 128 * 19; const int un = hn ? remap8(tn, 128 * 19) : 0;
        gemm_tile<false>(lds, g, (u / 19) * 128, (u % 19) * 128, e, st_, hn ? (un / 19) * 128 : -1, (un % 19) * 128); st_ = hn; } }
    GBAR; TSTAMP(1)
    { WSPTRS GemmArgs gq{P, NP, (const bf16_t*)(ws + OFF_WUQ), 192, 192, nullptr}; EpiUq eq{QA, SSA, C32, S32};
      GemmArgs gk{P + 256, NP, (const bf16_t*)(ws + OFF_WKV), 128, 128, nullptr}; EpiKv ek{KN, VTA, SSA, kmax};
      for (int t = bid_(); t < 896; t += gridDim.x) { const int u = remap8(t, 896);
        if (u < 384) gemm_tile<false>(lds, gq, (u / 3) * 128, (u % 3) * 128, eq);
        else { const int v = u - 384; gemm_tile<false>(lds, gk, (v >> 2) * 128, (v & 3) * 128, ek); } } }
    GBAR; TSTAMP(2)
    { WSPTRS AttnArgs a{P, VT, QA, KN, VTA, MIX, SSM, kmax, p.lq1 + l * 32, p.lk1 + l * 32, p.lq2 + l * 32, p.lk2 + l * 32, p.subln_g + l * 64, p.sinks + l * 4,
                 p.rpb + l * 4 * 465, p.lam_init[l]};
      unsigned* ctr = CTRL + 128 + 32 * l;
      if (threadIdx.x == 0) { int z_ = 0; asm volatile("" : "+v"(z_)); s_q[0] = z_; s_q[1] = z_; }
      for (;;) {
        if (threadIdx.x == 0) {
          const int xcc = (int)(__builtin_amdgcn_s_getreg((3 << 11) | 20) & 7u);
          const int pq_ = s_q[0]; int pass = pq_ >> 3, dq = pq_ & 7;
          int it = -1;
          if (((blockIdx.x >> 8) & 1u) && s_q[1] < 2) { const int idx = (int)atomicAdd(ctr + 16, 1u); if (idx < 1024) { it = 2048 + idx; s_q[1] = s_q[1] + 1; } else s_q[1] = 2; }
          if (it < 0)
          while (pass < 2) {
            const int ep = pass ^ (int)((blockIdx.x >> 8) & 1u);
            const int q = (xcc + dq) & 7; const int idx = (int)atomicAdd(ctr + ep * 8 + q, 1u);
            if (idx < 64) { it = ep * 1024 + (((((q >> 2) * 64 + idx) << 2)) | (q & 3)); break; }
            if (++dq == 8) { dq = 0; ++pass; }
          }
          if (it < 0) { const int idx = (int)atomicAdd(ctr + 16, 1u); it = idx < 1024 ? 2048 + idx : -1; }
          s_item = it; s_q[0] = pass * 8 + dq;
        }
        __syncthreads(); const int item = s_item; __syncthreads();
        if (item < 0) break;
        if (item < 1024) { if (!attn_pipe<1>(lds, a, item)) attn_item<1>(lds, a, item); }
        else if (item < 2048) { if (!attn_pipe<0>(lds, a, item - 1024)) attn_item<0>(lds, a, item - 1024); }
        else if (item < 2560) attn_item<2>(lds, a, item - 2048);
        else attn_item<3>(lds, a, item - 2560);
      } }
    TSTAMP(7)
    GBAR; TSTAMP(3)
    { WSPTRS GemmArgs g{MIX, 1024, (const bf16_t*)(ws + OFF_WOUT), 1024, 1024, SSM};
      EpiRes e{l == 0 ? p.x : p.out, p.out, XB, SSX};
      bool st_ = false;
      for (int t = bid_(); t < 1024; t += gridDim.x) { const int u = remap8(t, 1024); const int tn = t + (int)gridDim.x; const bool hn = tn < 1024; const int un = hn ? remap8(tn, 1024) : 0;
        gemm_tile<true>(lds, g, (u >> 3) * 128, (u & 7) * 128, e, st_, hn ? (un >> 3) * 128 : -1, (un & 7) * 128); st_ = hn; } }
    GBAR; TSTAMP(4)
    { WSPTRS GemmArgs g{XB, 1024, (const bf16_t*)(ws + OFF_WUP), 1024, 1024, nullptr}; EpiUp e{H, SSX};
      bool st_ = false;
      for (int t = bid_(); t < 4096; t += gridDim.x) { const int u = remap8(t, 4096); const int tn = t + (int)gridDim.x; const bool hn = tn < 4096; const int un = hn ? remap8(tn, 4096) : 0;
        gemm_tile<false>(lds, g, (u >> 5) * 128, (u & 31) * 128, e, st_, hn ? (un >> 5) * 128 : -1, (un & 31) * 128); st_ = hn; } }
    GBAR; TSTAMP(5)
    { WSPTRS GemmArgs g{H, 4096, (const bf16_t*)(ws + OFF_WDN), 4096, 4096, nullptr}; EpiRes e{p.out, p.out, XB, SSX};
      bool st_ = false;
      for (int t = bid_(); t < 1024; t += gridDim.x) { const int u = remap8(t, 1024); const int tn = t + (int)gridDim.x; const bool hn = tn < 1024; const int un = hn ? remap8(tn, 1024) : 0;
        gemm_tile<false>(lds, g, (u >> 3) * 128, (u & 7) * 128, e, st_, hn ? (un >> 3) * 128 : -1, (un & 7) * 128); st_ = hn; } }
    GBAR; TSTAMP(6)
  }
  const int l = 0; WSPTRS
  int tid_ = threadIdx.x; asm volatile("" : "+v"(tid_));
  const int lane = tid_ & 63, gw = bid_() * 4 + (tid_ >> 6), nw = gridDim.x * 4;
  for (int row = gw; row < S; row += nw) {
    const float rr = rowscale_ssx(SSX, row);
    f32x4* xr = (f32x4*)(p.out + (size_t)row * 1024);
#pragma unroll
    for (int i = 0; i < 4; ++i) { f32x4 v = xr[lane + 64 * i]; const f32x4 g = ((const f32x4*)p.fin_g)[lane + 64 * i]; v = v * rr * g; xr[lane + 64 * i] = v; }
  }
#ifdef PROBE_SEL
  { const int l = 0; WSPTRS
    if (blockIdx.x == 0 && threadIdx.x == 0) {
      unsigned long long tot = 0, sel = 0;
      for (int i = 0; i < 9; ++i) { tot += s_t[i]; if ((PROBE_SEL >> i) & 1) sel += s_t[i]; }
      ((float*)CTRL)[500] = (float)((double)sel / (double)tot);
    }
    grid.sync();
    const float fr = ((const float*)CTRL)[500];
    for (int row = gw; row < 64; row += nw) {
      f32x4* xr = (f32x4*)(p.out + (size_t)row * 1024);
      for (int i = 0; i < 4; ++i) { f32x4 v = xr[lane + 64 * i]; const float d = 0.05f * fr; v[0] += d; v[1] -= d; v[2] += d; v[3] -= d; xr[lane + 64 * i] = v; }
    }
  }
#endif
}

extern "C" void kernel_launch(void* const* d_in, const int* in_sizes, int n_in, void* d_out, int out_size,
                              void* d_ws, size_t ws_size, hipStream_t stream) {
  static int grid_blocks = 0;
  if (!grid_blocks) {
    int dev = 0, cus = 0, per_cu = 0;
    (void)hipGetDevice(&dev);
    (void)hipDeviceGetAttribute(&cus, hipDeviceAttributeMultiprocessorCount, dev);
    (void)hipOccupancyMaxActiveBlocksPerMultiprocessor(&per_cu, mega, 256, 0);
    per_cu = 2;
    grid_blocks = cus * per_cu;
  }
  Params p{};
  const float** pp = (const float**)&p;
  for (int i = 0; i < 23; ++i) pp[i] = (const float*)d_in[i];
  p.out = (float*)d_out; p.ws = (char*)d_ws;
  for (int l = 0; l < 4; ++l) p.lam_init[l] = (float)(0.8 - 0.6 * exp(-0.3 * (double)l));
  void* args[] = {&p};
  hipError_t e = hipLaunchCooperativeKernel((void*)mega, dim3(grid_blocks), dim3(256), args, 0, stream);
  if (e != hipSuccess) fprintf(stderr, "cooperative launch failed: %s (grid %d)\n", hipGetErrorString(e), grid_blocks);
}
```

```cpp
#include <hip/hip_runtime.h>
#include <hip/hip_cooperative_groups.h>
#include <cstdio>
#include <cmath>
namespace cg = cooperative_groups;

typedef unsigned short bf16_t;
typedef short bf16x8 __attribute__((ext_vector_type(8)));
typedef float f32x16 __attribute__((ext_vector_type(16)));
typedef float f32x4 __attribute__((ext_vector_type(4)));
typedef float f32x2 __attribute__((ext_vector_type(2)));
typedef unsigned u32x2 __attribute__((ext_vector_type(2)));
typedef unsigned u32x4 __attribute__((ext_vector_type(4)));
typedef __bf16 bf2_t __attribute__((ext_vector_type(2)));

constexpr int S = 16384, NP = 2432, VLD = S + 128;
constexpr float EPS = 1e-6f, LOG2E = 1.4426950408889634f;

constexpr size_t OFF_WIN = 0;
constexpr size_t OFF_WOUT = OFF_WIN + (size_t)NP * 1024 * 2;
constexpr size_t OFF_WUP = OFF_WOUT + (size_t)1024 * 1024 * 2;
constexpr size_t OFF_WDN = OFF_WUP + (size_t)4096 * 1024 * 2;
constexpr size_t OFF_WUQ = OFF_WDN + (size_t)4096 * 1024 * 2;
constexpr size_t OFF_WKV = OFF_WUQ + (size_t)384 * 192 * 2;
constexpr size_t OFF_XB = OFF_WKV + (size_t)512 * 128 * 2;
constexpr size_t OFF_MIX = OFF_XB + (size_t)S * 1024 * 2;
constexpr size_t OFF_R1 = OFF_MIX + (size_t)S * 1024 * 2;
constexpr size_t OFF_P = OFF_R1;
constexpr size_t OFF_VT = OFF_P + (size_t)S * NP * 2;
constexpr size_t OFF_QA = OFF_VT + (size_t)640 * VLD * 2;
constexpr size_t OFF_KN = OFF_QA + (size_t)S * 384 * 2;
constexpr size_t OFF_VTA = OFF_KN + (size_t)S * 256 * 2;
constexpr size_t OFF_H = OFF_R1;
constexpr size_t OFF_TAB = OFF_R1 + (size_t)S * 4096 * 2;
constexpr size_t OFF_SSX = OFF_TAB + (size_t)S * 96 * 4;
constexpr size_t OFF_SSA = OFF_SSX + (size_t)S * 16 * 4;
constexpr size_t OFF_SSM = OFF_SSA + (size_t)S * 8 * 4;
constexpr size_t OFF_CTRL = OFF_SSM + (size_t)12 * S * 4;
static_assert(OFF_VTA + (size_t)256 * VLD * 2 <= OFF_TAB, "overlay");

struct Params {
  const float *x, *norm1_g, *w_in, *qn_g, *w_uq, *kvn_g, *w_uk, *w_uv, *lq1, *lk1, *lq2, *lk2, *subln_g, *sinks, *rpb,
      *g_mla, *g_swa, *g_na, *w_out, *norm2_g, *w_up, *w_down, *fin_g;
  float* out; char* ws; float lam_init[4];
};

__device__ __forceinline__ unsigned pk2(float a, float b) { bf2_t r = __builtin_convertvector((f32x2){a, b}, bf2_t); return __builtin_bit_cast(unsigned, r); }
__device__ __forceinline__ bf16_t f2bf(float a) { return (bf16_t)(pk2(a, 0.f) & 0xffffu); }
__device__ __forceinline__ float bf2f(unsigned v) { return __uint_as_float(v << 16); }
__device__ __forceinline__ int crow(int r, int h) { return (r & 3) + 8 * (r >> 2) + 4 * h; }
__device__ __forceinline__ int permtok(int t) { return (t & ~12) | ((t & 4) << 1) | ((t & 8) >> 1); }
__device__ __forceinline__ int remap8(int t, int T) { return (t & 7) * (T >> 3) + (t >> 3); }
__device__ __forceinline__ int bid_() { int b = blockIdx.x; asm volatile("" : "+s"(b)); return b; }
#define MFMA(a, b, c) __builtin_amdgcn_mfma_f32_32x32x16_bf16((a), (b), (c), 0, 0, 0)

struct GemmArgs { const bf16_t* A; int lda; const bf16_t* Bt; int ldb; int K; const float* asc; };

#define LAS3 __attribute__((address_space(3)))
template <int V> struct IntC { static constexpr int value = V; };
__device__ __forceinline__ float seg_rscale(const float* asc, int seg, int tok) {
  if (seg == 1) return 1.f;
  const int idx = seg == 0 ? 0 : (seg == 2 ? 1 : 2);
  const float* sp = asc + (size_t)idx * 4 * S + tok;
  return rsqrtf((sp[0] + sp[S] + sp[2 * S] + sp[3 * S]) * (1.f / 256.f) + EPS);
}
template <bool ASC, class Epi>
__device__ __forceinline__ void gemm_tile(char* lds, const GemmArgs& g, int m0, int n0, const Epi& epi, bool staged = false, int nm0 = -1, int nn0 = 0) {
  int tid_ = threadIdx.x; asm volatile("" : "+v"(tid_));
  const int tid = tid_, lane = tid & 63, wid = __builtin_amdgcn_readfirstlane(tid >> 6), wr = wid >> 1, wc = wid & 1, c = lane & 31, h = lane >> 5;
  f32x16 acc[2][2];
#pragma unroll
  for (int i = 0; i < 2; ++i)
#pragma unroll
    for (int j = 0; j < 2; ++j)
#pragma unroll
      for (int r = 0; r < 16; ++r) acc[i][j][r] = 0.f;
  const int prow = tid >> 3, gch = (tid & 7) ^ ((prow >> 1) & 7);
  const bf16_t* Ap; Ap = g.A + (size_t)(m0 + prow) * g.lda + gch * 8;
  const bf16_t* Bp; Bp = g.Bt + (size_t)(n0 + prow) * g.ldb + gch * 8;
  (void)0;
  const size_t astep = (size_t)32 * g.lda, bstep = (size_t)32 * g.ldb;
  LAS3 char* l3 = (LAS3 char*)lds;
  const int nk = g.K >> 6;
  auto stage = [&](int kt, auto BUFC) {
    constexpr int buf = decltype(BUFC)::value;
#pragma unroll
    for (int i = 0; i < 4; ++i) {
      __builtin_amdgcn_global_load_lds((const unsigned*)(Ap + i * astep + kt * 64), (LAS3 unsigned*)(l3 + buf * 32768 + (256 * i + 64 * wid) * 16), 16, 0, 0);
      __builtin_amdgcn_global_load_lds((const unsigned*)(Bp + i * bstep + kt * 64), (LAS3 unsigned*)(l3 + buf * 32768 + 16384 + (256 * i + 64 * wid) * 16), 16, 0, 0);
    }
  };
  const int swz = (c >> 1) & 7;
  const unsigned lbase = (unsigned)(size_t)l3;
  const unsigned aoff = (wr * 64 + c) * 128, boff = 16384 + (wc * 64 + c) * 128;
  unsigned kofs[4];
#pragma unroll
  for (int ks = 0; ks < 4; ++ks) kofs[ks] = ((2 * ks + h) ^ swz) << 4;
  float rcur[2] = {1.f, 1.f};
  if (ASC) { rcur[0] = seg_rscale(g.asc, 0, m0 + wr * 64 + c); rcur[1] = seg_rscale(g.asc, 0, m0 + wr * 64 + 32 + c); }
  if (!staged) stage(0, IntC<0>{});
  asm volatile("s_waitcnt vmcnt(0)" ::: "memory"); __syncthreads();
  auto body = [&](int kt, auto BUFC) {
    constexpr int buf = decltype(BUFC)::value;
    if (kt + 1 < nk) stage(kt + 1, IntC<1 - buf>{});
    if (ASC) { if (kt > 0 && (kt & 3) == 0) {
#pragma unroll
      for (int mt = 0; mt < 2; ++mt) { const float rn = seg_rscale(g.asc, kt >> 2, m0 + wr * 64 + mt * 32 + c); const float f = rcur[mt] / rn; rcur[mt] = rn;
        acc[mt][0] = acc[mt][0] * f; acc[mt][1] = acc[mt][1] * f; } } }
    bf16x8 fr[2][4];
#define GRD(set, ks) { const unsigned aa_ = lbase + buf * 32768 + aoff + kofs[ks], bb_ = lbase + buf * 32768 + boff + kofs[ks]; \
      asm volatile("ds_read_b128 %0, %1" : "=v"(fr[set][0]) : "v"(aa_)); asm volatile("ds_read_b128 %0, %1 offset:4096" : "=v"(fr[set][1]) : "v"(aa_)); \
      asm volatile("ds_read_b128 %0, %1" : "=v"(fr[set][2]) : "v"(bb_)); asm volatile("ds_read_b128 %0, %1 offset:4096" : "=v"(fr[set][3]) : "v"(bb_)); }
    GRD(0, 0);
#pragma unroll
    for (int ks = 0; ks < 4; ++ks) {
      if (ks < 3) { GRD((ks + 1) & 1, ks + 1); asm volatile("s_waitcnt lgkmcnt(4)" : "+v"(fr[ks & 1][0]), "+v"(fr[ks & 1][1]), "+v"(fr[ks & 1][2]), "+v"(fr[ks & 1][3])); }
      else asm volatile("s_waitcnt lgkmcnt(0)" : "+v"(fr[ks & 1][0]), "+v"(fr[ks & 1][1]), "+v"(fr[ks & 1][2]), "+v"(fr[ks & 1][3]));
      __builtin_amdgcn_s_setprio(1);
#pragma unroll
      for (int mt = 0; mt < 2; ++mt)
#pragma unroll
        for (int nt = 0; nt < 2; ++nt) acc[mt][nt] = MFMA(fr[ks & 1][2 + nt], fr[ks & 1][mt], acc[mt][nt]);
      __builtin_amdgcn_s_setprio(0);
    }
#undef GRD
    asm volatile("s_waitcnt vmcnt(0)" ::: "memory"); __builtin_amdgcn_s_barrier(); asm volatile("" ::: "memory");
  };
  for (int kt = 0; kt < nk; kt += 2) { body(kt, IntC<0>{}); if (kt + 1 < nk) body(kt + 1, IntC<1>{}); }
  if (nm0 >= 0) {
    Ap = g.A + (size_t)(nm0 + prow) * g.lda + gch * 8; Bp = g.Bt + (size_t)(nn0 + prow) * g.ldb + gch * 8;
    stage(0, IntC<0>{});
  }
  if (ASC) {
#pragma unroll
    for (int mt = 0; mt < 2; ++mt) { acc[mt][0] = acc[mt][0] * rcur[mt]; acc[mt][1] = acc[mt][1] * rcur[mt]; } }
  epi(acc, m0, n0, wr, wc, c, h);
}

__device__ __forceinline__ void tile_rc256(int t, int NT, int& m0, int& n0) {
  const int x = t & 7, j = t >> 3;
  m0 = (x * 8 + (j & 7)) * 256; n0 = (j >> 3) * 128; (void)NT;
}
template <bool ASC, class Epi>
__device__ __forceinline__ void gemm_stream(char* lds, const GemmArgs& g, int NT, int ntiles, const Epi& epi) {
  int tid_ = threadIdx.x; asm volatile("" : "+v"(tid_));
  const int tid = tid_, lane = tid & 63, wid = __builtin_amdgcn_readfirstlane(tid >> 6), wr = wid >> 1, wc = wid & 1, c = lane & 31, h = lane >> 5;
  const int b = bid_(), G = (int)gridDim.x;
  __builtin_amdgcn_s_barrier();
  if (b >= ntiles) return;
  const int nk = g.K >> 5, my_tiles = (ntiles - b + G - 1) / G, total = my_tiles * nk;
  LAS3 char* l3 = (LAS3 char*)lds;
  const unsigned lbase = (unsigned)(size_t)l3;
  const int prow = tid >> 2, gch = (tid & 3) ^ ((tid >> 4) & 3);
  int s_t = b, s_kt = 0, sm0, sn0; tile_rc256(s_t, NT, sm0, sn0);
  const bf16_t* Ap = g.A + (size_t)(sm0 + prow) * g.lda + gch * 8;
  const bf16_t* Bp = g.Bt + (size_t)(sn0 + prow) * g.ldb + gch * 8;
  const size_t astep = (size_t)64 * g.lda, bstep = (size_t)64 * g.ldb;
  auto stage = [&](int slot) {
    LAS3 char* d = l3 + slot * 24576 + wid * 1024;
    __builtin_amdgcn_global_load_lds((const unsigned*)(Ap), (LAS3 unsigned*)(d), 16, 0, 0);
    __builtin_amdgcn_global_load_lds((const unsigned*)(Ap + astep), (LAS3 unsigned*)(d + 4096), 16, 0, 0);
    __builtin_amdgcn_global_load_lds((const unsigned*)(Ap + 2 * astep), (LAS3 unsigned*)(d + 8192), 16, 0, 0);
    __builtin_amdgcn_global_load_lds((const unsigned*)(Ap + 3 * astep), (LAS3 unsigned*)(d + 12288), 16, 0, 0);
    __builtin_amdgcn_global_load_lds((const unsigned*)(Bp), (LAS3 unsigned*)(d + 16384), 16, 0, 0);
    __builtin_amdgcn_global_load_lds((const unsigned*)(Bp + bstep), (LAS3 unsigned*)(d + 20480), 16, 0, 0);
    Ap += 32; Bp += 32;
    if (++s_kt == nk) { s_kt = 0; s_t += G; if (s_t < ntiles) { tile_rc256(s_t, NT, sm0, sn0);
        Ap = g.A + (size_t)(sm0 + prow) * g.lda + gch * 8; Bp = g.Bt + (size_t)(sn0 + prow) * g.ldb + gch * 8; } }
  };
  int c_t = b, c_kt = 0, cm0, cn0; tile_rc256(c_t, NT, cm0, cn0);
  f32x16 acc[4][2];
#pragma unroll
  for (int i = 0; i < 4; ++i)
#pragma unroll
    for (int j = 0; j < 2; ++j)
#pragma unroll
      for (int r = 0; r < 16; ++r) acc[i][j][r] = 0.f;
  const unsigned swz = (c >> 2) & 3;
  const unsigned aoff = (wr * 128 + c) * 64, boff = 16384 + (wc * 64 + c) * 64;
  const unsigned ko0 = ((0 + h) ^ swz) << 4, ko1 = ((2 + h) ^ swz) << 4;
  float rcur[4] = {1.f, 1.f, 1.f, 1.f};
  if (ASC) {
#pragma unroll
    for (int mt = 0; mt < 4; ++mt) rcur[mt] = seg_rscale(g.asc, 0, cm0 + wr * 128 + mt * 32 + c); }
  stage(0); if (total > 1) stage(1);
  int cslot = 0;
  for (int gi = 0; gi < total; ++gi) {
    if (gi + 1 < total) asm volatile("s_waitcnt vmcnt(6)" ::: "memory");
    else asm volatile("s_waitcnt vmcnt(0)" ::: "memory");
    __builtin_amdgcn_s_barrier(); asm volatile("" ::: "memory");
    if (gi + 2 < total) stage(cslot == 0 ? 2 : cslot - 1);
    if (ASC) { if (c_kt > 0 && (c_kt & 7) == 0) {
#pragma unroll
      for (int mt = 0; mt < 4; ++mt) { const float rn = seg_rscale(g.asc, c_kt >> 3, cm0 + wr * 128 + mt * 32 + c); const float f = rcur[mt] / rn; rcur[mt] = rn;
        acc[mt][0] = acc[mt][0] * f; acc[mt][1] = acc[mt][1] * f; } } }
    const unsigned sb = lbase + cslot * 24576;
    cslot = cslot == 2 ? 0 : cslot + 1;
    bf16x8 fa[4], fb[2], ga[4], gb[2];
    { const unsigned a0 = sb + aoff + ko0, a1 = sb + aoff + ko1, b0 = sb + boff + ko0, b1 = sb + boff + ko1;
      asm volatile("ds_read_b128 %0, %1" : "=v"(fa[0]) : "v"(a0)); asm volatile("ds_read_b128 %0, %1 offset:2048" : "=v"(fa[1]) : "v"(a0));
      asm volatile("ds_read_b128 %0, %1 offset:4096" : "=v"(fa[2]) : "v"(a0)); asm volatile("ds_read_b128 %0, %1 offset:6144" : "=v"(fa[3]) : "v"(a0));
      asm volatile("ds_read_b128 %0, %1" : "=v"(fb[0]) : "v"(b0)); asm volatile("ds_read_b128 %0, %1 offset:2048" : "=v"(fb[1]) : "v"(b0));
      asm volatile("ds_read_b128 %0, %1" : "=v"(ga[0]) : "v"(a1)); asm volatile("ds_read_b128 %0, %1 offset:2048" : "=v"(ga[1]) : "v"(a1));
      asm volatile("ds_read_b128 %0, %1 offset:4096" : "=v"(ga[2]) : "v"(a1)); asm volatile("ds_read_b128 %0, %1 offset:6144" : "=v"(ga[3]) : "v"(a1));
      asm volatile("ds_read_b128 %0, %1" : "=v"(gb[0]) : "v"(b1)); asm volatile("ds_read_b128 %0, %1 offset:2048" : "=v"(gb[1]) : "v"(b1)); }
    asm volatile("s_waitcnt lgkmcnt(6)" : "+v"(fa[0]), "+v"(fa[1]), "+v"(fa[2]), "+v"(fa[3]), "+v"(fb[0]), "+v"(fb[1]));
    __builtin_amdgcn_s_setprio(1);
#pragma unroll
    for (int mt = 0; mt < 4; ++mt)
#pragma unroll
      for (int nt = 0; nt < 2; ++nt) acc[mt][nt] = MFMA(fb[nt], fa[mt], acc[mt][nt]);
    __builtin_amdgcn_s_setprio(0);
    asm volatile("s_waitcnt lgkmcnt(0)" : "+v"(ga[0]), "+v"(ga[1]), "+v"(ga[2]), "+v"(ga[3]), "+v"(gb[0]), "+v"(gb[1]));
    __builtin_amdgcn_s_setprio(1);
#pragma unroll
    for (int mt = 0; mt < 4; ++mt)
#pragma unroll
      for (int nt = 0; nt < 2; ++nt) acc[mt][nt] = MFMA(gb[nt], ga[mt], acc[mt][nt]);
    __builtin_amdgcn_s_setprio(0);
    if (++c_kt == nk) {
      if (ASC) {
#pragma unroll
        for (int mt = 0; mt < 4; ++mt) { acc[mt][0] = acc[mt][0] * rcur[mt]; acc[mt][1] = acc[mt][1] * rcur[mt]; } }
      { int c2_ = c, h2_ = h; asm volatile("" : "+v"(c2_), "+v"(h2_));
        epi(acc, cm0, cn0, wr, wc, c2_, h2_); }
#pragma unroll
      for (int i = 0; i < 4; ++i)
#pragma unroll
        for (int j = 0; j < 2; ++j)
#pragma unroll
          for (int r = 0; r < 16; ++r) acc[i][j][r] = 0.f;
      c_kt = 0; c_t += G;
      if (c_t < ntiles) { tile_rc256(c_t, NT, cm0, cn0);
        if (ASC) {
#pragma unroll
          for (int mt = 0; mt < 4; ++mt) rcur[mt] = seg_rscale(g.asc, 0, cm0 + wr * 128 + mt * 32 + c); } }
    }
  }
}

__device__ __forceinline__ void store_plain(bf16_t* dst, const f32x16& v, int h) {
#pragma unroll
  for (int g = 0; g < 4; ++g) { u32x2 w; w.x = pk2(v[4 * g], v[4 * g + 1]); w.y = pk2(v[4 * g + 2], v[4 * g + 3]); *(u32x2*)(dst + 8 * g + 4 * h) = w; }
}
__device__ __forceinline__ void store_vt(bf16_t* vt, int featbase, int tok, const f32x16& v, int h) {
  const int pt = permtok(tok);
#pragma unroll
  for (int r = 0; r < 16; ++r) vt[(size_t)(featbase + crow(r, h)) * VLD + pt] = f2bf(v[r]);
}
__device__ __forceinline__ void rope32(f32x16& v, const float* c32, const float* s32, int tok, int h) {
  const f32x4 ca = *(const f32x4*)(c32 + tok * 16 + 4 * h), cb = *(const f32x4*)(c32 + tok * 16 + 8 + 4 * h);
  const f32x4 sa = *(const f32x4*)(s32 + tok * 16 + 4 * h), sb = *(const f32x4*)(s32 + tok * 16 + 8 + 4 * h);
#pragma unroll
  for (int i = 0; i < 4; ++i) {
    float x1 = v[i], x2 = v[i + 8]; v[i] = x1 * ca[i] - x2 * sa[i]; v[i + 8] = x2 * ca[i] + x1 * sa[i];
    x1 = v[4 + i]; x2 = v[12 + i]; v[4 + i] = x1 * cb[i] - x2 * sb[i]; v[12 + i] = x2 * cb[i] + x1 * sb[i];
  }
}
__device__ __forceinline__ void rope64(f32x16& v0, f32x16& v1, const float* c64, const float* s64, int tok, int h) {
#pragma unroll
  for (int g = 0; g < 4; ++g) {
    const f32x4 cg4 = *(const f32x4*)(c64 + tok * 32 + 8 * g + 4 * h), sg4 = *(const f32x4*)(s64 + tok * 32 + 8 * g + 4 * h);
#pragma unroll
    for (int i = 0; i < 4; ++i) { const float x1 = v0[4 * g + i], x2 = v1[4 * g + i]; v0[4 * g + i] = x1 * cg4[i] - x2 * sg4[i]; v1[4 * g + i] = x2 * cg4[i] + x1 * sg4[i]; }
  }
}
__device__ __forceinline__ float sumsq16(const f32x16& v) { float s = 0.f;
#pragma unroll
  for (int r = 0; r < 16; ++r) s += v[r] * v[r];
  return s; }
__device__ __forceinline__ void kmax_update(unsigned* slot, float s) {
  s += __shfl_xor(s, 32);
#pragma unroll
  for (int o = 16; o; o >>= 1) s = fmaxf(s, __shfl_xor(s, o));
  if ((threadIdx.x & 63) == 0) atomicMax(slot, __float_as_uint(s));
}
__device__ __forceinline__ float rowscale_ssx(const float* ssx, int tok) {
  const f32x4* sp = (const f32x4*)(ssx + (size_t)tok * 16); const f32x4 a = sp[0], b = sp[1], c = sp[2], d = sp[3];
  const float t = ((a[0] + a[1]) + (a[2] + a[3])) + ((b[0] + b[1]) + (b[2] + b[3])) + ((c[0] + c[1]) + (c[2] + c[3])) + ((d[0] + d[1]) + (d[2] + d[3]));
  return rsqrtf(t * (1.f / 1024.f) + EPS);
}

struct EpiIn {
  bf16_t* P; bf16_t* Vt; const float* ssx; float* ssa; const float *c32, *s32, *c64, *s64; unsigned* kmax;
  __device__ __forceinline__ void operator()(f32x16 (&acc)[2][2], int m0, int n0, int wr, int wc, int c, int h) const {
    const int g64 = (n0 >> 6) + wc;
    int vtb = -1, kslot = -1, ssl = -1; bool r32 = false, r64 = false;
    if (g64 <= 5) { if (g64 == 3) { r32 = true; kslot = 4; } else ssl = g64; }
    else if (g64 <= 13) { r32 = true; if (g64 >= 10) kslot = 5 + (g64 - 10); }
    else if (g64 <= 17) vtb = (g64 - 14) * 64;
    else if (g64 <= 23) { r64 = true; if (g64 >= 22) kslot = 9 + (g64 - 22); }
    else if (g64 <= 25) vtb = 256 + (g64 - 24) * 64;
    else if (g64 <= 33) { if (g64 >= 30) kslot = 11 + (g64 - 30); }
    else vtb = 384 + (g64 - 34) * 64;
#pragma unroll
    for (int mt = 0; mt < 2; ++mt) {
      const int tok = m0 + wr * 64 + mt * 32 + c;
      const float rr = rowscale_ssx(ssx, tok);
      f32x16 v0 = acc[mt][0] * rr, v1 = acc[mt][1] * rr;
      if (vtb >= 0) { store_vt(Vt, vtb, tok, v0, h); store_vt(Vt, vtb + 32, tok, v1, h); continue; }
      if (r32) { rope32(v0, c32, s32, tok, h); if (g64 != 3) rope32(v1, c32, s32, tok, h); }
      if (r64) rope64(v0, v1, c64, s64, tok, h);
      bf16_t* dst = P + (size_t)tok * NP + g64 * 64;
      store_plain(dst, v0, h); store_plain(dst + 32, v1, h);
      if (kslot >= 0) kmax_update(kmax + kslot, sumsq16(v0) + (g64 == 3 ? 0.f : sumsq16(v1)));
      if (ssl >= 0) { float s = sumsq16(v0) + sumsq16(v1); s += __shfl_xor(s, 32); if (h == 0) ssa[(size_t)tok * 8 + ssl] = s; }
    }
  }
};
struct EpiUq {
  bf16_t* Qa; const float* ssa; const float *c32, *s32;
  __device__ __forceinline__ void operator()(f32x16 (&acc)[2][2], int m0, int n0, int wr, int wc, int c, int h) const {
    const int g32 = ((n0 >> 6) + wc) * 2;
#pragma unroll
    for (int mt = 0; mt < 2; ++mt) {
      const int tok = m0 + wr * 64 + mt * 32 + c;
      const float* sp = ssa + (size_t)tok * 8; const float rr = rsqrtf((sp[0] + sp[1] + sp[2]) * (1.f / 192.f) + EPS);
#pragma unroll
      for (int nt = 0; nt < 2; ++nt) {
        f32x16 v = acc[mt][nt] * rr;
        if ((g32 + nt) % 3 == 2) rope32(v, c32, s32, tok, h);
        store_plain(Qa + (size_t)tok * 384 + (g32 + nt) * 32, v, h);
      }
    }
  }
};
struct EpiKv {
  bf16_t* KN; bf16_t* VtA; const float* ssa; unsigned* kmax;
  __device__ __forceinline__ void operator()(f32x16 (&acc)[2][2], int m0, int n0, int wr, int wc, int c, int h) const {
    const int g64 = (n0 >> 6) + wc;
#pragma unroll
    for (int mt = 0; mt < 2; ++mt) {
      const int tok = m0 + wr * 64 + mt * 32 + c;
      const float* sp = ssa + (size_t)tok * 8; const float rr = rsqrtf((sp[4] + sp[5]) * (1.f / 128.f) + EPS);
      const f32x16 v0 = acc[mt][0] * rr, v1 = acc[mt][1] * rr;
      if (g64 < 4) {
        bf16_t* dst = KN + (size_t)tok * 256 + g64 * 64; store_plain(dst, v0, h); store_plain(dst + 32, v1, h);
        kmax_update(kmax + g64, sumsq16(v0) + sumsq16(v1));
      } else { store_vt(VtA, (g64 - 4) * 64, tok, v0, h); store_vt(VtA, (g64 - 4) * 64 + 32, tok, v1, h); }
    }
  }
};
struct EpiRes {
  const float* xold; float* xnew; bf16_t* xb; float* ssx;
  __device__ __forceinline__ void operator()(f32x16 (&acc)[2][2], int m0, int n0, int wr, int wc, int c, int h) const {
#pragma unroll
    for (int mt = 0; mt < 2; ++mt) {
      const int tok = m0 + wr * 64 + mt * 32 + c; float s = 0.f;
#pragma unroll
      for (int nt = 0; nt < 2; ++nt)
#pragma unroll
        for (int g = 0; g < 4; ++g) {
          const size_t off = (size_t)tok * 1024 + n0 + wc * 64 + nt * 32 + 8 * g + 4 * h;
          f32x4 xo = *(const f32x4*)(xold + off);
#pragma unroll
          for (int i = 0; i < 4; ++i) { xo[i] += acc[mt][nt][4 * g + i]; s += xo[i] * xo[i]; }
          *(f32x4*)(xnew + off) = xo;
          u32x2 w; w.x = pk2(xo[0], xo[1]); w.y = pk2(xo[2], xo[3]); *(u32x2*)(xb + off) = w;
        }
      s += __shfl_xor(s, 32);
      if (h == 0) ssx[(size_t)tok * 16 + (n0 >> 7) * 2 + wc] = s;
    }
  }
};
struct EpiUp {
  bf16_t* H; const float* ssx;
  __device__ __forceinline__ void operator()(f32x16 (&acc)[2][2], int m0, int n0, int wr, int wc, int c, int h) const {
#pragma unroll
    for (int mt = 0; mt < 2; ++mt) {
      const int tok = m0 + wr * 64 + mt * 32 + c; const float rr = rowscale_ssx(ssx, tok);
#pragma unroll
      for (int nt = 0; nt < 2; ++nt) {
        f32x16 v;
#pragma unroll
        for (int r = 0; r < 16; ++r) { const float t = fmaxf(acc[mt][nt][r] * rr, 0.f); v[r] = t * t; }
        store_plain(H + (size_t)tok * 4096 + n0 + wc * 64 + nt * 32, v, h);
      }
    }
  }
};

struct EpiRes4 {
  const float* xold; float* xnew; bf16_t* xb; float* ssx;
  __device__ __forceinline__ void operator()(f32x16 (&acc)[4][2], int m0, int n0, int wr, int wc, int c, int h) const {
#pragma unroll
    for (int mt = 0; mt < 4; ++mt) {
      __builtin_amdgcn_sched_barrier(0);
      const int tok = m0 + wr * 128 + mt * 32 + c; float s = 0.f;
#pragma unroll
      for (int nt = 0; nt < 2; ++nt)
#pragma unroll
        for (int g = 0; g < 4; ++g) {
          const size_t off = (size_t)tok * 1024 + n0 + wc * 64 + nt * 32 + 8 * g + 4 * h;
          f32x4 xo = *(const f32x4*)(xold + off);
#pragma unroll
          for (int i = 0; i < 4; ++i) { xo[i] += acc[mt][nt][4 * g + i]; s += xo[i] * xo[i]; }
          *(f32x4*)(xnew + off) = xo;
          u32x2 w; w.x = pk2(xo[0], xo[1]); w.y = pk2(xo[2], xo[3]); *(u32x2*)(xb + off) = w;
        }
      s += __shfl_xor(s, 32);
      if (h == 0) ssx[(size_t)tok * 16 + (n0 >> 7) * 2 + wc] = s;
    }
  }
};
struct EpiUp4 {
  bf16_t* H; const float* ssx;
  __device__ __forceinline__ void operator()(f32x16 (&acc)[4][2], int m0, int n0, int wr, int wc, int c, int h) const {
#pragma unroll
    for (int mt = 0; mt < 4; ++mt) {
      __builtin_amdgcn_sched_barrier(0);
      const int tok = m0 + wr * 128 + mt * 32 + c; const float rr = rowscale_ssx(ssx, tok);
#pragma unroll
      for (int nt = 0; nt < 2; ++nt) {
        f32x16 v;
#pragma unroll
        for (int r = 0; r < 16; ++r) { const float t = fmaxf(acc[mt][nt][r] * rr, 0.f); v[r] = t * t; }
        store_plain(H + (size_t)tok * 4096 + n0 + wc * 64 + nt * 32, v, h);
      }
    }
  }
};

struct AttnArgs { const bf16_t *P, *Vt, *Qa, *KN, *VtA; bf16_t* mix; float* ssm; const unsigned* kmax;
  const float *lq1, *lk1, *lq2, *lk2, *subln, *sinks, *rpb; float lam_init; };

constexpr int ABUF = 22528, AKOFF = 13312, ATAB = 2 * ABUF;

template <int MODE>
__device__ __forceinline__ void attn_item(char* lds, const AttnArgs& a, int item) {
  constexpr int KSTR = MODE == 0 ? 208 : 144;
  constexpr int NKS = MODE == 0 ? 6 : (MODE == 1 ? 2 : 4);
  constexpr int NKP = MODE == 0 ? 3 : 2;
  constexpr int NQT = MODE == 1 ? 2 : 1;
  int tid_ = threadIdx.x; asm volatile("" : "+v"(tid_));
  const int tid = tid_, lane = tid & 63, wid = tid >> 6, c = lane & 31, h = lane >> 5;
  int hd, sb, se; int qtok[NQT]; const bf16_t* qptr[NQT]; const bf16_t* kbase; const bf16_t* vbase; int k2slot;
  int narow = 0, nars = 0, nahalf = 0, kvh = 0;
  if constexpr (MODE == 0) { hd = item & 3; const int qb = item >> 2; sb = 0; se = 256;
    qtok[0] = qb * 128 + wid * 32 + c; qptr[0] = a.Qa + (size_t)qtok[0] * 384 + hd * 96;
    kbase = a.KN + hd * 64; vbase = a.VtA + (size_t)hd * 64 * VLD; k2slot = hd; }
  else if constexpr (MODE == 1) { hd = item & 3; const int qb = item >> 2; sb = 0; se = 256;
#pragma unroll
    for (int qt = 0; qt < 2; ++qt) { qtok[qt] = qb * 128 + wid * 32 + c; qptr[qt] = a.P + (size_t)qtok[qt] * NP + 384 + hd * 64 + qt * 32; }
    kbase = a.P + 640 + hd * 64; vbase = a.Vt + (size_t)hd * 64 * VLD; k2slot = 5 + hd; }
  else if constexpr (MODE == 2) { hd = item & 3; kvh = hd >> 1; const int qb = item >> 2; sb = max(0, 2 * qb - 2); se = min(256, 2 * qb + 4);
    qtok[0] = qb * 128 + wid * 32 + c; qptr[0] = a.P + (size_t)qtok[0] * NP + 1152 + hd * 64;
    kbase = a.P + 1408 + kvh * 64; vbase = a.Vt + (size_t)(256 + kvh * 64) * VLD; k2slot = 9 + kvh; }
  else { hd = item & 3; const int rg = item >> 2; narow = rg * 2 + (wid >> 1); nahalf = wid & 1; nars = min(max(narow - 4, 0), 248);
    sb = min(max(rg * 2 - 4, 0), 248); se = min(max(rg * 2 - 3, 0), 248) + 8;
    qtok[0] = narow * 64 + nahalf * 32 + c; qptr[0] = a.P + (size_t)qtok[0] * NP + 1664 + hd * 64;
    kbase = a.P + 1920 + hd * 64; vbase = a.Vt + (size_t)(384 + hd * 64) * VLD; k2slot = 11 + hd; }

  bf16x8 qf[NQT][NKS]; float q2max = 0.f;
#pragma unroll
  for (int qt = 0; qt < NQT; ++qt) { float s = 0.f;
#pragma unroll
    for (int ks = 0; ks < NKS; ++ks) { qf[qt][ks] = *(const bf16x8*)(qptr[qt] + ks * 16 + h * 8);
#pragma unroll
      for (int j = 0; j < 8; ++j) { const float f = bf2f((unsigned short)qf[qt][ks][j]); s += f * f; } }
    s += __shfl_xor(s, 32); q2max = fmaxf(q2max, s); }
#pragma unroll
  for (int o = 16; o; o >>= 1) q2max = fmaxf(q2max, __shfl_xor(q2max, o));
  float k2 = __uint_as_float(a.kmax[k2slot]); if (MODE == 0) k2 += __uint_as_float(a.kmax[4]);
  float cb = sqrtf(q2max * k2) * 1.01f + 0.01f;
  if (MODE == 3) {
    float* tab = (float*)(lds + ATAB); const float* rp = a.rpb + hd * 465; float bm = 0.f;
    for (int i = lane; i < 465; i += 64) bm = fmaxf(bm, fabsf(rp[i]));
#pragma unroll
    for (int o = 32; o; o >>= 1) bm = fmaxf(bm, __shfl_xor(bm, o));
    cb += bm * LOG2E;
    for (int i = tid; i < 480; i += 256) { const int dr = i >> 5, dc = i & 31; tab[i] = dc < 31 ? rp[dr * 31 + dc] * LOG2E : 0.f; }
  }
  f32x16 negc;
#pragma unroll
  for (int r = 0; r < 16; ++r) negc[r] = -cb;

  f32x16 O[NQT][2]; float l[NQT];
#pragma unroll
  for (int i = 0; i < NQT; ++i) l[i] = 0.f;
#pragma unroll
  for (int i = 0; i < NQT; ++i)
#pragma unroll
    for (int j = 0; j < 2; ++j)
#pragma unroll
      for (int r = 0; r < 16; ++r) O[i][j][r] = 0.f;

  u32x4 rk[NKP], rv[2];
  auto gload = [&](int st) {
    const int kb = st * 64;
#pragma unroll
    for (int i = 0; i < NKP; ++i) { const int p = tid + 256 * i;
      if (MODE == 0) {
        if (i < 2) { const int row = p >> 3, ch = p & 7; rk[i] = *(const u32x4*)(kbase + (size_t)(kb + row) * 256 + ch * 8); }
        else { const int row = tid >> 2, ch = tid & 3; rk[i] = *(const u32x4*)(a.P + (size_t)(kb + row) * NP + 192 + ch * 8); } }
      else { const int row = p >> 3, ch = p & 7; rk[i] = *(const u32x4*)(kbase + (size_t)(kb + row) * NP + ch * 8); } }
#pragma unroll
    for (int i = 0; i < 2; ++i) { const int p = tid + 256 * i, dv = p >> 3, ch = p & 7; rv[i] = *(const u32x4*)(vbase + (size_t)dv * VLD + kb + ch * 8); }
  };
  auto lstore = [&](int buf) {
    char* b = lds + buf * ABUF;
#pragma unroll
    for (int i = 0; i < NKP; ++i) { const int p = tid + 256 * i;
      if (MODE == 0) { if (i < 2) { const int row = p >> 3, ch = p & 7; *(u32x4*)(b + row * 208 + ch * 16) = rk[i]; } else { const int row = tid >> 2, ch = tid & 3; *(u32x4*)(b + row * 208 + 128 + ch * 16) = rk[i]; } }
      else { const int row = p >> 3, ch = p & 7; *(u32x4*)(b + row * 144 + ch * 16) = rk[i]; } }
#pragma unroll
    for (int i = 0; i < 2; ++i) { const int p = tid + 256 * i, dv = p >> 3, ch = p & 7; *(u32x4*)(b + AKOFF + dv * 144 + ch * 16) = rv[i]; }
  };

  gload(sb); lstore(0); __syncthreads();
  for (int st = sb; st < se; ++st) {
    const int buf = (st - sb) & 1;
    if (st + 1 < se) gload(st + 1);
    __builtin_amdgcn_sched_barrier(0);
    const bool active = MODE != 3 || (st >= nars && st < nars + 8);
    if (active) {
      const char* Kb = lds + buf * ABUF; const char* Vb = Kb + AKOFF;
#pragma unroll
      for (int kt2 = 0; kt2 < 2; ++kt2) {
        f32x16 sc[NQT];
#pragma unroll
        for (int qt = 0; qt < NQT; ++qt) sc[qt] = negc;
        if (MODE != 1) {
#pragma unroll
          for (int ks = 0; ks < NKS; ++ks) { const bf16x8 kf = *(const bf16x8*)(Kb + (kt2 * 32 + c) * KSTR + ks * 32 + h * 16);
#pragma unroll
            for (int qt = 0; qt < NQT; ++qt) sc[qt] = MFMA(kf, qf[qt][ks], sc[qt]); }
        } else {
#pragma unroll
          for (int qt = 0; qt < NQT; ++qt)
#pragma unroll
            for (int ks = 0; ks < NKS; ++ks) { const bf16x8 kf = *(const bf16x8*)(Kb + (kt2 * 32 + c) * KSTR + qt * 64 + ks * 32 + h * 16);
              sc[qt] = MFMA(kf, qf[qt][ks], sc[qt]); }
        }
        if (MODE == 2) {
          const int kb0 = st * 64 + kt2 * 32 - qtok[0];
#pragma unroll
          for (int i = 0; i < 16; ++i) { const int d = kb0 + crow(i, h); const bool ok = d <= 128 && d >= -128;
            sc[0][i] = ok ? sc[0][i] : -INFINITY; }
        }
        if (MODE == 3) {
          const float* trow = (const float*)(lds + ATAB) + (st - narow + 7) * 32;
#pragma unroll
          for (int qt = 0; qt < NQT; ++qt) { const int w = nahalf * 32 + c, cs = min(max(w - 8, 0), 48);
#pragma unroll
            for (int i = 0; i < 16; ++i) { const int kc = kt2 * 32 + crow(i, h); const bool ok = kc >= cs && kc < cs + 16;
              const float bv = trow[(kc - w + 15) & 31]; sc[qt][i] = ok ? sc[qt][i] + bv : -INFINITY; } }
        }
        bf16x8 pf[NQT][2];
#pragma unroll
        for (int qt = 0; qt < NQT; ++qt) {
          float p[16];
#pragma unroll
          for (int i = 0; i < 16; ++i) { p[i] = __builtin_amdgcn_exp2f(sc[qt][i]); l[qt] += p[i]; }
#pragma unroll
          for (int s2 = 0; s2 < 2; ++s2) { u32x4 w; w.x = pk2(p[8 * s2], p[8 * s2 + 1]); w.y = pk2(p[8 * s2 + 2], p[8 * s2 + 3]);
            w.z = pk2(p[8 * s2 + 4], p[8 * s2 + 5]); w.w = pk2(p[8 * s2 + 6], p[8 * s2 + 7]); pf[qt][s2] = __builtin_bit_cast(bf16x8, w); }
        }
#pragma unroll
        for (int dt = 0; dt < 2; ++dt)
#pragma unroll
          for (int s2 = 0; s2 < 2; ++s2) { const bf16x8 vf = *(const bf16x8*)(Vb + (dt * 32 + c) * 144 + kt2 * 64 + s2 * 32 + h * 16);
#pragma unroll
            for (int qt = 0; qt < NQT; ++qt) O[qt][dt] = MFMA(vf, pf[qt][s2], O[qt][dt]); }
      }
    }
    __builtin_amdgcn_sched_barrier(0);
    if (st + 1 < se) lstore(buf ^ 1);
    __syncthreads();
  }

#pragma unroll
  for (int qt = 0; qt < NQT; ++qt) l[qt] += __shfl_xor(l[qt], 32);
  if (MODE == 1) {
    float pa = 0.f, pb = 0.f;
    if (lane < 32) { pa = a.lq1[lane] * a.lk1[lane]; pb = a.lq2[lane] * a.lk2[lane]; }
#pragma unroll
    for (int o = 32; o; o >>= 1) { pa += __shfl_xor(pa, o); pb += __shfl_xor(pb, o); }
    const float lam = expf(pa) - expf(pb) + a.lam_init;
    const float i0 = 1.f / l[0], i1 = lam / l[NQT - 1];
    f32x16 o[2]; float ss = 0.f;
#pragma unroll
    for (int dt = 0; dt < 2; ++dt)
#pragma unroll
      for (int r = 0; r < 16; ++r) { o[dt][r] = O[0][dt][r] * i0 - O[NQT - 1][dt][r] * i1; ss += o[dt][r] * o[dt][r]; }
    ss += __shfl_xor(ss, 32);
    const float rn = rsqrtf(ss * (1.f / 64.f) + EPS) * (1.f - a.lam_init);
#pragma unroll
    for (int dt = 0; dt < 2; ++dt) {
#pragma unroll
      for (int g = 0; g < 4; ++g) { const f32x4 gg = *(const f32x4*)(a.subln + dt * 32 + 8 * g + 4 * h);
#pragma unroll
        for (int i = 0; i < 4; ++i) o[dt][4 * g + i] *= rn * gg[i]; }
      store_plain(a.mix + (size_t)qtok[0] * 1024 + 256 + hd * 64 + dt * 32, o[dt], h);
    }
  } else {
#pragma unroll
    for (int qt = 0; qt < NQT; ++qt) {
      int head, colb, seg;
      if (MODE == 0) { head = hd; colb = hd * 64; seg = 0; }
      else if (MODE == 2) { head = hd; colb = 512 + head * 64; seg = 1; l[qt] += __builtin_amdgcn_exp2f(a.sinks[head] * LOG2E - cb); }
      else { head = hd; colb = 768 + hd * 64; seg = 2; }
      const float inv = 1.f / l[qt]; float ss = 0.f;
#pragma unroll
      for (int dt = 0; dt < 2; ++dt) { f32x16 o = O[qt][dt] * inv; ss += sumsq16(o); store_plain(a.mix + (size_t)qtok[qt] * 1024 + colb + dt * 32, o, h); }
      ss += __shfl_xor(ss, 32);
      if (h == 0) a.ssm[(size_t)(seg * 4 + head) * S + qtok[qt]] = ss;
    }
  }
}


template <bool B> struct BoolC { static constexpr bool value = B; };
#define SGB(mask, n) __builtin_amdgcn_sched_group_barrier((mask), (n), 0)
template <int MODE>
__device__ __forceinline__ bool attn_pipe(char* lds, const AttnArgs& a, int item) {
  constexpr int KSTR = MODE == 0 ? 208 : 144;
  constexpr int NKS = MODE == 0 ? 6 : 2;
  constexpr int NKP = MODE == 0 ? 3 : 2;
  constexpr int NST = 256;
  constexpr int NQT = MODE == 0 ? 1 : 2;
  int tid_ = threadIdx.x; asm volatile("" : "+v"(tid_));
  const int tid = tid_, lane = tid & 63, wid = tid >> 6, c = lane & 31, h = lane >> 5;
  const int hd = item & 3, qb = item >> 2;
  int qtok[NQT]; const bf16_t* qptr[NQT]; const bf16_t* kbase; const bf16_t* vbase; int k2slot;
  if constexpr (MODE == 0) {
    qtok[0] = qb * 128 + wid * 32 + c; qptr[0] = a.Qa + (size_t)qtok[0] * 384 + hd * 96;
    kbase = a.KN + hd * 64; vbase = a.VtA + (size_t)hd * 64 * VLD; k2slot = hd;
  } else {
#pragma unroll
    for (int qt = 0; qt < 2; ++qt) { qtok[qt] = qb * 128 + wid * 32 + c; qptr[qt] = a.P + (size_t)qtok[qt] * NP + 384 + hd * 64 + qt * 32; }
    kbase = a.P + 640 + hd * 64; vbase = a.Vt + (size_t)hd * 64 * VLD; k2slot = 5 + hd;
  }
  bf16x8 qf[NQT][NKS]; float q2max = 0.f;
#pragma unroll
  for (int qt = 0; qt < NQT; ++qt) { float s = 0.f;
#pragma unroll
    for (int ks = 0; ks < NKS; ++ks) { qf[qt][ks] = *(const bf16x8*)(qptr[qt] + ks * 16 + h * 8);
#pragma unroll
      for (int j = 0; j < 8; ++j) { const float f = bf2f((unsigned short)qf[qt][ks][j]); s += f * f; } }
    s += __shfl_xor(s, 32); q2max = fmaxf(q2max, s); }
#pragma unroll
  for (int o = 16; o; o >>= 1) q2max = fmaxf(q2max, __shfl_xor(q2max, o));
  float k2 = __uint_as_float(a.kmax[k2slot]); if (MODE == 0) k2 += __uint_as_float(a.kmax[4]);
  const float cb = sqrtf(q2max * k2) * 1.01f + 0.01f;
  { volatile int* flag = (volatile int*)(lds + 3 * ABUF);
    if (tid == 0) *flag = 0;
    __syncthreads();
    if (cb > 96.f && lane == 0) *flag = 1;
    __syncthreads();
    if (*flag) return false; }
  f32x16 O[NQT][2]; float l[NQT];
#pragma unroll
  for (int i = 0; i < NQT; ++i) { l[i] = 0.f;
#pragma unroll
    for (int j = 0; j < 2; ++j)
#pragma unroll
      for (int r = 0; r < 16; ++r) O[i][j][r] = 0.f; }

  u32x4 rk[NKP], rv[2];
  auto gload = [&](int st) {
    const int kb = st * 64;
#pragma unroll
    for (int i = 0; i < NKP; ++i) { const int p = tid + 256 * i;
      if (MODE == 0) {
        if (i < 2) { const int row = p >> 3, ch = p & 7; rk[i] = *(const u32x4*)(kbase + (size_t)(kb + row) * 256 + ch * 8); }
        else { const int row = tid >> 2, ch = tid & 3; rk[i] = *(const u32x4*)(a.P + (size_t)(kb + row) * NP + 192 + ch * 8); } }
      else { const int row = p >> 3, ch = p & 7; rk[i] = *(const u32x4*)(kbase + (size_t)(kb + row) * NP + ch * 8); } }
#pragma unroll
    for (int i = 0; i < 2; ++i) { const int p = tid + 256 * i, dv = p >> 3, ch = p & 7; rv[i] = *(const u32x4*)(vbase + (size_t)dv * VLD + kb + ch * 8); }
  };
  auto lstore = [&](int buf) {
    char* b = lds + buf * ABUF;
#pragma unroll
    for (int i = 0; i < NKP; ++i) { const int p = tid + 256 * i;
      if (MODE == 0) { if (i < 2) { const int row = p >> 3, ch = p & 7; *(u32x4*)(b + row * 208 + ch * 16) = rk[i]; } else { const int row = tid >> 2, ch = tid & 3; *(u32x4*)(b + row * 208 + 128 + ch * 16) = rk[i]; } }
      else { const int row = p >> 3, ch = p & 7; *(u32x4*)(b + row * 144 + ch * 16) = rk[i]; } }
#pragma unroll
    for (int i = 0; i < 2; ++i) { const int p = tid + 256 * i, dv = p >> 3, ch = p & 7; *(u32x4*)(b + AKOFF + dv * 144 + ch * 16) = rv[i]; }
  };
  const int koff = c * KSTR + h * 16, voff = AKOFF + c * 144 + h * 16;
#define QK_UNIT(dst, Kb, u) { _Pragma("unroll") for (int r_ = 0; r_ < 16; ++r_) dst[r_] = 0.f; \
    _Pragma("unroll") for (int ks = 0; ks < NKS; ++ks) { \
      const bf16x8 kf = *(const bf16x8*)((Kb) + koff + ((u) / NQT) * 32 * KSTR + (MODE == 1 ? ((u) % NQT) * 64 : 0) + ks * 32); \
      dst = MFMA(kf, qf[(u) % NQT][ks], dst); } }
#define EXP_UNIT(src, u, pf) { float p_[16]; \
    _Pragma("unroll") for (int i = 0; i < 16; ++i) { p_[i] = __builtin_amdgcn_exp2f(src[i]); l[(u) % NQT] += p_[i]; } \
    _Pragma("unroll") for (int s2 = 0; s2 < 2; ++s2) { u32x4 w_; w_.x = pk2(p_[8 * s2], p_[8 * s2 + 1]); w_.y = pk2(p_[8 * s2 + 2], p_[8 * s2 + 3]); \
      w_.z = pk2(p_[8 * s2 + 4], p_[8 * s2 + 5]); w_.w = pk2(p_[8 * s2 + 6], p_[8 * s2 + 7]); pf[s2] = __builtin_bit_cast(bf16x8, w_); } }
#define PV_UNIT(Vb, u, pf) { \
    _Pragma("unroll") for (int dt = 0; dt < 2; ++dt) \
    _Pragma("unroll") for (int s2 = 0; s2 < 2; ++s2) { \
      const bf16x8 vf = *(const bf16x8*)((Vb) + voff + dt * 32 * 144 + ((u) / NQT) * 64 + s2 * 32); \
      O[(u) % NQT][dt] = MFMA(vf, pf[s2], O[(u) % NQT][dt]); } }
#define SCHED_ITER(NM) { SGB(0x100, 2); \
    _Pragma("unroll") for (int i_ = 0; i_ < (NM); ++i_) { SGB(0x008, 1); SGB(0x002, (40 + (NM) - 1) / (NM)); if (i_ + 2 < (NM)) SGB(0x100, 1); } }

  gload(0); lstore(0); gload(1); lstore(1); __syncthreads();
  f32x16 sc, sn;
  QK_UNIT(sc, lds, 0);
  int cur = 0;
  for (int st = 0; st < NST; ++st) {
    const int nxt = cur == 2 ? 0 : cur + 1, wr = nxt == 2 ? 0 : nxt + 1;
    if (st + 2 < NST) gload(st + 2);
    const char* Kc = lds + cur * ABUF; const char* Kn = lds + nxt * ABUF;
    bf16x8 pa[2], pb[2];
    __builtin_amdgcn_sched_barrier(0);
    if constexpr (NQT == 2) {
      QK_UNIT(sn, Kc, 1); EXP_UNIT(sc, 0, pa); SCHED_ITER(NKS); sc = sn;
      __builtin_amdgcn_sched_barrier(0);
      QK_UNIT(sn, Kc, 2); EXP_UNIT(sc, 1, pb); PV_UNIT(Kc, 0, pa); SCHED_ITER(NKS + 4); sc = sn;
      __builtin_amdgcn_sched_barrier(0);
      QK_UNIT(sn, Kc, 3); EXP_UNIT(sc, 2, pa); PV_UNIT(Kc, 1, pb); SCHED_ITER(NKS + 4); sc = sn;
      __builtin_amdgcn_sched_barrier(0);
      QK_UNIT(sn, Kn, 0); EXP_UNIT(sc, 3, pb); PV_UNIT(Kc, 2, pa); SCHED_ITER(NKS + 4); sc = sn;
      __builtin_amdgcn_sched_barrier(0);
      PV_UNIT(Kc, 3, pb);
    } else {
      QK_UNIT(sn, Kc, 1); EXP_UNIT(sc, 0, pa); SCHED_ITER(NKS); sc = sn;
      __builtin_amdgcn_sched_barrier(0);
      QK_UNIT(sn, Kn, 0); EXP_UNIT(sc, 1, pb); PV_UNIT(Kc, 0, pa); SCHED_ITER(NKS + 4); sc = sn;
      __builtin_amdgcn_sched_barrier(0);
      PV_UNIT(Kc, 1, pb);
    }
    __builtin_amdgcn_sched_barrier(0);
    if (st + 2 < NST) lstore(wr);
    __syncthreads();
    cur = nxt;
  }
#undef QK_UNIT
#undef EXP_UNIT
#undef PV_UNIT
#undef SCHED_ITER

#pragma unroll
  for (int qt = 0; qt < NQT; ++qt) l[qt] += __shfl_xor(l[qt], 32);
  if constexpr (MODE == 1) {
    float pa = 0.f, pb = 0.f;
    if (lane < 32) { pa = a.lq1[lane] * a.lk1[lane]; pb = a.lq2[lane] * a.lk2[lane]; }
#pragma unroll
    for (int o = 32; o; o >>= 1) { pa += __shfl_xor(pa, o); pb += __shfl_xor(pb, o); }
    const float lam = expf(pa) - expf(pb) + a.lam_init;
    const float i0 = 1.f / l[0], i1 = lam / l[1];
    f32x16 o[2]; float ss = 0.f;
#pragma unroll
    for (int dt = 0; dt < 2; ++dt)
#pragma unroll
      for (int r = 0; r < 16; ++r) { o[dt][r] = O[0][dt][r] * i0 - O[1][dt][r] * i1; ss += o[dt][r] * o[dt][r]; }
    ss += __shfl_xor(ss, 32);
    const float rn = rsqrtf(ss * (1.f / 64.f) + EPS) * (1.f - a.lam_init);
#pragma unroll
    for (int dt = 0; dt < 2; ++dt) {
#pragma unroll
      for (int g = 0; g < 4; ++g) { const f32x4 gg = *(const f32x4*)(a.subln + dt * 32 + 8 * g + 4 * h);
#pragma unroll
        for (int i = 0; i < 4; ++i) o[dt][4 * g + i] *= rn * gg[i]; }
      store_plain(a.mix + (size_t)qtok[0] * 1024 + 256 + hd * 64 + dt * 32, o[dt], h);
    }
  } else {
#pragma unroll
    for (int qt = 0; qt < NQT; ++qt) {
      const float inv = 1.f / l[qt]; float ss = 0.f;
#pragma unroll
      for (int dt = 0; dt < 2; ++dt) { f32x16 o = O[qt][dt] * inv; ss += sumsq16(o); store_plain(a.mix + (size_t)qtok[qt] * 1024 + hd * 64 + dt * 32, o, h); }
      ss += __shfl_xor(ss, 32);
      if (h == 0) a.ssm[(size_t)hd * S + qtok[qt]] = ss;
    }
  }
  return true;
}

template <class F>
__device__ __forceinline__ void conv_tile(float* tl, bf16_t* out, int K, int n0, int k0, const F& f) {
  int tid_ = threadIdx.x; asm volatile("" : "+v"(tid_));
  const int tid = tid_, tx = tid & 63, ty = tid >> 6;
#pragma unroll 4
  for (int i = 0; i < 16; ++i) { const int k = ty + 4 * i; tl[k * 65 + tx] = f(k0 + k, n0 + tx); }
  __syncthreads();
  const int kx2 = (tid & 31) * 2, ny = tid >> 5;
#pragma unroll 4
  for (int i = 0; i < 8; ++i) { const int n = ny + 8 * i; *(unsigned*)(out + (size_t)(n0 + n) * K + k0 + kx2) = pk2(tl[kx2 * 65 + n], tl[(kx2 + 1) * 65 + n]); }
  __syncthreads();
}

__device__ void conv_layer(char* lds, const Params& p, int l) {
  float* tl = (float*)lds; char* ws = p.ws;
  const float* w_in = p.w_in + (size_t)l * 1024 * 2400; const float* g1 = p.norm1_g + l * 1024;
  const float* w_out = p.w_out + (size_t)l * 1024 * 1024; const float* gm = p.g_mla + l * 256; const float* gs = p.g_swa + l * 256; const float* gn = p.g_na + l * 256;
  const float* w_up = p.w_up + (size_t)l * 1024 * 4096; const float* g2 = p.norm2_g + l * 1024;
  const float* w_dn = p.w_down + (size_t)l * 4096 * 1024;
  const float* w_uq = p.w_uq + (size_t)l * 192 * 384; const float* qg = p.qn_g + l * 192;
  const float* w_uk = p.w_uk + (size_t)l * 128 * 256; const float* w_uv = p.w_uv + (size_t)l * 128 * 256; const float* kg = p.kvn_g + l * 128;
  const float sB = 0.17677669529663687f * LOG2E, sC = 0.125f * LOG2E, sA = 0.10206207261596577f * LOG2E;
  for (int t = bid_(); t < 2946; t += gridDim.x) {
    if (t < 608) { const int nt = t >> 4, kt = t & 15;
      conv_tile(tl, (bf16_t*)(ws + OFF_WIN), 1024, nt * 64, kt * 64, [&](int k, int n) -> float {
        int src; if (n < 192) src = n; else if (n < 224) src = 320 + n - 192; else if (n < 256) src = -1; else if (n < 384) src = 192 + n - 256; else src = 352 + n - 384;
        if (src < 0) return 0.f;
        float sc = 1.f; if (n >= 384 && n < 640) sc = sB; else if ((n >= 1152 && n < 1408) || (n >= 1664 && n < 1920)) sc = sC;
        return w_in[(size_t)k * 2400 + src] * g1[k] * sc; });
    } else if (t < 864) { const int u = t - 608, nt = u >> 4, kt = u & 15;
      conv_tile(tl, (bf16_t*)(ws + OFF_WOUT), 1024, nt * 64, kt * 64, [&](int k, int n) -> float {
        const float g = k < 256 ? gm[k] : (k < 512 ? 1.f : (k < 768 ? gs[k - 512] : gn[k - 768]));
        return w_out[(size_t)k * 1024 + n] * g; });
    } else if (t < 1888) { const int u = t - 864, nt = u >> 4, kt = u & 15;
      conv_tile(tl, (bf16_t*)(ws + OFF_WUP), 1024, nt * 64, kt * 64, [&](int k, int n) -> float { return w_up[(size_t)k * 4096 + n] * g2[k]; });
    } else if (t < 2912) { const int u = t - 1888, nt = u >> 6, kt = u & 63;
      conv_tile(tl, (bf16_t*)(ws + OFF_WDN), 4096, nt * 64, kt * 64, [&](int k, int n) -> float { return w_dn[(size_t)k * 1024 + n]; });
    } else if (t < 2930) { const int u = t - 2912, nt = u / 3, kt = u % 3;
      conv_tile(tl, (bf16_t*)(ws + OFF_WUQ), 192, nt * 64, kt * 64, [&](int k, int n) -> float { return w_uq[(size_t)k * 384 + n] * qg[k] * sA; });
    } else { const int u = t - 2930, nt = u >> 1, kt = u & 1;
      conv_tile(tl, (bf16_t*)(ws + OFF_WKV), 128, nt * 64, kt * 64, [&](int k, int n) -> float {
        return (n < 256 ? w_uk[(size_t)k * 256 + n] : w_uv[(size_t)k * 256 + n - 256]) * kg[k]; });
    }
  }
}

__device__ __forceinline__ void gbar(unsigned* base) {
  __syncthreads();
  if (threadIdx.x == 0) {
    __builtin_amdgcn_fence(__ATOMIC_RELEASE, "agent");
    const unsigned g = blockIdx.x & 15u, ng = gridDim.x >> 4;
    unsigned* cnt = base + g * 32; unsigned* root = base + 16 * 32; unsigned* gen = base + (17 + g) * 32;
    const unsigned old = __hip_atomic_load(gen, __ATOMIC_RELAXED, __HIP_MEMORY_SCOPE_AGENT);
    if (__hip_atomic_fetch_add(cnt, 1u, __ATOMIC_RELAXED, __HIP_MEMORY_SCOPE_AGENT) == ng - 1u) {
      __hip_atomic_store(cnt, 0u, __ATOMIC_RELAXED, __HIP_MEMORY_SCOPE_AGENT);
      __builtin_amdgcn_fence(__ATOMIC_RELEASE, "agent");
      if (__hip_atomic_fetch_add(root, 1u, __ATOMIC_RELAXED, __HIP_MEMORY_SCOPE_AGENT) == 15u) {
        __hip_atomic_store(root, 0u, __ATOMIC_RELAXED, __HIP_MEMORY_SCOPE_AGENT);
        __builtin_amdgcn_fence(__ATOMIC_RELEASE, "agent");
        for (unsigned k = 0; k < 16; ++k) __hip_atomic_fetch_add(base + (17 + k) * 32, 1u, __ATOMIC_RELAXED, __HIP_MEMORY_SCOPE_AGENT);
      }
    }
    while (__hip_atomic_load(gen, __ATOMIC_RELAXED, __HIP_MEMORY_SCOPE_AGENT) == old) __builtin_amdgcn_s_sleep(2);
    __builtin_amdgcn_fence(__ATOMIC_ACQUIRE, "agent");
  }
  __syncthreads();
}

__device__ __forceinline__ void sincos_acc(float ang, float& sn, float& cs) {
  const double a = (double)ang; const double n = rint(a * 0.15915494309189535);
  const double r = a - n * 6.283185307179586476925; const double r2 = r * r;
  double s = -1.0 / 51090942171709440000.0;
  s = s * r2 + 1.0 / 121645100408832000.0; s = s * r2 - 1.0 / 355687428096000.0; s = s * r2 + 1.0 / 1307674368000.0; s = s * r2 - 1.0 / 6227020800.0;
  s = s * r2 + 1.0 / 39916800.0; s = s * r2 - 1.0 / 362880.0; s = s * r2 + 1.0 / 5040.0; s = s * r2 - 1.0 / 120.0; s = s * r2 + 1.0 / 6.0; s = s * r2 - 1.0; s = -s * r;
  double c = 1.0 / 1124000727777607680000.0;
  c = c * r2 - 1.0 / 2432902008176640000.0; c = c * r2 + 1.0 / 6402373705728000.0; c = c * r2 - 1.0 / 20922789888000.0; c = c * r2 + 1.0 / 87178291200.0;
  c = c * r2 - 1.0 / 479001600.0; c = c * r2 + 1.0 / 3628800.0; c = c * r2 - 1.0 / 40320.0; c = c * r2 + 1.0 / 720.0; c = c * r2 - 1.0 / 24.0; c = c * r2 + 0.5; c = 1.0 - c * r2;
  sn = (float)s; cs = (float)c;
}

__global__ void __launch_bounds__(256, 2) mega(Params p) {
  cg::grid_group grid = cg::this_grid();
  __shared__ __attribute__((aligned(16))) char lds[73728];
  __shared__ int s_item; __shared__ int s_q[2];
#ifdef PROBE_SEL
  __shared__ unsigned long long s_t[10];
  if (threadIdx.x == 0) { for (int i = 0; i < 9; ++i) s_t[i] = 0; s_t[9] = __builtin_amdgcn_s_memrealtime(); }
#define TSTAMP(k) { if (blockIdx.x == 0 && threadIdx.x == 0) { const unsigned long long t_ = __builtin_amdgcn_s_memrealtime(); s_t[k] += t_ - s_t[9]; s_t[9] = t_; } }
#else
#define TSTAMP(k)
#endif
#define GBAR { size_t wz2_ = 0; asm volatile("" : "+s"(wz2_)); gbar((unsigned*)(p.ws + OFF_CTRL + wz2_) + 1024); }
#define WSPTRS \
  size_t wz_ = 0; asm volatile("" : "+s"(wz_)); char* ws = p.ws + wz_; \
  bf16_t* XB = (bf16_t*)(ws + OFF_XB); bf16_t* MIX = (bf16_t*)(ws + OFF_MIX); bf16_t* P = (bf16_t*)(ws + OFF_P); bf16_t* VT = (bf16_t*)(ws + OFF_VT); \
  bf16_t* QA = (bf16_t*)(ws + OFF_QA); bf16_t* KN = (bf16_t*)(ws + OFF_KN); bf16_t* VTA = (bf16_t*)(ws + OFF_VTA); bf16_t* H = (bf16_t*)(ws + OFF_H); \
  float* C32 = (float*)(ws + OFF_TAB); float* S32 = C32 + S * 16; float* C64 = S32 + S * 16; float* S64 = C64 + S * 32; \
  float* SSX = (float*)(ws + OFF_SSX); float* SSA = (float*)(ws + OFF_SSA); float* SSM = (float*)(ws + OFF_SSM); \
  unsigned* CTRL = (unsigned*)(ws + OFF_CTRL); unsigned* kmax = CTRL + 16 + 16 * l; \
  (void)XB; (void)MIX; (void)P; (void)VT; (void)QA; (void)KN; (void)VTA; (void)H; (void)C32; (void)S32; (void)C64; (void)S64; (void)SSX; (void)SSA; (void)SSM; (void)CTRL; (void)kmax;

  { const int l = 0; WSPTRS
  int tid_ = threadIdx.x; asm volatile("" : "+v"(tid_));
  const int tid = tid_, lane = tid & 63, wid = tid >> 6, gw = bid_() * 4 + wid, nw = gridDim.x * 4;
  if (blockIdx.x == 0) { for (int i = tid; i < 4096; i += 256) CTRL[i] = 0u; }
  for (int row = gw; row < S; row += nw) {
    const f32x4* xr = (const f32x4*)(p.x + (size_t)row * 1024); float s = 0.f;
#pragma unroll
    for (int i = 0; i < 4; ++i) { const f32x4 v = xr[lane + 64 * i]; s += v[0] * v[0] + v[1] * v[1] + v[2] * v[2] + v[3] * v[3];
      u32x2 w; w.x = pk2(v[0], v[1]); w.y = pk2(v[2], v[3]); *(u32x2*)(XB + (size_t)row * 1024 + (lane + 64 * i) * 4) = w; }
#pragma unroll
    for (int o = 32; o; o >>= 1) s += __shfl_xor(s, o);
    if (lane < 16) SSX[(size_t)row * 16 + lane] = lane == 0 ? s : 0.f;
  }
  for (int idx = bid_() * 256 + tid; idx < S * 48; idx += gridDim.x * 256) {
    const int pos = idx / 48, i = idx - pos * 48; float sn, cs;
    if (i < 16) { const float inv = 1.0f / powf(10000.f, (float)(2 * i) / 32.f); sincos_acc((float)pos * inv, sn, cs); C32[pos * 16 + i] = cs; S32[pos * 16 + i] = sn; }
    else { const int j = i - 16; const float inv = 1.0f / powf(10000.f, (float)(2 * j) / 64.f); sincos_acc((float)pos * inv, sn, cs); C64[pos * 32 + j] = cs; S64[pos * 32 + j] = sn; }
  }
  }

#pragma unroll 1
  for (int l = 0; l < 4; ++l) {
    conv_layer(lds, p, l);
    if (l == 0) grid.sync(); else GBAR;
    TSTAMP(0)
    { WSPTRS GemmArgs g{XB, 1024, (const bf16_t*)(ws + OFF_WIN), 1024, 1024, nullptr};
      EpiIn e{P, VT, SSX, SSA, C32, S32, C64, S64, kmax};
      bool st_ = false;
      for (int t = bid_(); t < 128 * 19; t += gridDim.x) { const int u = remap8(t, 128 * 19); const int tn = t + (int)gridDim.x; const bool hn = tn < 128 * 19; const int un = hn ? remap8(tn, 128 * 19) : 0;
        gemm_tile<false>(lds, g, (u / 19) * 128, (u % 19) * 128, e, st_, hn ? (un / 19) * 128 : -1, (un % 19) * 128); st_ = hn; } }
    GBAR; TSTAMP(1)
    { WSPTRS GemmArgs gq{P, NP, (const bf16_t*)(ws + OFF_WUQ), 192, 192, nullptr}; EpiUq eq{QA, SSA, C32, S32};
      GemmArgs gk{P + 256, NP, (const bf16_t*)(ws + OFF_WKV), 128, 128, nullptr}; EpiKv ek{KN, VTA, SSA, kmax};
      for (int t = bid_(); t < 896; t += gridDim.x) { const int u = remap8(t, 896);
        if (u < 384) gemm_tile<false>(lds, gq, (u / 3) * 128, (u % 3) * 128, eq);
        else { const int v = u - 384; gemm_tile<false>(lds, gk, (v >> 2) * 128, (v & 3) * 128, ek); } } }
    GBAR; TSTAMP(2)
    { WSPTRS AttnArgs a{P, VT, QA, KN, VTA, MIX, SSM, kmax, p.lq1 + l * 32, p.lk1 + l * 32, p.lq2 + l * 32, p.lk2 + l * 32, p.subln_g + l * 64, p.sinks + l * 4,
                 p.rpb + l * 4 * 465, p.lam_init[l]};
      unsigned* ctr = CTRL + 128 + 32 * l;
      if (threadIdx.x == 0) { int z_ = 0; asm volatile("" : "+v"(z_)); s_q[0] = z_; s_q[1] = z_; }
      for (;;) {
        if (threadIdx.x == 0) {
          const int xcc = (int)(__builtin_amdgcn_s_getreg((3 << 11) | 20) & 7u);
          const int pq_ = s_q[0]; int pass = pq_ >> 3, dq = pq_ & 7;
          int it = -1;
          if (((blockIdx.x >> 8) & 1u) && s_q[1] < 2) { const int idx = (int)atomicAdd(ctr + 16, 1u); if (idx < 1024) { it = 2048 + idx; s_q[1] = s_q[1] + 1; } else s_q[1] = 2; }
          if (it < 0)
          while (pass < 2) {
            const int ep = pass ^ (int)((blockIdx.x >> 8) & 1u);
            const int q = (xcc + dq) & 7; const int idx = (int)atomicAdd(ctr + ep * 8 + q, 1u);
            if (idx < 64) { it = ep * 1024 + (((((q >> 2) * 64 + idx) << 2)) | (q & 3)); break; }
            if (++dq == 8) { dq = 0; ++pass; }
          }
          if (it < 0) { const int idx = (int)atomicAdd(ctr + 16, 1u); it = idx < 1024 ? 2048 + idx : -1; }
          s_item = it; s_q[0] = pass * 8 + dq;
        }
        __syncthreads(); const int item = s_item; __syncthreads();
        if (item < 0) break;
        if (item < 1024) { if (!attn_pipe<1>(lds, a, item)) attn_item<1>(lds, a, item); }
        else if (item < 2048) { if (!attn_pipe<0>(lds, a, item - 1024)) attn_item<0>(lds, a, item - 1024); }
        else if (item < 2560) attn_item<2>(lds, a, item - 2048);
        else attn_item<3>(lds, a, item - 2560);
      } }
    TSTAMP(7)
    GBAR; TSTAMP(3)
    { WSPTRS GemmArgs g{MIX, 1024, (const bf16_t*)(ws + OFF_WOUT), 1024, 1024, SSM};
      EpiRes e{l == 0 ? p.x : p.out, p.out, XB, SSX};
      bool st_ = false;
      for (int t = bid_(); t < 1024; t += gridDim.x) { const int u = remap8(t, 1024); const int tn = t + (int)gridDim.x; const bool hn = tn < 1024; const int un = hn ? remap8(tn, 1024) : 0;
        gemm_tile<true>(lds, g, (u >> 3) * 128, (u & 7) * 128, e, st_, hn ? (un >> 3) * 128 : -1, (un & 7) * 128); st_ = hn; } }
    GBAR; TSTAMP(4)
    { WSPTRS GemmArgs g{XB, 1024, (const bf16_t*)(ws + OFF_WUP), 1024, 1024, nullptr}; EpiUp4 e{H, SSX};
      gemm_stream<false>(lds, g, 32, 2048, e); }
    GBAR; TSTAMP(5)
    { WSPTRS GemmArgs g{H, 4096, (const bf16_t*)(ws + OFF_WDN), 4096, 4096, nullptr}; EpiRes e{p.out, p.out, XB, SSX};
      bool st_ = false;
      for (int t = bid_(); t < 1024; t += gridDim.x) { const int u = remap8(t, 1024); const int tn = t + (int)gridDim.x; const bool hn = tn < 1024; const int un = hn ? remap8(tn, 1024) : 0;
        gemm_tile<false>(lds, g, (u >> 3) * 128, (u & 7) * 128, e, st_, hn ? (un >> 3) * 128 : -1, (un & 7) * 128); st_ = hn; } }
    GBAR; TSTAMP(6)
  }
  const int l = 0; WSPTRS
  int tid_ = threadIdx.x; asm volatile("" : "+v"(tid_));
  const int lane = tid_ & 63, gw = bid_() * 4 + (tid_ >> 6), nw = gridDim.x * 4;
  for (int row = gw; row < S; row += nw) {
    const float rr = rowscale_ssx(SSX, row);
    f32x4* xr = (f32x4*)(p.out + (size_t)row * 1024);
#pragma unroll
    for (int i = 0; i < 4; ++i) { f32x4 v = xr[lane + 64 * i]; const f32x4 g = ((const f32x4*)p.fin_g)[lane + 64 * i]; v = v * rr * g; xr[lane + 64 * i] = v; }
  }
#ifdef PROBE_SEL
  { const int l = 0; WSPTRS
    if (blockIdx.x == 0 && threadIdx.x == 0) {
      unsigned long long tot = 0, sel = 0;
      for (int i = 0; i < 9; ++i) { tot += s_t[i]; if ((PROBE_SEL >> i) & 1) sel += s_t[i]; }
      ((float*)CTRL)[500] = (float)((double)sel / (double)tot);
    }
    grid.sync();
    const float fr = ((const float*)CTRL)[500];
    for (int row = gw; row < 64; row += nw) {
      f32x4* xr = (f32x4*)(p.out + (size_t)row * 1024);
      for (int i = 0; i < 4; ++i) { f32x4 v = xr[lane + 64 * i]; const float d = 0.05f * fr; v[0] += d; v[1] -= d; v[2] += d; v[3] -= d; xr[lane + 64 * i] = v; }
    }
  }
#endif
}

extern "C" void kernel_launch(void* const* d_in, const int* in_sizes, int n_in, void* d_out, int out_size,
                              void* d_ws, size_t ws_size, hipStream_t stream) {
  static int grid_blocks = 0;
  if (!grid_blocks) {
    int dev = 0, cus = 0, per_cu = 0;
    (void)hipGetDevice(&dev);
    (void)hipDeviceGetAttribute(&cus, hipDeviceAttributeMultiprocessorCount, dev);
    (void)hipOccupancyMaxActiveBlocksPerMultiprocessor(&per_cu, mega, 256, 0);
    per_cu = 2;
    grid_blocks = cus * per_cu;
  }
  Params p{};
  const float** pp = (const float**)&p;
  for (int i = 0; i < 23; ++i) pp[i] = (const float*)d_in[i];
  p.out = (float*)d_out; p.ws = (char*)d_ws;
  for (int l = 0; l < 4; ++l) p.lam_init[l] = (float)(0.8 - 0.6 * exp(-0.3 * (double)l));
  void* args[] = {&p};
  hipError_t e = hipLaunchCooperativeKernel((void*)mega, dim3(grid_blocks), dim3(256), args, 0, stream);
  if (e != hipSuccess) fprintf(stderr, "cooperative launch failed: %s (grid %d)\n", hipGetErrorString(e), grid_blocks);
}
```

```cpp
#include <hip/hip_runtime.h>
#include <hip/hip_cooperative_groups.h>
#include <cstdio>
#include <cmath>
namespace cg = cooperative_groups;

typedef unsigned short bf16_t;
typedef short bf16x8 __attribute__((ext_vector_type(8)));
typedef float f32x16 __attribute__((ext_vector_type(16)));
typedef float f32x4 __attribute__((ext_vector_type(4)));
typedef float f32x2 __attribute__((ext_vector_type(2)));
typedef unsigned u32x2 __attribute__((ext_vector_type(2)));
typedef unsigned u32x4 __attribute__((ext_vector_type(4)));
typedef __bf16 bf2_t __attribute__((ext_vector_type(2)));

constexpr int S = 16384, NP = 2432, VLD = S + 128;
constexpr float EPS = 1e-6f, LOG2E = 1.4426950408889634f;

constexpr size_t OFF_WIN = 0;
constexpr size_t OFF_WOUT = OFF_WIN + (size_t)NP * 1024 * 2;
constexpr size_t OFF_WUP = OFF_WOUT + (size_t)1024 * 1024 * 2;
constexpr size_t OFF_WDN = OFF_WUP + (size_t)4096 * 1024 * 2;
constexpr size_t OFF_WUQ = OFF_WDN + (size_t)4096 * 1024 * 2;
constexpr size_t OFF_WKV = OFF_WUQ + (size_t)384 * 192 * 2;
constexpr size_t OFF_XB = OFF_WKV + (size_t)512 * 128 * 2;
constexpr size_t OFF_MIX = OFF_XB + (size_t)S * 1024 * 2;
constexpr size_t OFF_R1 = OFF_MIX + (size_t)S * 1024 * 2;
constexpr size_t OFF_P = OFF_R1;
constexpr size_t OFF_VT = OFF_P + (size_t)S * NP * 2;
constexpr size_t OFF_QA = OFF_VT + (size_t)640 * VLD * 2;
constexpr size_t OFF_KN = OFF_QA + (size_t)S * 384 * 2;
constexpr size_t OFF_VTA = OFF_KN + (size_t)S * 256 * 2;
constexpr size_t OFF_H = OFF_R1;
constexpr size_t OFF_TAB = OFF_R1 + (size_t)S * 4096 * 2;
constexpr size_t OFF_SSX = OFF_TAB + (size_t)S * 96 * 4;
constexpr size_t OFF_SSA = OFF_SSX + (size_t)S * 16 * 4;
constexpr size_t OFF_SSM = OFF_SSA + (size_t)S * 8 * 4;
constexpr size_t OFF_CTRL = OFF_SSM + (size_t)12 * S * 4;
static_assert(OFF_VTA + (size_t)256 * VLD * 2 <= OFF_TAB, "overlay");

struct Params {
  const float *x, *norm1_g, *w_in, *qn_g, *w_uq, *kvn_g, *w_uk, *w_uv, *lq1, *lk1, *lq2, *lk2, *subln_g, *sinks, *rpb,
      *g_mla, *g_swa, *g_na, *w_out, *norm2_g, *w_up, *w_down, *fin_g;
  float* out; char* ws; float lam_init[4];
};

__device__ __forceinline__ unsigned pk2(float a, float b) { bf2_t r = __builtin_convertvector((f32x2){a, b}, bf2_t); return __builtin_bit_cast(unsigned, r); }
__device__ __forceinline__ bf16_t f2bf(float a) { return (bf16_t)(pk2(a, 0.f) & 0xffffu); }
__device__ __forceinline__ float bf2f(unsigned v) { return __uint_as_float(v << 16); }
__device__ __forceinline__ int crow(int r, int h) { return (r & 3) + 8 * (r >> 2) + 4 * h; }
__device__ __forceinline__ int permtok(int t) { return (t & ~12) | ((t & 4) << 1) | ((t & 8) >> 1); }
__device__ __forceinline__ int remap8(int t, int T) { return (t & 7) * (T >> 3) + (t >> 3); }
__device__ __forceinline__ int bid_() { int b = blockIdx.x; asm volatile("" : "+s"(b)); return b; }
#define MFMA(a, b, c) __builtin_amdgcn_mfma_f32_32x32x16_bf16((a), (b), (c), 0, 0, 0)

struct GemmArgs { const bf16_t* A; int lda; const bf16_t* Bt; int ldb; int K; const float* asc; };

#define LAS3 __attribute__((address_space(3)))
template <int V> struct IntC { static constexpr int value = V; };
__device__ __forceinline__ float seg_rscale(const float* asc, int seg, int tok) {
  if (seg == 1) return 1.f;
  const int idx = seg == 0 ? 0 : (seg == 2 ? 1 : 2);
  const float* sp = asc + (size_t)idx * 4 * S + tok;
  return rsqrtf((sp[0] + sp[S] + sp[2 * S] + sp[3 * S]) * (1.f / 256.f) + EPS);
}
template <bool ASC, class Epi>
__device__ __forceinline__ void gemm_tile(char* lds, const GemmArgs& g, int m0, int n0, const Epi& epi, bool staged = false, int nm0 = -1, int nn0 = 0) {
  int tid_ = threadIdx.x; asm volatile("" : "+v"(tid_));
  const int tid = tid_, lane = tid & 63, wid = __builtin_amdgcn_readfirstlane(tid >> 6), wr = wid >> 1, wc = wid & 1, c = lane & 31, h = lane >> 5;
  f32x16 acc[2][2];
#pragma unroll
  for (int i = 0; i < 2; ++i)
#pragma unroll
    for (int j = 0; j < 2; ++j)
#pragma unroll
      for (int r = 0; r < 16; ++r) acc[i][j][r] = 0.f;
  const int prow = tid >> 3, gch = (tid & 7) ^ ((prow >> 1) & 7);
  const bf16_t* Ap; Ap = g.A + (size_t)(m0 + prow) * g.lda + gch * 8;
  const bf16_t* Bp; Bp = g.Bt + (size_t)(n0 + prow) * g.ldb + gch * 8;
  (void)0;
  const size_t astep = (size_t)32 * g.lda, bstep = (size_t)32 * g.ldb;
  LAS3 char* l3 = (LAS3 char*)lds;
  const int nk = g.K >> 6;
  auto stage = [&](int kt, auto BUFC) {
    constexpr int buf = decltype(BUFC)::value;
#pragma unroll
    for (int i = 0; i < 4; ++i) {
      __builtin_amdgcn_global_load_lds((const unsigned*)(Ap + i * astep + kt * 64), (LAS3 unsigned*)(l3 + buf * 32768 + (256 * i + 64 * wid) * 16), 16, 0, 0);
      __builtin_amdgcn_global_load_lds((const unsigned*)(Bp + i * bstep + kt * 64), (LAS3 unsigned*)(l3 + buf * 32768 + 16384 + (256 * i + 64 * wid) * 16), 16, 0, 0);
    }
  };
  const int swz = (c >> 1) & 7;
  const unsigned lbase = (unsigned)(size_t)l3;
  const unsigned aoff = (wr * 64 + c) * 128, boff = 16384 + (wc * 64 + c) * 128;
  unsigned kofs[4];
#pragma unroll
  for (int ks = 0; ks < 4; ++ks) kofs[ks] = ((2 * ks + h) ^ swz) << 4;
  float rcur[2] = {1.f, 1.f};
  if (ASC) { rcur[0] = seg_rscale(g.asc, 0, m0 + wr * 64 + c); rcur[1] = seg_rscale(g.asc, 0, m0 + wr * 64 + 32 + c); }
  if (!staged) stage(0, IntC<0>{});
  asm volatile("s_waitcnt vmcnt(0)" ::: "memory"); __syncthreads();
  auto body = [&](int kt, auto BUFC) {
    constexpr int buf = decltype(BUFC)::value;
    if (kt + 1 < nk) stage(kt + 1, IntC<1 - buf>{});
    if (ASC) { if (kt > 0 && (kt & 3) == 0) {
#pragma unroll
      for (int mt = 0; mt < 2; ++mt) { const float rn = seg_rscale(g.asc, kt >> 2, m0 + wr * 64 + mt * 32 + c); const float f = rcur[mt] / rn; rcur[mt] = rn;
        acc[mt][0] = acc[mt][0] * f; acc[mt][1] = acc[mt][1] * f; } } }
    bf16x8 fr[2][4];
#define GRD(set, ks) { const unsigned aa_ = lbase + buf * 32768 + aoff + kofs[ks], bb_ = lbase + buf * 32768 + boff + kofs[ks]; \
      asm volatile("ds_read_b128 %0, %1" : "=v"(fr[set][0]) : "v"(aa_)); asm volatile("ds_read_b128 %0, %1 offset:4096" : "=v"(fr[set][1]) : "v"(aa_)); \
      asm volatile("ds_read_b128 %0, %1" : "=v"(fr[set][2]) : "v"(bb_)); asm volatile("ds_read_b128 %0, %1 offset:4096" : "=v"(fr[set][3]) : "v"(bb_)); }
    GRD(0, 0);
#pragma unroll
    for (int ks = 0; ks < 4; ++ks) {
      if (ks < 3) { GRD((ks + 1) & 1, ks + 1); asm volatile("s_waitcnt lgkmcnt(4)" : "+v"(fr[ks & 1][0]), "+v"(fr[ks & 1][1]), "+v"(fr[ks & 1][2]), "+v"(fr[ks & 1][3])); }
      else asm volatile("s_waitcnt lgkmcnt(0)" : "+v"(fr[ks & 1][0]), "+v"(fr[ks & 1][1]), "+v"(fr[ks & 1][2]), "+v"(fr[ks & 1][3]));
      __builtin_amdgcn_s_setprio(1);
#pragma unroll
      for (int mt = 0; mt < 2; ++mt)
#pragma unroll
        for (int nt = 0; nt < 2; ++nt) acc[mt][nt] = MFMA(fr[ks & 1][2 + nt], fr[ks & 1][mt], acc[mt][nt]);
      __builtin_amdgcn_s_setprio(0);
    }
#undef GRD
    asm volatile("s_waitcnt vmcnt(0)" ::: "memory"); __builtin_amdgcn_s_barrier(); asm volatile("" ::: "memory");
  };
  for (int kt = 0; kt < nk; kt += 2) { body(kt, IntC<0>{}); if (kt + 1 < nk) body(kt + 1, IntC<1>{}); }
  if (nm0 >= 0) {
    Ap = g.A + (size_t)(nm0 + prow) * g.lda + gch * 8; Bp = g.Bt + (size_t)(nn0 + prow) * g.ldb + gch * 8;
    stage(0, IntC<0>{});
  }
  if (ASC) {
#pragma unroll
    for (int mt = 0; mt < 2; ++mt) { acc[mt][0] = acc[mt][0] * rcur[mt]; acc[mt][1] = acc[mt][1] * rcur[mt]; } }
  epi(acc, m0, n0, wr, wc, c, h);
}

__device__ __forceinline__ void tile_rc256(int t, int NT, int& m0, int& n0) {
  const int x = t & 7, j = t >> 3;
  m0 = (x * 8 + (j & 7)) * 256; n0 = (j >> 3) * 128; (void)NT;
}
template <bool ASC, class Epi>
__device__ __forceinline__ void gemm_stream(char* lds, const GemmArgs& g, int NT, int ntiles, const Epi& epi) {
  int tid_ = threadIdx.x; asm volatile("" : "+v"(tid_));
  const int tid = tid_, lane = tid & 63, wid = __builtin_amdgcn_readfirstlane(tid >> 6), wr = wid >> 1, wc = wid & 1, c = lane & 31, h = lane >> 5;
  const int b = bid_(), G = (int)gridDim.x;
  __builtin_amdgcn_s_barrier();
  if (b >= ntiles) return;
  const int nk = g.K >> 5, my_tiles = (ntiles - b + G - 1) / G, total = my_tiles * nk;
  LAS3 char* l3 = (LAS3 char*)lds;
  const unsigned lbase = (unsigned)(size_t)l3;
  const int prow = tid >> 2, gch = (tid & 3) ^ ((tid >> 4) & 3);
  int s_t = b, s_kt = 0, sm0, sn0; tile_rc256(s_t, NT, sm0, sn0);
  const bf16_t* Ap = g.A + (size_t)(sm0 + prow) * g.lda + gch * 8;
  const bf16_t* Bp = g.Bt + (size_t)(sn0 + prow) * g.ldb + gch * 8;
  const size_t astep = (size_t)64 * g.lda, bstep = (size_t)64 * g.ldb;
  auto stage = [&](int slot) {
    LAS3 char* d = l3 + slot * 24576 + wid * 1024;
    __builtin_amdgcn_global_load_lds((const unsigned*)(Ap), (LAS3 unsigned*)(d), 16, 0, 0);
    __builtin_amdgcn_global_load_lds((const unsigned*)(Ap + astep), (LAS3 unsigned*)(d + 4096), 16, 0, 0);
    __builtin_amdgcn_global_load_lds((const unsigned*)(Ap + 2 * astep), (LAS3 unsigned*)(d + 8192), 16, 0, 0);
    __builtin_amdgcn_global_load_lds((const unsigned*)(Ap + 3 * astep), (LAS3 unsigned*)(d + 12288), 16, 0, 0);
    __builtin_amdgcn_global_load_lds((const unsigned*)(Bp), (LAS3 unsigned*)(d + 16384), 16, 0, 0);
    __builtin_amdgcn_global_load_lds((const unsigned*)(Bp + bstep), (LAS3 unsigned*)(d + 20480), 16, 0, 0);
    Ap += 32; Bp += 32;
    if (++s_kt == nk) { s_kt = 0; s_t += G; if (s_t < ntiles) { tile_rc256(s_t, NT, sm0, sn0);
        Ap = g.A + (size_t)(sm0 + prow) * g.lda + gch * 8; Bp = g.Bt + (size_t)(sn0 + prow) * g.ldb + gch * 8; } }
  };
  int c_t = b, c_kt = 0, cm0, cn0; tile_rc256(c_t, NT, cm0, cn0);
  f32x16 acc[4][2];
#pragma unroll
  for (int i = 0; i < 4; ++i)
#pragma unroll
    for (int j = 0; j < 2; ++j)
#pragma unroll
      for (int r = 0; r < 16; ++r) acc[i][j][r] = 0.f;
  const unsigned swz = (c >> 2) & 3;
  const unsigned aoff = (wr * 128 + c) * 64, boff = 16384 + (wc * 64 + c) * 64;
  const unsigned ko0 = ((0 + h) ^ swz) << 4, ko1 = ((2 + h) ^ swz) << 4;
  float rcur[4] = {1.f, 1.f, 1.f, 1.f};
  if (ASC) {
#pragma unroll
    for (int mt = 0; mt < 4; ++mt) rcur[mt] = seg_rscale(g.asc, 0, cm0 + wr * 128 + mt * 32 + c); }
  stage(0); if (total > 1) stage(1);
  int cslot = 0;
  for (int gi = 0; gi < total; ++gi) {
    if (gi + 1 < total) asm volatile("s_waitcnt vmcnt(6)" ::: "memory");
    else asm volatile("s_waitcnt vmcnt(0)" ::: "memory");
    __builtin_amdgcn_s_barrier(); asm volatile("" ::: "memory");
    if (gi + 2 < total) stage(cslot == 0 ? 2 : cslot - 1);
    if (ASC) { if (c_kt > 0 && (c_kt & 7) == 0) {
#pragma unroll
      for (int mt = 0; mt < 4; ++mt) { const float rn = seg_rscale(g.asc, c_kt >> 3, cm0 + wr * 128 + mt * 32 + c); const float f = rcur[mt] / rn; rcur[mt] = rn;
        acc[mt][0] = acc[mt][0] * f; acc[mt][1] = acc[mt][1] * f; } } }
    const unsigned sb = lbase + cslot * 24576;
    cslot = cslot == 2 ? 0 : cslot + 1;
    bf16x8 fa[4], fb[2], ga[4], gb[2];
    { const unsigned a0 = sb + aoff + ko0, a1 = sb + aoff + ko1, b0 = sb + boff + ko0, b1 = sb + boff + ko1;
      asm volatile("ds_read_b128 %0, %1" : "=v"(fa[0]) : "v"(a0)); asm volatile("ds_read_b128 %0, %1 offset:2048" : "=v"(fa[1]) : "v"(a0));
      asm volatile("ds_read_b128 %0, %1 offset:4096" : "=v"(fa[2]) : "v"(a0)); asm volatile("ds_read_b128 %0, %1 offset:6144" : "=v"(fa[3]) : "v"(a0));
      asm volatile("ds_read_b128 %0, %1" : "=v"(fb[0]) : "v"(b0)); asm volatile("ds_read_b128 %0, %1 offset:2048" : "=v"(fb[1]) : "v"(b0));
      asm volatile("ds_read_b128 %0, %1" : "=v"(ga[0]) : "v"(a1)); asm volatile("ds_read_b128 %0, %1 offset:2048" : "=v"(ga[1]) : "v"(a1));
      asm volatile("ds_read_b128 %0, %1 offset:4096" : "=v"(ga[2]) : "v"(a1)); asm volatile("ds_read_b128 %0, %1 offset:6144" : "=v"(ga[3]) : "v"(a1));
      asm volatile("ds_read_b128 %0, %1" : "=v"(gb[0]) : "v"(b1)); asm volatile("ds_read_b128 %0, %1 offset:2048" : "=v"(gb[1]) : "v"(b1)); }
    asm volatile("s_waitcnt lgkmcnt(6)" : "+v"(fa[0]), "+v"(fa[1]), "+v"(fa[2]), "+v"(fa[3]), "+v"(fb[0]), "+v"(fb[1]));
    __builtin_amdgcn_s_setprio(1);
#pragma unroll
    for (int mt = 0; mt < 4; ++mt)
#pragma unroll
      for (int nt = 0; nt < 2; ++nt) acc[mt][nt] = MFMA(fb[nt], fa[mt], acc[mt][nt]);
    __builtin_amdgcn_s_setprio(0);
    asm volatile("s_waitcnt lgkmcnt(0)" : "+v"(ga[0]), "+v"(ga[1]), "+v"(ga[2]), "+v"(ga[3]), "+v"(gb[0]), "+v"(gb[1]));
    __builtin_amdgcn_s_setprio(1);
#pragma unroll
    for (int mt = 0; mt < 4; ++mt)
#pragma unroll
      for (int nt = 0; nt < 2; ++nt) acc[mt][nt] = MFMA(gb[nt], ga[mt], acc[mt][nt]);
    __builtin_amdgcn_s_setprio(0);
    if (++c_kt == nk) {
      if (ASC) {
#pragma unroll
        for (int mt = 0; mt < 4; ++mt) { acc[mt][0] = acc[mt][0] * rcur[mt]; acc[mt][1] = acc[mt][1] * rcur[mt]; } }
      { int c2_ = c, h2_ = h; asm volatile("" : "+v"(c2_), "+v"(h2_));
        epi(acc, cm0, cn0, wr, wc, c2_, h2_); }
#pragma unroll
      for (int i = 0; i < 4; ++i)
#pragma unroll
        for (int j = 0; j < 2; ++j)
#pragma unroll
          for (int r = 0; r < 16; ++r) acc[i][j][r] = 0.f;
      c_kt = 0; c_t += G;
      if (c_t < ntiles) { tile_rc256(c_t, NT, cm0, cn0);
        if (ASC) {
#pragma unroll
          for (int mt = 0; mt < 4; ++mt) rcur[mt] = seg_rscale(g.asc, 0, cm0 + wr * 128 + mt * 32 + c); } }
    }
  }
}

__device__ __forceinline__ void store_plain(bf16_t* dst, const f32x16& v, int h) {
#pragma unroll
  for (int g = 0; g < 4; ++g) { u32x2 w; w.x = pk2(v[4 * g], v[4 * g + 1]); w.y = pk2(v[4 * g + 2], v[4 * g + 3]); *(u32x2*)(dst + 8 * g + 4 * h) = w; }
}
__device__ __forceinline__ void store_vt(bf16_t* vt, int featbase, int tok, const f32x16& v, int h) {
  const int pt = permtok(tok);
#pragma unroll
  for (int r = 0; r < 16; ++r) vt[(size_t)(featbase + crow(r, h)) * VLD + pt] = f2bf(v[r]);
}
__device__ __forceinline__ void rope32(f32x16& v, const float* c32, const float* s32, int tok, int h) {
  const f32x4 ca = *(const f32x4*)(c32 + tok * 16 + 4 * h), cb = *(const f32x4*)(c32 + tok * 16 + 8 + 4 * h);
  const f32x4 sa = *(const f32x4*)(s32 + tok * 16 + 4 * h), sb = *(const f32x4*)(s32 + tok * 16 + 8 + 4 * h);
#pragma unroll
  for (int i = 0; i < 4; ++i) {
    float x1 = v[i], x2 = v[i + 8]; v[i] = x1 * ca[i] - x2 * sa[i]; v[i + 8] = x2 * ca[i] + x1 * sa[i];
    x1 = v[4 + i]; x2 = v[12 + i]; v[4 + i] = x1 * cb[i] - x2 * sb[i]; v[12 + i] = x2 * cb[i] + x1 * sb[i];
  }
}
__device__ __forceinline__ void rope64(f32x16& v0, f32x16& v1, const float* c64, const float* s64, int tok, int h) {
#pragma unroll
  for (int g = 0; g < 4; ++g) {
    const f32x4 cg4 = *(const f32x4*)(c64 + tok * 32 + 8 * g + 4 * h), sg4 = *(const f32x4*)(s64 + tok * 32 + 8 * g + 4 * h);
#pragma unroll
    for (int i = 0; i < 4; ++i) { const float x1 = v0[4 * g + i], x2 = v1[4 * g + i]; v0[4 * g + i] = x1 * cg4[i] - x2 * sg4[i]; v1[4 * g + i] = x2 * cg4[i] + x1 * sg4[i]; }
  }
}
__device__ __forceinline__ float sumsq16(const f32x16& v) { float s = 0.f;
#pragma unroll
  for (int r = 0; r < 16; ++r) s += v[r] * v[r];
  return s; }
__device__ __forceinline__ void kmax_update(unsigned* slot, float s) {
  s += __shfl_xor(s, 32);
#pragma unroll
  for (int o = 16; o; o >>= 1) s = fmaxf(s, __shfl_xor(s, o));
  if ((threadIdx.x & 63) == 0) atomicMax(slot, __float_as_uint(s));
}
__device__ __forceinline__ float rowscale_ssx(const float* ssx, int tok) {
  const f32x4* sp = (const f32x4*)(ssx + (size_t)tok * 16); const f32x4 a = sp[0], b = sp[1], c = sp[2], d = sp[3];
  const float t = ((a[0] + a[1]) + (a[2] + a[3])) + ((b[0] + b[1]) + (b[2] + b[3])) + ((c[0] + c[1]) + (c[2] + c[3])) + ((d[0] + d[1]) + (d[2] + d[3]));
  return rsqrtf(t * (1.f / 1024.f) + EPS);
}

struct EpiIn {
  bf16_t* P; bf16_t* Vt; const float* ssx; float* ssa; const float *c32, *s32, *c64, *s64; unsigned* kmax;
  __device__ __forceinline__ void operator()(f32x16 (&acc)[2][2], int m0, int n0, int wr, int wc, int c, int h) const {
    const int g64 = (n0 >> 6) + wc;
    int vtb = -1, kslot = -1, ssl = -1; bool r32 = false, r64 = false;
    if (g64 <= 5) { if (g64 == 3) { r32 = true; kslot = 4; } else ssl = g64; }
    else if (g64 <= 13) { r32 = true; if (g64 >= 10) kslot = 5 + (g64 - 10); }
    else if (g64 <= 17) vtb = (g64 - 14) * 64;
    else if (g64 <= 23) { r64 = true; if (g64 >= 22) kslot = 9 + (g64 - 22); }
    else if (g64 <= 25) vtb = 256 + (g64 - 24) * 64;
    else if (g64 <= 33) { if (g64 >= 30) kslot = 11 + (g64 - 30); }
    else vtb = 384 + (g64 - 34) * 64;
#pragma unroll
    for (int mt = 0; mt < 2; ++mt) {
      const int tok = m0 + wr * 64 + mt * 32 + c;
      const float rr = rowscale_ssx(ssx, tok);
      f32x16 v0 = acc[mt][0] * rr, v1 = acc[mt][1] * rr;
      if (vtb >= 0) { store_vt(Vt, vtb, tok, v0, h); store_vt(Vt, vtb + 32, tok, v1, h); continue; }
      if (r32) { rope32(v0, c32, s32, tok, h); if (g64 != 3) rope32(v1, c32, s32, tok, h); }
      if (r64) rope64(v0, v1, c64, s64, tok, h);
      bf16_t* dst = P + (size_t)tok * NP + g64 * 64;
      store_plain(dst, v0, h); store_plain(dst + 32, v1, h);
      if (kslot >= 0) kmax_update(kmax + kslot, sumsq16(v0) + (g64 == 3 ? 0.f : sumsq16(v1)));
      if (ssl >= 0) { float s = sumsq16(v0) + sumsq16(v1); s += __shfl_xor(s, 32); if (h == 0) ssa[(size_t)tok * 8 + ssl] = s; }
    }
  }
};
struct EpiUq {
  bf16_t* Qa; const float* ssa; const float *c32, *s32;
  __device__ __forceinline__ void operator()(f32x16 (&acc)[2][2], int m0, int n0, int wr, int wc, int c, int h) const {
    const int g32 = ((n0 >> 6) + wc) * 2;
#pragma unroll
    for (int mt = 0; mt < 2; ++mt) {
      const int tok = m0 + wr * 64 + mt * 32 + c;
      const float* sp = ssa + (size_t)tok * 8; const float rr = rsqrtf((sp[0] + sp[1] + sp[2]) * (1.f / 192.f) + EPS);
#pragma unroll
      for (int nt = 0; nt < 2; ++nt) {
        f32x16 v = acc[mt][nt] * rr;
        if ((g32 + nt) % 3 == 2) rope32(v, c32, s32, tok, h);
        store_plain(Qa + (size_t)tok * 384 + (g32 + nt) * 32, v, h);
      }
    }
  }
};
struct EpiKv {
  bf16_t* KN; bf16_t* VtA; const float* ssa; unsigned* kmax;
  __device__ __forceinline__ void operator()(f32x16 (&acc)[2][2], int m0, int n0, int wr, int wc, int c, int h) const {
    const int g64 = (n0 >> 6) + wc;
#pragma unroll
    for (int mt = 0; mt < 2; ++mt) {
      const int tok = m0 + wr * 64 + mt * 32 + c;
      const float* sp = ssa + (size_t)tok * 8; const float rr = rsqrtf((sp[4] + sp[5]) * (1.f / 128.f) + EPS);
      const f32x16 v0 = acc[mt][0] * rr, v1 = acc[mt][1] * rr;
      if (g64 < 4) {
        bf16_t* dst = KN + (size_t)tok * 256 + g64 * 64; store_plain(dst, v0, h); store_plain(dst + 32, v1, h);
        kmax_update(kmax + g64, sumsq16(v0) + sumsq16(v1));
      } else { store_vt(VtA, (g64 - 4) * 64, tok, v0, h); store_vt(VtA, (g64 - 4) * 64 + 32, tok, v1, h); }
    }
  }
};
struct EpiRes {
  bf16_t* xb; float* ssx;
  __device__ __forceinline__ void operator()(f32x16 (&acc)[2][2], int m0, int n0, int wr, int wc, int c, int h) const {
#pragma unroll
    for (int mt = 0; mt < 2; ++mt) {
      const int tok = m0 + wr * 64 + mt * 32 + c; float s = 0.f;
#pragma unroll
      for (int nt = 0; nt < 2; ++nt)
#pragma unroll
        for (int g = 0; g < 4; ++g) {
          const size_t off = (size_t)tok * 1024 + n0 + wc * 64 + nt * 32 + 8 * g + 4 * h;
          const u32x2 xo2 = *(const u32x2*)(xb + off);
          f32x4 xo; xo[0] = bf2f(xo2.x & 0xffffu); xo[1] = __uint_as_float(xo2.x & 0xffff0000u); xo[2] = bf2f(xo2.y & 0xffffu); xo[3] = __uint_as_float(xo2.y & 0xffff0000u);
#pragma unroll
          for (int i = 0; i < 4; ++i) { xo[i] += acc[mt][nt][4 * g + i]; s += xo[i] * xo[i]; }
          u32x2 w; w.x = pk2(xo[0], xo[1]); w.y = pk2(xo[2], xo[3]); *(u32x2*)(xb + off) = w;
        }
      s += __shfl_xor(s, 32);
      if (h == 0) ssx[(size_t)tok * 16 + (n0 >> 7) * 2 + wc] = s;
    }
  }
};
struct EpiUp {
  bf16_t* H; const float* ssx;
  __device__ __forceinline__ void operator()(f32x16 (&acc)[2][2], int m0, int n0, int wr, int wc, int c, int h) const {
#pragma unroll
    for (int mt = 0; mt < 2; ++mt) {
      const int tok = m0 + wr * 64 + mt * 32 + c; const float rr = rowscale_ssx(ssx, tok);
#pragma unroll
      for (int nt = 0; nt < 2; ++nt) {
        f32x16 v;
#pragma unroll
        for (int r = 0; r < 16; ++r) { const float t = fmaxf(acc[mt][nt][r] * rr, 0.f); v[r] = t * t; }
        store_plain(H + (size_t)tok * 4096 + n0 + wc * 64 + nt * 32, v, h);
      }
    }
  }
};

struct EpiUp4 {
  bf16_t* H; const float* ssx;
  __device__ __forceinline__ void operator()(f32x16 (&acc)[4][2], int m0, int n0, int wr, int wc, int c, int h) const {
#pragma unroll
    for (int mt = 0; mt < 4; ++mt) {
      __builtin_amdgcn_sched_barrier(0);
      const int tok = m0 + wr * 128 + mt * 32 + c; const float rr = rowscale_ssx(ssx, tok);
#pragma unroll
      for (int nt = 0; nt < 2; ++nt) {
        f32x16 v;
#pragma unroll
        for (int r = 0; r < 16; ++r) { const float t = fmaxf(acc[mt][nt][r] * rr, 0.f); v[r] = t * t; }
        store_plain(H + (size_t)tok * 4096 + n0 + wc * 64 + nt * 32, v, h);
      }
    }
  }
};

struct AttnArgs { const bf16_t *P, *Vt, *Qa, *KN, *VtA; bf16_t* mix; float* ssm; const unsigned* kmax;
  const float *lq1, *lk1, *lq2, *lk2, *subln, *sinks, *rpb; float lam_init; };

constexpr int ABUF = 22528, AKOFF = 13312, ATAB = 2 * ABUF;

template <int MODE>
__device__ __forceinline__ void attn_item(char* lds, const AttnArgs& a, int item) {
  constexpr int KSTR = MODE == 0 ? 208 : 144;
  constexpr int NKS = MODE == 0 ? 6 : (MODE == 1 ? 2 : 4);
  constexpr int NKP = MODE == 0 ? 3 : 2;
  constexpr int NQT = MODE == 1 ? 2 : 1;
  int tid_ = threadIdx.x; asm volatile("" : "+v"(tid_));
  const int tid = tid_, lane = tid & 63, wid = tid >> 6, c = lane & 31, h = lane >> 5;
  int hd, sb, se; int qtok[NQT]; const bf16_t* qptr[NQT]; const bf16_t* kbase; const bf16_t* vbase; int k2slot;
  int narow = 0, nars = 0, nahalf = 0, kvh = 0;
  if constexpr (MODE == 0) { hd = item & 3; const int qb = item >> 2; sb = 0; se = 256;
    qtok[0] = qb * 128 + wid * 32 + c; qptr[0] = a.Qa + (size_t)qtok[0] * 384 + hd * 96;
    kbase = a.KN + hd * 64; vbase = a.VtA + (size_t)hd * 64 * VLD; k2slot = hd; }
  else if constexpr (MODE == 1) { hd = item & 3; const int qb = item >> 2; sb = 0; se = 256;
#pragma unroll
    for (int qt = 0; qt < 2; ++qt) { qtok[qt] = qb * 128 + wid * 32 + c; qptr[qt] = a.P + (size_t)qtok[qt] * NP + 384 + hd * 64 + qt * 32; }
    kbase = a.P + 640 + hd * 64; vbase = a.Vt + (size_t)hd * 64 * VLD; k2slot = 5 + hd; }
  else if constexpr (MODE == 2) { hd = item & 3; kvh = hd >> 1; const int qb = item >> 2; sb = max(0, 2 * qb - 2); se = min(256, 2 * qb + 4);
    qtok[0] = qb * 128 + wid * 32 + c; qptr[0] = a.P + (size_t)qtok[0] * NP + 1152 + hd * 64;
    kbase = a.P + 1408 + kvh * 64; vbase = a.Vt + (size_t)(256 + kvh * 64) * VLD; k2slot = 9 + kvh; }
  else { hd = item & 3; const int rg = item >> 2; narow = rg * 2 + (wid >> 1); nahalf = wid & 1; nars = min(max(narow - 4, 0), 248);
    sb = min(max(rg * 2 - 4, 0), 248); se = min(max(rg * 2 - 3, 0), 248) + 8;
    qtok[0] = narow * 64 + nahalf * 32 + c; qptr[0] = a.P + (size_t)qtok[0] * NP + 1664 + hd * 64;
    kbase = a.P + 1920 + hd * 64; vbase = a.Vt + (size_t)(384 + hd * 64) * VLD; k2slot = 11 + hd; }

  bf16x8 qf[NQT][NKS]; float q2max = 0.f;
#pragma unroll
  for (int qt = 0; qt < NQT; ++qt) { float s = 0.f;
#pragma unroll
    for (int ks = 0; ks < NKS; ++ks) { qf[qt][ks] = *(const bf16x8*)(qptr[qt] + ks * 16 + h * 8);
#pragma unroll
      for (int j = 0; j < 8; ++j) { const float f = bf2f((unsigned short)qf[qt][ks][j]); s += f * f; } }
    s += __shfl_xor(s, 32); q2max = fmaxf(q2max, s); }
#pragma unroll
  for (int o = 16; o; o >>= 1) q2max = fmaxf(q2max, __shfl_xor(q2max, o));
  float k2 = __uint_as_float(a.kmax[k2slot]); if (MODE == 0) k2 += __uint_as_float(a.kmax[4]);
  float cb = sqrtf(q2max * k2) * 1.01f + 0.01f;
  if (MODE == 3) {
    float* tab = (float*)(lds + ATAB); const float* rp = a.rpb + hd * 465; float bm = 0.f;
    for (int i = lane; i < 465; i += 64) bm = fmaxf(bm, fabsf(rp[i]));
#pragma unroll
    for (int o = 32; o; o >>= 1) bm = fmaxf(bm, __shfl_xor(bm, o));
    cb += bm * LOG2E;
    for (int i = tid; i < 480; i += 256) { const int dr = i >> 5, dc = i & 31; tab[i] = dc < 31 ? rp[dr * 31 + dc] * LOG2E : 0.f; }
  }
  f32x16 negc;
#pragma unroll
  for (int r = 0; r < 16; ++r) negc[r] = -cb;

  f32x16 O[NQT][2]; float l[NQT];
#pragma unroll
  for (int i = 0; i < NQT; ++i) l[i] = 0.f;
#pragma unroll
  for (int i = 0; i < NQT; ++i)
#pragma unroll
    for (int j = 0; j < 2; ++j)
#pragma unroll
      for (int r = 0; r < 16; ++r) O[i][j][r] = 0.f;

  u32x4 rk[NKP], rv[2];
  auto gload = [&](int st) {
    const int kb = st * 64;
#pragma unroll
    for (int i = 0; i < NKP; ++i) { const int p = tid + 256 * i;
      if (MODE == 0) {
        if (i < 2) { const int row = p >> 3, ch = p & 7; rk[i] = *(const u32x4*)(kbase + (size_t)(kb + row) * 256 + ch * 8); }
        else { const int row = tid >> 2, ch = tid & 3; rk[i] = *(const u32x4*)(a.P + (size_t)(kb + row) * NP + 192 + ch * 8); } }
      else { const int row = p >> 3, ch = p & 7; rk[i] = *(const u32x4*)(kbase + (size_t)(kb + row) * NP + ch * 8); } }
#pragma unroll
    for (int i = 0; i < 2; ++i) { const int p = tid + 256 * i, dv = p >> 3, ch = p & 7; rv[i] = *(const u32x4*)(vbase + (size_t)dv * VLD + kb + ch * 8); }
  };
  auto lstore = [&](int buf) {
    char* b = lds + buf * ABUF;
#pragma unroll
    for (int i = 0; i < NKP; ++i) { const int p = tid + 256 * i;
      if (MODE == 0) { if (i < 2) { const int row = p >> 3, ch = p & 7; *(u32x4*)(b + row * 208 + ch * 16) = rk[i]; } else { const int row = tid >> 2, ch = tid & 3; *(u32x4*)(b + row * 208 + 128 + ch * 16) = rk[i]; } }
      else { const int row = p >> 3, ch = p & 7; *(u32x4*)(b + row * 144 + ch * 16) = rk[i]; } }
#pragma unroll
    for (int i = 0; i < 2; ++i) { const int p = tid + 256 * i, dv = p >> 3, ch = p & 7; *(u32x4*)(b + AKOFF + dv * 144 + ch * 16) = rv[i]; }
  };

  gload(sb); lstore(0); __syncthreads();
  for (int st = sb; st < se; ++st) {
    const int buf = (st - sb) & 1;
    if (st + 1 < se) gload(st + 1);
    __builtin_amdgcn_sched_barrier(0);
    const bool active = MODE != 3 || (st >= nars && st < nars + 8);
    if (active) {
      const char* Kb = lds + buf * ABUF; const char* Vb = Kb + AKOFF;
#pragma unroll
      for (int kt2 = 0; kt2 < 2; ++kt2) {
        f32x16 sc[NQT];
#pragma unroll
        for (int qt = 0; qt < NQT; ++qt) sc[qt] = negc;
        if (MODE != 1) {
#pragma unroll
          for (int ks = 0; ks < NKS; ++ks) { const bf16x8 kf = *(const bf16x8*)(Kb + (kt2 * 32 + c) * KSTR + ks * 32 + h * 16);
#pragma unroll
            for (int qt = 0; qt < NQT; ++qt) sc[qt] = MFMA(kf, qf[qt][ks], sc[qt]); }
        } else {
#pragma unroll
          for (int qt = 0; qt < NQT; ++qt)
#pragma unroll
            for (int ks = 0; ks < NKS; ++ks) { const bf16x8 kf = *(const bf16x8*)(Kb + (kt2 * 32 + c) * KSTR + qt * 64 + ks * 32 + h * 16);
              sc[qt] = MFMA(kf, qf[qt][ks], sc[qt]); }
        }
        if (MODE == 2) {
          const int kb0 = st * 64 + kt2 * 32 - qtok[0];
#pragma unroll
          for (int i = 0; i < 16; ++i) { const int d = kb0 + crow(i, h); const bool ok = d <= 128 && d >= -128;
            sc[0][i] = ok ? sc[0][i] : -INFINITY; }
        }
        if (MODE == 3) {
          const float* trow = (const float*)(lds + ATAB) + (st - narow + 7) * 32;
#pragma unroll
          for (int qt = 0; qt < NQT; ++qt) { const int w = nahalf * 32 + c, cs = min(max(w - 8, 0), 48);
#pragma unroll
            for (int i = 0; i < 16; ++i) { const int kc = kt2 * 32 + crow(i, h); const bool ok = kc >= cs && kc < cs + 16;
              const float bv = trow[(kc - w + 15) & 31]; sc[qt][i] = ok ? sc[qt][i] + bv : -INFINITY; } }
        }
        bf16x8 pf[NQT][2];
#pragma unroll
        for (int qt = 0; qt < NQT; ++qt) {
          float p[16];
#pragma unroll
          for (int i = 0; i < 16; ++i) { p[i] = __builtin_amdgcn_exp2f(sc[qt][i]); l[qt] += p[i]; }
#pragma unroll
          for (int s2 = 0; s2 < 2; ++s2) { u32x4 w; w.x = pk2(p[8 * s2], p[8 * s2 + 1]); w.y = pk2(p[8 * s2 + 2], p[8 * s2 + 3]);
            w.z = pk2(p[8 * s2 + 4], p[8 * s2 + 5]); w.w = pk2(p[8 * s2 + 6], p[8 * s2 + 7]); pf[qt][s2] = __builtin_bit_cast(bf16x8, w); }
        }
#pragma unroll
        for (int dt = 0; dt < 2; ++dt)
#pragma unroll
          for (int s2 = 0; s2 < 2; ++s2) { const bf16x8 vf = *(const bf16x8*)(Vb + (dt * 32 + c) * 144 + kt2 * 64 + s2 * 32 + h * 16);
#pragma unroll
            for (int qt = 0; qt < NQT; ++qt) O[qt][dt] = MFMA(vf, pf[qt][s2], O[qt][dt]); }
      }
    }
    __builtin_amdgcn_sched_barrier(0);
    if (st + 1 < se) lstore(buf ^ 1);
    __syncthreads();
  }

#pragma unroll
  for (int qt = 0; qt < NQT; ++qt) l[qt] += __shfl_xor(l[qt], 32);
  if (MODE == 1) {
    float pa = 0.f, pb = 0.f;
    if (lane < 32) { pa = a.lq1[lane] * a.lk1[lane]; pb = a.lq2[lane] * a.lk2[lane]; }
#pragma unroll
    for (int o = 32; o; o >>= 1) { pa += __shfl_xor(pa, o); pb += __shfl_xor(pb, o); }
    const float lam = expf(pa) - expf(pb) + a.lam_init;
    const float i0 = 1.f / l[0], i1 = lam / l[NQT - 1];
    f32x16 o[2]; float ss = 0.f;
#pragma unroll
    for (int dt = 0; dt < 2; ++dt)
#pragma unroll
      for (int r = 0; r < 16; ++r) { o[dt][r] = O[0][dt][r] * i0 - O[NQT - 1][dt][r] * i1; ss += o[dt][r] * o[dt][r]; }
    ss += __shfl_xor(ss, 32);
    const float rn = rsqrtf(ss * (1.f / 64.f) + EPS) * (1.f - a.lam_init);
#pragma unroll
    for (int dt = 0; dt < 2; ++dt) {
#pragma unroll
      for (int g = 0; g < 4; ++g) { const f32x4 gg = *(const f32x4*)(a.subln + dt * 32 + 8 * g + 4 * h);
#pragma unroll
        for (int i = 0; i < 4; ++i) o[dt][4 * g + i] *= rn * gg[i]; }
      store_plain(a.mix + (size_t)qtok[0] * 1024 + 256 + hd * 64 + dt * 32, o[dt], h);
    }
  } else {
#pragma unroll
    for (int qt = 0; qt < NQT; ++qt) {
      int head, colb, seg;
      if (MODE == 0) { head = hd; colb = hd * 64; seg = 0; }
      else if (MODE == 2) { head = hd; colb = 512 + head * 64; seg = 1; l[qt] += __builtin_amdgcn_exp2f(a.sinks[head] * LOG2E - cb); }
      else { head = hd; colb = 768 + hd * 64; seg = 2; }
      const float inv = 1.f / l[qt]; float ss = 0.f;
#pragma unroll
      for (int dt = 0; dt < 2; ++dt) { f32x16 o = O[qt][dt] * inv; ss += sumsq16(o); store_plain(a.mix + (size_t)qtok[qt] * 1024 + colb + dt * 32, o, h); }
      ss += __shfl_xor(ss, 32);
      if (h == 0) a.ssm[(size_t)(seg * 4 + head) * S + qtok[qt]] = ss;
    }
  }
}


template <bool B> struct BoolC { static constexpr bool value = B; };
#define SGB(mask, n) __builtin_amdgcn_sched_group_barrier((mask), (n), 0)
template <int MODE>
__device__ __forceinline__ bool attn_pipe(char* lds, const AttnArgs& a, int item) {
  constexpr int KSTR = MODE == 0 ? 208 : 144;
  constexpr int NKS = MODE == 0 ? 6 : 2;
  constexpr int NKP = MODE == 0 ? 3 : 2;
  constexpr int NST = 256;
  constexpr int NQT = MODE == 0 ? 1 : 2;
  int tid_ = threadIdx.x; asm volatile("" : "+v"(tid_));
  const int tid = tid_, lane = tid & 63, wid = tid >> 6, c = lane & 31, h = lane >> 5;
  const int hd = item & 3, qb = item >> 2;
  int qtok[NQT]; const bf16_t* qptr[NQT]; const bf16_t* kbase; const bf16_t* vbase; int k2slot;
  if constexpr (MODE == 0) {
    qtok[0] = qb * 128 + wid * 32 + c; qptr[0] = a.Qa + (size_t)qtok[0] * 384 + hd * 96;
    kbase = a.KN + hd * 64; vbase = a.VtA + (size_t)hd * 64 * VLD; k2slot = hd;
  } else {
#pragma unroll
    for (int qt = 0; qt < 2; ++qt) { qtok[qt] = qb * 128 + wid * 32 + c; qptr[qt] = a.P + (size_t)qtok[qt] * NP + 384 + hd * 64 + qt * 32; }
    kbase = a.P + 640 + hd * 64; vbase = a.Vt + (size_t)hd * 64 * VLD; k2slot = 5 + hd;
  }
  bf16x8 qf[NQT][NKS]; float q2max = 0.f;
#pragma unroll
  for (int qt = 0; qt < NQT; ++qt) { float s = 0.f;
#pragma unroll
    for (int ks = 0; ks < NKS; ++ks) { qf[qt][ks] = *(const bf16x8*)(qptr[qt] + ks * 16 + h * 8);
#pragma unroll
      for (int j = 0; j < 8; ++j) { const float f = bf2f((unsigned short)qf[qt][ks][j]); s += f * f; } }
    s += __shfl_xor(s, 32); q2max = fmaxf(q2max, s); }
#pragma unroll
  for (int o = 16; o; o >>= 1) q2max = fmaxf(q2max, __shfl_xor(q2max, o));
  float k2 = __uint_as_float(a.kmax[k2slot]); if (MODE == 0) k2 += __uint_as_float(a.kmax[4]);
  const float cb = sqrtf(q2max * k2) * 1.01f + 0.01f;
  { volatile int* flag = (volatile int*)(lds + 3 * ABUF);
    if (tid == 0) *flag = 0;
    __syncthreads();
    if (cb > 96.f && lane == 0) *flag = 1;
    __syncthreads();
    if (*flag) return false; }
  f32x16 O[NQT][2]; float l[NQT];
#pragma unroll
  for (int i = 0; i < NQT; ++i) { l[i] = 0.f;
#pragma unroll
    for (int j = 0; j < 2; ++j)
#pragma unroll
      for (int r = 0; r < 16; ++r) O[i][j][r] = 0.f; }

  u32x4 rk[NKP], rv[2];
  auto gload = [&](int st) {
    const int kb = st * 64;
#pragma unroll
    for (int i = 0; i < NKP; ++i) { const int p = tid + 256 * i;
      if (MODE == 0) {
        if (i < 2) { const int row = p >> 3, ch = p & 7; rk[i] = *(const u32x4*)(kbase + (size_t)(kb + row) * 256 + ch * 8); }
        else { const int row = tid >> 2, ch = tid & 3; rk[i] = *(const u32x4*)(a.P + (size_t)(kb + row) * NP + 192 + ch * 8); } }
      else { const int row = p >> 3, ch = p & 7; rk[i] = *(const u32x4*)(kbase + (size_t)(kb + row) * NP + ch * 8); } }
#pragma unroll
    for (int i = 0; i < 2; ++i) { const int p = tid + 256 * i, dv = p >> 3, ch = p & 7; rv[i] = *(const u32x4*)(vbase + (size_t)dv * VLD + kb + ch * 8); }
  };
  auto lstore = [&](int buf) {
    char* b = lds + buf * ABUF;
#pragma unroll
    for (int i = 0; i < NKP; ++i) { const int p = tid + 256 * i;
      if (MODE == 0) { if (i < 2) { const int row = p >> 3, ch = p & 7; *(u32x4*)(b + row * 208 + ch * 16) = rk[i]; } else { const int row = tid >> 2, ch = tid & 3; *(u32x4*)(b + row * 208 + 128 + ch * 16) = rk[i]; } }
      else { const int row = p >> 3, ch = p & 7; *(u32x4*)(b + row * 144 + ch * 16) = rk[i]; } }
#pragma unroll
    for (int i = 0; i < 2; ++i) { const int p = tid + 256 * i, dv = p >> 3, ch = p & 7; *(u32x4*)(b + AKOFF + dv * 144 + ch * 16) = rv[i]; }
  };
  const int koff = c * KSTR + h * 16, voff = AKOFF + c * 144 + h * 16;
#define QK_UNIT(dst, Kb, u) { _Pragma("unroll") for (int r_ = 0; r_ < 16; ++r_) dst[r_] = 0.f; \
    _Pragma("unroll") for (int ks = 0; ks < NKS; ++ks) { \
      const bf16x8 kf = *(const bf16x8*)((Kb) + koff + ((u) / NQT) * 32 * KSTR + (MODE == 1 ? ((u) % NQT) * 64 : 0) + ks * 32); \
      dst = MFMA(kf, qf[(u) % NQT][ks], dst); } }
#define EXP_UNIT(src, u, pf) { float p_[16]; \
    _Pragma("unroll") for (int i = 0; i < 16; ++i) { p_[i] = __builtin_amdgcn_exp2f(src[i]); l[(u) % NQT] += p_[i]; } \
    _Pragma("unroll") for (int s2 = 0; s2 < 2; ++s2) { u32x4 w_; w_.x = pk2(p_[8 * s2], p_[8 * s2 + 1]); w_.y = pk2(p_[8 * s2 + 2], p_[8 * s2 + 3]); \
      w_.z = pk2(p_[8 * s2 + 4], p_[8 * s2 + 5]); w_.w = pk2(p_[8 * s2 + 6], p_[8 * s2 + 7]); pf[s2] = __builtin_bit_cast(bf16x8, w_); } }
#define PV_UNIT(Vb, u, pf) { \
    _Pragma("unroll") for (int dt = 0; dt < 2; ++dt) \
    _Pragma("unroll") for (int s2 = 0; s2 < 2; ++s2) { \
      const bf16x8 vf = *(const bf16x8*)((Vb) + voff + dt * 32 * 144 + ((u) / NQT) * 64 + s2 * 32); \
      O[(u) % NQT][dt] = MFMA(vf, pf[s2], O[(u) % NQT][dt]); } }
#define SCHED_ITER(NM) { SGB(0x100, 2); \
    _Pragma("unroll") for (int i_ = 0; i_ < (NM); ++i_) { SGB(0x008, 1); SGB(0x002, (40 + (NM) - 1) / (NM)); if (i_ + 2 < (NM)) SGB(0x100, 1); } }

  gload(0); lstore(0); gload(1); lstore(1); __syncthreads();
  f32x16 sc, sn;
  QK_UNIT(sc, lds, 0);
  int cur = 0;
  for (int st = 0; st < NST; ++st) {
    const int nxt = cur == 2 ? 0 : cur + 1, wr = nxt == 2 ? 0 : nxt + 1;
    if (st + 2 < NST) gload(st + 2);
    const char* Kc = lds + cur * ABUF; const char* Kn = lds + nxt * ABUF;
    bf16x8 pa[2], pb[2];
    __builtin_amdgcn_sched_barrier(0);
    if constexpr (NQT == 2) {
      QK_UNIT(sn, Kc, 1); EXP_UNIT(sc, 0, pa); SCHED_ITER(NKS); sc = sn;
      __builtin_amdgcn_sched_barrier(0);
      QK_UNIT(sn, Kc, 2); EXP_UNIT(sc, 1, pb); PV_UNIT(Kc, 0, pa); SCHED_ITER(NKS + 4); sc = sn;
      __builtin_amdgcn_sched_barrier(0);
      QK_UNIT(sn, Kc, 3); EXP_UNIT(sc, 2, pa); PV_UNIT(Kc, 1, pb); SCHED_ITER(NKS + 4); sc = sn;
      __builtin_amdgcn_sched_barrier(0);
      QK_UNIT(sn, Kn, 0); EXP_UNIT(sc, 3, pb); PV_UNIT(Kc, 2, pa); SCHED_ITER(NKS + 4); sc = sn;
      __builtin_amdgcn_sched_barrier(0);
      PV_UNIT(Kc, 3, pb);
    } else {
      QK_UNIT(sn, Kc, 1); EXP_UNIT(sc, 0, pa); SCHED_ITER(NKS); sc = sn;
      __builtin_amdgcn_sched_barrier(0);
      QK_UNIT(sn, Kn, 0); EXP_UNIT(sc, 1, pb); PV_UNIT(Kc, 0, pa); SCHED_ITER(NKS + 4); sc = sn;
      __builtin_amdgcn_sched_barrier(0);
      PV_UNIT(Kc, 1, pb);
    }
    __builtin_amdgcn_sched_barrier(0);
    if (st + 2 < NST) lstore(wr);
    __syncthreads();
    cur = nxt;
  }
#undef QK_UNIT
#undef EXP_UNIT
#undef PV_UNIT
#undef SCHED_ITER

#pragma unroll
  for (int qt = 0; qt < NQT; ++qt) l[qt] += __shfl_xor(l[qt], 32);
  if constexpr (MODE == 1) {
    float pa = 0.f, pb = 0.f;
    if (lane < 32) { pa = a.lq1[lane] * a.lk1[lane]; pb = a.lq2[lane] * a.lk2[lane]; }
#pragma unroll
    for (int o = 32; o; o >>= 1) { pa += __shfl_xor(pa, o); pb += __shfl_xor(pb, o); }
    const float lam = expf(pa) - expf(pb) + a.lam_init;
    const float i0 = 1.f / l[0], i1 = lam / l[1];
    f32x16 o[2]; float ss = 0.f;
#pragma unroll
    for (int dt = 0; dt < 2; ++dt)
#pragma unroll
      for (int r = 0; r < 16; ++r) { o[dt][r] = O[0][dt][r] * i0 - O[1][dt][r] * i1; ss += o[dt][r] * o[dt][r]; }
    ss += __shfl_xor(ss, 32);
    const float rn = rsqrtf(ss * (1.f / 64.f) + EPS) * (1.f - a.lam_init);
#pragma unroll
    for (int dt = 0; dt < 2; ++dt) {
#pragma unroll
      for (int g = 0; g < 4; ++g) { const f32x4 gg = *(const f32x4*)(a.subln + dt * 32 + 8 * g + 4 * h);
#pragma unroll
        for (int i = 0; i < 4; ++i) o[dt][4 * g + i] *= rn * gg[i]; }
      store_plain(a.mix + (size_t)qtok[0] * 1024 + 256 + hd * 64 + dt * 32, o[dt], h);
    }
  } else {
#pragma unroll
    for (int qt = 0; qt < NQT; ++qt) {
      const float inv = 1.f / l[qt]; float ss = 0.f;
#pragma unroll
      for (int dt = 0; dt < 2; ++dt) { f32x16 o = O[qt][dt] * inv; ss += sumsq16(o); store_plain(a.mix + (size_t)qtok[qt] * 1024 + hd * 64 + dt * 32, o, h); }
      ss += __shfl_xor(ss, 32);
      if (h == 0) a.ssm[(size_t)hd * S + qtok[qt]] = ss;
    }
  }
  return true;
}

template <class F>
__device__ __forceinline__ void conv_tile(float* tl, bf16_t* out, int K, int n0, int k0, const F& f) {
  int tid_ = threadIdx.x; asm volatile("" : "+v"(tid_));
  const int tid = tid_, tx = tid & 63, ty = tid >> 6;
#pragma unroll 4
  for (int i = 0; i < 16; ++i) { const int k = ty + 4 * i; tl[k * 65 + tx] = f(k0 + k, n0 + tx); }
  __syncthreads();
  const int kx2 = (tid & 31) * 2, ny = tid >> 5;
#pragma unroll 4
  for (int i = 0; i < 8; ++i) { const int n = ny + 8 * i; *(unsigned*)(out + (size_t)(n0 + n) * K + k0 + kx2) = pk2(tl[kx2 * 65 + n], tl[(kx2 + 1) * 65 + n]); }
  __syncthreads();
}

__device__ void conv_layer(char* lds, const Params& p, int l) {
  float* tl = (float*)lds; char* ws = p.ws;
  const float* w_in = p.w_in + (size_t)l * 1024 * 2400; const float* g1 = p.norm1_g + l * 1024;
  const float* w_out = p.w_out + (size_t)l * 1024 * 1024; const float* gm = p.g_mla + l * 256; const float* gs = p.g_swa + l * 256; const float* gn = p.g_na + l * 256;
  const float* w_up = p.w_up + (size_t)l * 1024 * 4096; const float* g2 = p.norm2_g + l * 1024;
  const float* w_dn = p.w_down + (size_t)l * 4096 * 1024;
  const float* w_uq = p.w_uq + (size_t)l * 192 * 384; const float* qg = p.qn_g + l * 192;
  const float* w_uk = p.w_uk + (size_t)l * 128 * 256; const float* w_uv = p.w_uv + (size_t)l * 128 * 256; const float* kg = p.kvn_g + l * 128;
  const float sB = 0.17677669529663687f * LOG2E, sC = 0.125f * LOG2E, sA = 0.10206207261596577f * LOG2E;
  for (int t = bid_(); t < 2946; t += gridDim.x) {
    if (t < 608) { const int nt = t >> 4, kt = t & 15;
      conv_tile(tl, (bf16_t*)(ws + OFF_WIN), 1024, nt * 64, kt * 64, [&](int k, int n) -> float {
        int src; if (n < 192) src = n; else if (n < 224) src = 320 + n - 192; else if (n < 256) src = -1; else if (n < 384) src = 192 + n - 256; else src = 352 + n - 384;
        if (src < 0) return 0.f;
        float sc = 1.f; if (n >= 384 && n < 640) sc = sB; else if ((n >= 1152 && n < 1408) || (n >= 1664 && n < 1920)) sc = sC;
        return w_in[(size_t)k * 2400 + src] * g1[k] * sc; });
    } else if (t < 864) { const int u = t - 608, nt = u >> 4, kt = u & 15;
      conv_tile(tl, (bf16_t*)(ws + OFF_WOUT), 1024, nt * 64, kt * 64, [&](int k, int n) -> float {
        const float g = k < 256 ? gm[k] : (k < 512 ? 1.f : (k < 768 ? gs[k - 512] : gn[k - 768]));
        return w_out[(size_t)k * 1024 + n] * g; });
    } else if (t < 1888) { const int u = t - 864, nt = u >> 4, kt = u & 15;
      conv_tile(tl, (bf16_t*)(ws + OFF_WUP), 1024, nt * 64, kt * 64, [&](int k, int n) -> float { return w_up[(size_t)k * 4096 + n] * g2[k]; });
    } else if (t < 2912) { const int u = t - 1888, nt = u >> 6, kt = u & 63;
      conv_tile(tl, (bf16_t*)(ws + OFF_WDN), 4096, nt * 64, kt * 64, [&](int k, int n) -> float { return w_dn[(size_t)k * 1024 + n]; });
    } else if (t < 2930) { const int u = t - 2912, nt = u / 3, kt = u % 3;
      conv_tile(tl, (bf16_t*)(ws + OFF_WUQ), 192, nt * 64, kt * 64, [&](int k, int n) -> float { return w_uq[(size_t)k * 384 + n] * qg[k] * sA; });
    } else { const int u = t - 2930, nt = u >> 1, kt = u & 1;
      conv_tile(tl, (bf16_t*)(ws + OFF_WKV), 128, nt * 64, kt * 64, [&](int k, int n) -> float {
        return (n < 256 ? w_uk[(size_t)k * 256 + n] : w_uv[(size_t)k * 256 + n - 256]) * kg[k]; });
    }
  }
}

__device__ __forceinline__ void gbar(unsigned* base) {
  __syncthreads();
  if (threadIdx.x == 0) {
    __builtin_amdgcn_fence(__ATOMIC_RELEASE, "agent");
    const unsigned g = blockIdx.x & 15u, ng = gridDim.x >> 4;
    unsigned* cnt = base + g * 32; unsigned* root = base + 16 * 32; unsigned* gen = base + (17 + g) * 32;
    const unsigned old = __hip_atomic_load(gen, __ATOMIC_RELAXED, __HIP_MEMORY_SCOPE_AGENT);
    if (__hip_atomic_fetch_add(cnt, 1u, __ATOMIC_RELAXED, __HIP_MEMORY_SCOPE_AGENT) == ng - 1u) {
      __hip_atomic_store(cnt, 0u, __ATOMIC_RELAXED, __HIP_MEMORY_SCOPE_AGENT);
      __builtin_amdgcn_fence(__ATOMIC_RELEASE, "agent");
      if (__hip_atomic_fetch_add(root, 1u, __ATOMIC_RELAXED, __HIP_MEMORY_SCOPE_AGENT) == 15u) {
        __hip_atomic_store(root, 0u, __ATOMIC_RELAXED, __HIP_MEMORY_SCOPE_AGENT);
        __builtin_amdgcn_fence(__ATOMIC_RELEASE, "agent");
        for (unsigned k = 0; k < 16; ++k) __hip_atomic_fetch_add(base + (17 + k) * 32, 1u, __ATOMIC_RELAXED, __HIP_MEMORY_SCOPE_AGENT);
      }
    }
    while (__hip_atomic_load(gen, __ATOMIC_RELAXED, __HIP_MEMORY_SCOPE_AGENT) == old) __builtin_amdgcn_s_sleep(2);
    __builtin_amdgcn_fence(__ATOMIC_ACQUIRE, "agent");
  }
  __syncthreads();
}

__device__ __forceinline__ void sincos_acc(float ang, float& sn, float& cs) {
  const double a = (double)ang; const double n = rint(a * 0.15915494309189535);
  const double r = a - n * 6.283185307179586476925; const double r2 = r * r;
  double s = -1.0 / 51090942171709440000.0;
  s = s * r2 + 1.0 / 121645100408832000.0; s = s * r2 - 1.0 / 355687428096000.0; s = s * r2 + 1.0 / 1307674368000.0; s = s * r2 - 1.0 / 6227020800.0;
  s = s * r2 + 1.0 / 39916800.0; s = s * r2 - 1.0 / 362880.0; s = s * r2 + 1.0 / 5040.0; s = s * r2 - 1.0 / 120.0; s = s * r2 + 1.0 / 6.0; s = s * r2 - 1.0; s = -s * r;
  double c = 1.0 / 1124000727777607680000.0;
  c = c * r2 - 1.0 / 2432902008176640000.0; c = c * r2 + 1.0 / 6402373705728000.0; c = c * r2 - 1.0 / 20922789888000.0; c = c * r2 + 1.0 / 87178291200.0;
  c = c * r2 - 1.0 / 479001600.0; c = c * r2 + 1.0 / 3628800.0; c = c * r2 - 1.0 / 40320.0; c = c * r2 + 1.0 / 720.0; c = c * r2 - 1.0 / 24.0; c = c * r2 + 0.5; c = 1.0 - c * r2;
  sn = (float)s; cs = (float)c;
}

__global__ void __launch_bounds__(256, 2) mega(Params p) {
  cg::grid_group grid = cg::this_grid();
  __shared__ __attribute__((aligned(16))) char lds[73728];
  __shared__ int s_item; __shared__ int s_q[2];
#ifdef PROBE_SEL
  __shared__ unsigned long long s_t[10];
  if (threadIdx.x == 0) { for (int i = 0; i < 9; ++i) s_t[i] = 0; s_t[9] = __builtin_amdgcn_s_memrealtime(); }
#define TSTAMP(k) { if (blockIdx.x == 0 && threadIdx.x == 0) { const unsigned long long t_ = __builtin_amdgcn_s_memrealtime(); s_t[k] += t_ - s_t[9]; s_t[9] = t_; } }
#else
#define TSTAMP(k)
#endif
#define GBAR { size_t wz2_ = 0; asm volatile("" : "+s"(wz2_)); gbar((unsigned*)(p.ws + OFF_CTRL + wz2_) + 1024); }
#define WSPTRS \
  size_t wz_ = 0; asm volatile("" : "+s"(wz_)); char* ws = p.ws + wz_; \
  bf16_t* XB = (bf16_t*)(ws + OFF_XB); bf16_t* MIX = (bf16_t*)(ws + OFF_MIX); bf16_t* P = (bf16_t*)(ws + OFF_P); bf16_t* VT = (bf16_t*)(ws + OFF_VT); \
  bf16_t* QA = (bf16_t*)(ws + OFF_QA); bf16_t* KN = (bf16_t*)(ws + OFF_KN); bf16_t* VTA = (bf16_t*)(ws + OFF_VTA); bf16_t* H = (bf16_t*)(ws + OFF_H); \
  float* C32 = (float*)(ws + OFF_TAB); float* S32 = C32 + S * 16; float* C64 = S32 + S * 16; float* S64 = C64 + S * 32; \
  float* SSX = (float*)(ws + OFF_SSX); float* SSA = (float*)(ws + OFF_SSA); float* SSM = (float*)(ws + OFF_SSM); \
  unsigned* CTRL = (unsigned*)(ws + OFF_CTRL); unsigned* kmax = CTRL + 16 + 16 * l; \
  (void)XB; (void)MIX; (void)P; (void)VT; (void)QA; (void)KN; (void)VTA; (void)H; (void)C32; (void)S32; (void)C64; (void)S64; (void)SSX; (void)SSA; (void)SSM; (void)CTRL; (void)kmax;

  { const int l = 0; WSPTRS
  int tid_ = threadIdx.x; asm volatile("" : "+v"(tid_));
  const int tid = tid_, lane = tid & 63, wid = tid >> 6, gw = bid_() * 4 + wid, nw = gridDim.x * 4;
  if (blockIdx.x == 0) { for (int i = tid; i < 4096; i += 256) CTRL[i] = 0u; }
  for (int row = gw; row < S; row += nw) {
    const f32x4* xr = (const f32x4*)(p.x + (size_t)row * 1024); float s = 0.f;
#pragma unroll
    for (int i = 0; i < 4; ++i) { const f32x4 v = xr[lane + 64 * i]; s += v[0] * v[0] + v[1] * v[1] + v[2] * v[2] + v[3] * v[3];
      u32x2 w; w.x = pk2(v[0], v[1]); w.y = pk2(v[2], v[3]); *(u32x2*)(XB + (size_t)row * 1024 + (lane + 64 * i) * 4) = w; }
#pragma unroll
    for (int o = 32; o; o >>= 1) s += __shfl_xor(s, o);
    if (lane < 16) SSX[(size_t)row * 16 + lane] = lane == 0 ? s : 0.f;
  }
  for (int idx = bid_() * 256 + tid; idx < S * 48; idx += gridDim.x * 256) {
    const int pos = idx / 48, i = idx - pos * 48; float sn, cs;
    if (i < 16) { const float inv = 1.0f / powf(10000.f, (float)(2 * i) / 32.f); sincos_acc((float)pos * inv, sn, cs); C32[pos * 16 + i] = cs; S32[pos * 16 + i] = sn; }
    else { const int j = i - 16; const float inv = 1.0f / powf(10000.f, (float)(2 * j) / 64.f); sincos_acc((float)pos * inv, sn, cs); C64[pos * 32 + j] = cs; S64[pos * 32 + j] = sn; }
  }
  }

#pragma unroll 1
  for (int l = 0; l < 4; ++l) {
    conv_layer(lds, p, l);
    if (l == 0) grid.sync(); else GBAR;
    TSTAMP(0)
    { WSPTRS GemmArgs g{XB, 1024, (const bf16_t*)(ws + OFF_WIN), 1024, 1024, nullptr};
      EpiIn e{P, VT, SSX, SSA, C32, S32, C64, S64, kmax};
      bool st_ = false;
      for (int t = bid_(); t < 128 * 19; t += gridDim.x) { const int u = remap8(t, 128 * 19); const int tn = t + (int)gridDim.x; const bool hn = tn < 128 * 19; const int un = hn ? remap8(tn, 128 * 19) : 0;
        gemm_tile<false>(lds, g, (u / 19) * 128, (u % 19) * 128, e, st_, hn ? (un / 19) * 128 : -1, (un % 19) * 128); st_ = hn; } }
    GBAR; TSTAMP(1)
    { WSPTRS GemmArgs gq{P, NP, (const bf16_t*)(ws + OFF_WUQ), 192, 192, nullptr}; EpiUq eq{QA, SSA, C32, S32};
      GemmArgs gk{P + 256, NP, (const bf16_t*)(ws + OFF_WKV), 128, 128, nullptr}; EpiKv ek{KN, VTA, SSA, kmax};
      for (int t = bid_(); t < 896; t += gridDim.x) { const int u = remap8(t, 896);
        if (u < 384) gemm_tile<false>(lds, gq, (u / 3) * 128, (u % 3) * 128, eq);
        else { const int v = u - 384; gemm_tile<false>(lds, gk, (v >> 2) * 128, (v & 3) * 128, ek); } } }
    GBAR; TSTAMP(2)
    { WSPTRS AttnArgs a{P, VT, QA, KN, VTA, MIX, SSM, kmax, p.lq1 + l * 32, p.lk1 + l * 32, p.lq2 + l * 32, p.lk2 + l * 32, p.subln_g + l * 64, p.sinks + l * 4,
                 p.rpb + l * 4 * 465, p.lam_init[l]};
      unsigned* ctr = CTRL + 128 + 32 * l;
      if (threadIdx.x == 0) { int z_ = 0; asm volatile("" : "+v"(z_)); s_q[0] = z_; s_q[1] = z_; }
      for (;;) {
        if (threadIdx.x == 0) {
          const int xcc = (int)(__builtin_amdgcn_s_getreg((3 << 11) | 20) & 7u);
          const int pq_ = s_q[0]; int pass = pq_ >> 3, dq = pq_ & 7;
          int it = -1;
          if (((blockIdx.x >> 8) & 1u) && s_q[1] < 2) { const int idx = (int)atomicAdd(ctr + 16, 1u); if (idx < 1024) { it = 2048 + idx; s_q[1] = s_q[1] + 1; } else s_q[1] = 2; }
          if (it < 0)
          while (pass < 2) {
            const int ep = pass ^ (int)((blockIdx.x >> 8) & 1u);
            const int q = (xcc + dq) & 7; const int idx = (int)atomicAdd(ctr + ep * 8 + q, 1u);
            if (idx < 64) { it = ep * 1024 + (((((q >> 2) * 64 + idx) << 2)) | (q & 3)); break; }
            if (++dq == 8) { dq = 0; ++pass; }
          }
          if (it < 0) { const int idx = (int)atomicAdd(ctr + 16, 1u); it = idx < 1024 ? 2048 + idx : -1; }
          s_item = it; s_q[0] = pass * 8 + dq;
        }
        __syncthreads(); const int item = s_item; __syncthreads();
        if (item < 0) break;
        if (item < 1024) { if (!attn_pipe<1>(lds, a, item)) attn_item<1>(lds, a, item); }
        else if (item < 2048) { if (!attn_pipe<0>(lds, a, item - 1024)) attn_item<0>(lds, a, item - 1024); }
        else if (item < 2560) attn_item<2>(lds, a, item - 2048);
        else attn_item<3>(lds, a, item - 2560);
      } }
    TSTAMP(7)
    GBAR; TSTAMP(3)
    { WSPTRS GemmArgs g{MIX, 1024, (const bf16_t*)(ws + OFF_WOUT), 1024, 1024, SSM};
      EpiRes e{XB, SSX};
      bool st_ = false;
      for (int t = bid_(); t < 1024; t += gridDim.x) { const int u = remap8(t, 1024); const int tn = t + (int)gridDim.x; const bool hn = tn < 1024; const int un = hn ? remap8(tn, 1024) : 0;
        gemm_tile<true>(lds, g, (u >> 3) * 128, (u & 7) * 128, e, st_, hn ? (un >> 3) * 128 : -1, (un & 7) * 128); st_ = hn; } }
    GBAR; TSTAMP(4)
    { WSPTRS GemmArgs g{XB, 1024, (const bf16_t*)(ws + OFF_WUP), 1024, 1024, nullptr}; EpiUp4 e{H, SSX};
      gemm_stream<false>(lds, g, 32, 2048, e); }
    GBAR; TSTAMP(5)
    { WSPTRS GemmArgs g{H, 4096, (const bf16_t*)(ws + OFF_WDN), 4096, 4096, nullptr}; EpiRes e{XB, SSX};
      bool st_ = false;
      for (int t = bid_(); t < 1024; t += gridDim.x) { const int u = remap8(t, 1024); const int tn = t + (int)gridDim.x; const bool hn = tn < 1024; const int un = hn ? remap8(tn, 1024) : 0;
        gemm_tile<false>(lds, g, (u >> 3) * 128, (u & 7) * 128, e, st_, hn ? (un >> 3) * 128 : -1, (un & 7) * 128); st_ = hn; } }
    GBAR; TSTAMP(6)
  }
  const int l = 0; WSPTRS
  int tid_ = threadIdx.x; asm volatile("" : "+v"(tid_));
  const int lane = tid_ & 63, gw = bid_() * 4 + (tid_ >> 6), nw = gridDim.x * 4;
  for (int row = gw; row < S; row += nw) {
    const float rr = rowscale_ssx(SSX, row);
    const u32x2* xr = (const u32x2*)(XB + (size_t)row * 1024); f32x4* orow = (f32x4*)(p.out + (size_t)row * 1024);
#pragma unroll
    for (int i = 0; i < 4; ++i) { const u32x2 w = xr[lane + 64 * i]; const f32x4 g = ((const f32x4*)p.fin_g)[lane + 64 * i]; f32x4 v;
      v[0] = bf2f(w.x & 0xffffu); v[1] = __uint_as_float(w.x & 0xffff0000u); v[2] = bf2f(w.y & 0xffffu); v[3] = __uint_as_float(w.y & 0xffff0000u);
      orow[lane + 64 * i] = v * rr * g; }
  }
#ifdef PROBE_SEL
  { const int l = 0; WSPTRS
    if (blockIdx.x == 0 && threadIdx.x == 0) {
      unsigned long long tot = 0, sel = 0;
      for (int i = 0; i < 9; ++i) { tot += s_t[i]; if ((PROBE_SEL >> i) & 1) sel += s_t[i]; }
      ((float*)CTRL)[500] = (float)((double)sel / (double)tot);
    }
    grid.sync();
    const float fr = ((const float*)CTRL)[500];
    for (int row = gw; row < 64; row += nw) {
      f32x4* xr = (f32x4*)(p.out + (size_t)row * 1024);
      for (int i = 0; i < 4; ++i) { f32x4 v = xr[lane + 64 * i]; const float d = 0.05f * fr; v[0] += d; v[1] -= d; v[2] += d; v[3] -= d; xr[lane + 64 * i] = v; }
    }
  }
#endif
}

extern "C" void kernel_launch(void* const* d_in, const int* in_sizes, int n_in, void* d_out, int out_size,
                              void* d_ws, size_t ws_size, hipStream_t stream) {
  static int grid_blocks = 0;
  if (!grid_blocks) {
    int dev = 0, cus = 0, per_cu = 0;
    (void)hipGetDevice(&dev);
    (void)hipDeviceGetAttribute(&cus, hipDeviceAttributeMultiprocessorCount, dev);
    (void)hipOccupancyMaxActiveBlocksPerMultiprocessor(&per_cu, mega, 256, 0);
    per_cu = 2;
    grid_blocks = cus * per_cu;
  }
  Params p{};
  const float** pp = (const float**)&p;
  for (int i = 0; i < 23; ++i) pp[i] = (const float*)d_in[i];
  p.out = (float*)d_out; p.ws = (char*)d_ws;
  for (int l = 0; l < 4; ++l) p.lam_init[l] = (float)(0.8 - 0.6 * exp(-0.3 * (double)l));
  void* args[] = {&p};
  hipError_t e = hipLaunchCooperativeKernel((void*)mega, dim3(grid_blocks), dim3(256), args, 0, stream);
  if (e != hipSuccess) fprintf(stderr, "cooperative launch failed: %s (grid %d)\n", hipGetErrorString(e), grid_blocks);
}
```

```cpp
#include <hip/hip_runtime.h>
#include <hip/hip_cooperative_groups.h>
#include <cstdio>
#include <cmath>
namespace cg = cooperative_groups;

typedef unsigned short bf16_t;
typedef short bf16x8 __attribute__((ext_vector_type(8)));
typedef float f32x16 __attribute__((ext_vector_type(16)));
typedef float f32x4 __attribute__((ext_vector_type(4)));
typedef float f32x2 __attribute__((ext_vector_type(2)));
typedef unsigned u32x2 __attribute__((ext_vector_type(2)));
typedef unsigned u32x4 __attribute__((ext_vector_type(4)));
typedef __bf16 bf2_t __attribute__((ext_vector_type(2)));

constexpr int S = 16384, NP = 2432, VLD = S + 128;
constexpr float EPS = 1e-6f, LOG2E = 1.4426950408889634f;

constexpr size_t OFF_WIN = 0;
constexpr size_t OFF_WOUT = OFF_WIN + (size_t)NP * 1024 * 2;
constexpr size_t OFF_WUP = OFF_WOUT + (size_t)1024 * 1024 * 2;
constexpr size_t OFF_WDN = OFF_WUP + (size_t)4096 * 1024 * 2;
constexpr size_t OFF_WUQ = OFF_WDN + (size_t)4096 * 1024 * 2;
constexpr size_t OFF_WKV = OFF_WUQ + (size_t)384 * 192 * 2;
constexpr size_t OFF_XB = OFF_WKV + (size_t)512 * 128 * 2;
constexpr size_t OFF_MIX = OFF_XB + (size_t)S * 1024 * 2;
constexpr size_t OFF_R1 = OFF_MIX + (size_t)S * 1024 * 2;
constexpr size_t OFF_P = OFF_R1;
constexpr size_t OFF_VT = OFF_P + (size_t)S * NP * 2;
constexpr size_t OFF_QA = OFF_VT + (size_t)640 * VLD * 2;
constexpr size_t OFF_KN = OFF_QA + (size_t)S * 384 * 2;
constexpr size_t OFF_VTA = OFF_KN + (size_t)S * 256 * 2;
constexpr size_t OFF_H = OFF_R1;
constexpr size_t OFF_TAB = OFF_R1 + (size_t)S * 4096 * 2;
constexpr size_t OFF_SSX = OFF_TAB + (size_t)S * 96 * 4;
constexpr size_t OFF_SSA = OFF_SSX + (size_t)S * 16 * 4;
constexpr size_t OFF_SSM = OFF_SSA + (size_t)S * 8 * 4;
constexpr size_t OFF_CTRL = OFF_SSM + (size_t)12 * S * 4;
static_assert(OFF_VTA + (size_t)256 * VLD * 2 <= OFF_TAB, "overlay");

struct Params {
  const float *x, *norm1_g, *w_in, *qn_g, *w_uq, *kvn_g, *w_uk, *w_uv, *lq1, *lk1, *lq2, *lk2, *subln_g, *sinks, *rpb,
      *g_mla, *g_swa, *g_na, *w_out, *norm2_g, *w_up, *w_down, *fin_g;
  float* out; char* ws; float lam_init[4];
};

__device__ __forceinline__ unsigned pk2(float a, float b) { bf2_t r = __builtin_convertvector((f32x2){a, b}, bf2_t); return __builtin_bit_cast(unsigned, r); }
__device__ __forceinline__ bf16_t f2bf(float a) { return (bf16_t)(pk2(a, 0.f) & 0xffffu); }
__device__ __forceinline__ float bf2f(unsigned v) { return __uint_as_float(v << 16); }
__device__ __forceinline__ int crow(int r, int h) { return (r & 3) + 8 * (r >> 2) + 4 * h; }
__device__ __forceinline__ int permtok(int t) { return (t & ~12) | ((t & 4) << 1) | ((t & 8) >> 1); }
__device__ __forceinline__ int remap8(int t, int T) { return (t & 7) * (T >> 3) + (t >> 3); }
__device__ __forceinline__ int bid_() { int b = blockIdx.x; asm volatile("" : "+s"(b)); return b; }
#define MFMA(a, b, c) __builtin_amdgcn_mfma_f32_32x32x16_bf16((a), (b), (c), 0, 0, 0)

struct GemmArgs { const bf16_t* A; int lda; const bf16_t* Bt; int ldb; int K; const float* asc; };

#define LAS3 __attribute__((address_space(3)))
template <int V> struct IntC { static constexpr int value = V; };
__device__ __forceinline__ float seg_rscale(const float* asc, int seg, int tok) {
  if (seg == 1) return 1.f;
  const int idx = seg == 0 ? 0 : (seg == 2 ? 1 : 2);
  const float* sp = asc + (size_t)idx * 4 * S + tok;
  return rsqrtf((sp[0] + sp[S] + sp[2 * S] + sp[3 * S]) * (1.f / 256.f) + EPS);
}
template <bool ASC, class Epi>
__device__ __forceinline__ void gemm_tile(char* lds, const GemmArgs& g, int m0, int n0, const Epi& epi, bool staged = false, int nm0 = -1, int nn0 = 0) {
  int tid_ = threadIdx.x; asm volatile("" : "+v"(tid_));
  const int tid = tid_, lane = tid & 63, wid = __builtin_amdgcn_readfirstlane(tid >> 6), wr = wid >> 1, wc = wid & 1, c = lane & 31, h = lane >> 5;
  f32x16 acc[2][2];
#pragma unroll
  for (int i = 0; i < 2; ++i)
#pragma unroll
    for (int j = 0; j < 2; ++j)
#pragma unroll
      for (int r = 0; r < 16; ++r) acc[i][j][r] = 0.f;
  const int prow = tid >> 3, gch = (tid & 7) ^ ((prow >> 1) & 7);
  const bf16_t* Ap; Ap = g.A + (size_t)(m0 + prow) * g.lda + gch * 8;
  const bf16_t* Bp; Bp = g.Bt + (size_t)(n0 + prow) * g.ldb + gch * 8;
  (void)0;
  const size_t astep = (size_t)32 * g.lda, bstep = (size_t)32 * g.ldb;
  LAS3 char* l3 = (LAS3 char*)lds;
  const int nk = g.K >> 6;
  auto stage = [&](int kt, auto BUFC) {
    constexpr int buf = decltype(BUFC)::value;
#pragma unroll
    for (int i = 0; i < 4; ++i) {
      __builtin_amdgcn_global_load_lds((const unsigned*)(Ap + i * astep + kt * 64), (LAS3 unsigned*)(l3 + buf * 32768 + (256 * i + 64 * wid) * 16), 16, 0, 0);
      __builtin_amdgcn_global_load_lds((const unsigned*)(Bp + i * bstep + kt * 64), (LAS3 unsigned*)(l3 + buf * 32768 + 16384 + (256 * i + 64 * wid) * 16), 16, 0, 0);
    }
  };
  const int swz = (c >> 1) & 7;
  const unsigned lbase = (unsigned)(size_t)l3;
  const unsigned aoff = (wr * 64 + c) * 128, boff = 16384 + (wc * 64 + c) * 128;
  unsigned kofs[4];
#pragma unroll
  for (int ks = 0; ks < 4; ++ks) kofs[ks] = ((2 * ks + h) ^ swz) << 4;
  float rcur[2] = {1.f, 1.f};
  if (ASC) { rcur[0] = seg_rscale(g.asc, 0, m0 + wr * 64 + c); rcur[1] = seg_rscale(g.asc, 0, m0 + wr * 64 + 32 + c); }
  if (!staged) stage(0, IntC<0>{});
  asm volatile("s_waitcnt vmcnt(0)" ::: "memory"); __syncthreads();
  auto body = [&](int kt, auto BUFC) {
    constexpr int buf = decltype(BUFC)::value;
    if (kt + 1 < nk) stage(kt + 1, IntC<1 - buf>{});
    if (ASC) { if (kt > 0 && (kt & 3) == 0) {
#pragma unroll
      for (int mt = 0; mt < 2; ++mt) { const float rn = seg_rscale(g.asc, kt >> 2, m0 + wr * 64 + mt * 32 + c); const float f = rcur[mt] / rn; rcur[mt] = rn;
        acc[mt][0] = acc[mt][0] * f; acc[mt][1] = acc[mt][1] * f; } } }
    bf16x8 fr[2][4];
#define GRD(set, ks) { const unsigned aa_ = lbase + buf * 32768 + aoff + kofs[ks], bb_ = lbase + buf * 32768 + boff + kofs[ks]; \
      asm volatile("ds_read_b128 %0, %1" : "=v"(fr[set][0]) : "v"(aa_)); asm volatile("ds_read_b128 %0, %1 offset:4096" : "=v"(fr[set][1]) : "v"(aa_)); \
      asm volatile("ds_read_b128 %0, %1" : "=v"(fr[set][2]) : "v"(bb_)); asm volatile("ds_read_b128 %0, %1 offset:4096" : "=v"(fr[set][3]) : "v"(bb_)); }
    GRD(0, 0);
#pragma unroll
    for (int ks = 0; ks < 4; ++ks) {
      if (ks < 3) { GRD((ks + 1) & 1, ks + 1); asm volatile("s_waitcnt lgkmcnt(4)" : "+v"(fr[ks & 1][0]), "+v"(fr[ks & 1][1]), "+v"(fr[ks & 1][2]), "+v"(fr[ks & 1][3])); }
      else asm volatile("s_waitcnt lgkmcnt(0)" : "+v"(fr[ks & 1][0]), "+v"(fr[ks & 1][1]), "+v"(fr[ks & 1][2]), "+v"(fr[ks & 1][3]));
      __builtin_amdgcn_s_setprio(1);
#pragma unroll
      for (int mt = 0; mt < 2; ++mt)
#pragma unroll
        for (int nt = 0; nt < 2; ++nt) acc[mt][nt] = MFMA(fr[ks & 1][2 + nt], fr[ks & 1][mt], acc[mt][nt]);
      __builtin_amdgcn_s_setprio(0);
    }
#undef GRD
    asm volatile("s_waitcnt vmcnt(0)" ::: "memory"); __builtin_amdgcn_s_barrier(); asm volatile("" ::: "memory");
  };
  for (int kt = 0; kt < nk; kt += 2) { body(kt, IntC<0>{}); if (kt + 1 < nk) body(kt + 1, IntC<1>{}); }
  if constexpr (Epi::kLds) {
    if (ASC) {
#pragma unroll
      for (int mt = 0; mt < 2; ++mt) { acc[mt][0] = acc[mt][0] * rcur[mt]; acc[mt][1] = acc[mt][1] * rcur[mt]; } }
    epi(acc, m0, n0, wr, wc, c, h, lds);
    if (nm0 >= 0) { Ap = g.A + (size_t)(nm0 + prow) * g.lda + gch * 8; Bp = g.Bt + (size_t)(nn0 + prow) * g.ldb + gch * 8; stage(0, IntC<0>{}); }
  } else {
  if (nm0 >= 0) {
    Ap = g.A + (size_t)(nm0 + prow) * g.lda + gch * 8; Bp = g.Bt + (size_t)(nn0 + prow) * g.ldb + gch * 8;
    stage(0, IntC<0>{});
  }
  if (ASC) {
#pragma unroll
    for (int mt = 0; mt < 2; ++mt) { acc[mt][0] = acc[mt][0] * rcur[mt]; acc[mt][1] = acc[mt][1] * rcur[mt]; } }
  epi(acc, m0, n0, wr, wc, c, h);
  }
}

__device__ __forceinline__ void tile_rc256(int t, int NT, int& m0, int& n0) {
  const int x = t & 7, j = t >> 3;
  m0 = (x * 8 + (j & 7)) * 256; n0 = (j >> 3) * 128; (void)NT;
}
template <bool ASC, class Epi>
__device__ __forceinline__ void gemm_stream(char* lds, const GemmArgs& g, int NT, int ntiles, const Epi& epi) {
  int tid_ = threadIdx.x; asm volatile("" : "+v"(tid_));
  const int tid = tid_, lane = tid & 63, wid = __builtin_amdgcn_readfirstlane(tid >> 6), wr = wid >> 1, wc = wid & 1, c = lane & 31, h = lane >> 5;
  const int b = bid_(), G = (int)gridDim.x;
  __builtin_amdgcn_s_barrier();
  if (b >= ntiles) return;
  const int nk = g.K >> 5, my_tiles = (ntiles - b + G - 1) / G, total = my_tiles * nk;
  LAS3 char* l3 = (LAS3 char*)lds;
  const unsigned lbase = (unsigned)(size_t)l3;
  const int prow = tid >> 2, gch = (tid & 3) ^ ((tid >> 4) & 3);
  int s_t = b, s_kt = 0, sm0, sn0; tile_rc256(s_t, NT, sm0, sn0);
  const bf16_t* Ap = g.A + (size_t)(sm0 + prow) * g.lda + gch * 8;
  const bf16_t* Bp = g.Bt + (size_t)(sn0 + prow) * g.ldb + gch * 8;
  const size_t astep = (size_t)64 * g.lda, bstep = (size_t)64 * g.ldb;
  auto stage = [&](int slot) {
    LAS3 char* d = l3 + slot * 24576 + wid * 1024;
    __builtin_amdgcn_global_load_lds((const unsigned*)(Ap), (LAS3 unsigned*)(d), 16, 0, 0);
    __builtin_amdgcn_global_load_lds((const unsigned*)(Ap + astep), (LAS3 unsigned*)(d + 4096), 16, 0, 0);
    __builtin_amdgcn_global_load_lds((const unsigned*)(Ap + 2 * astep), (LAS3 unsigned*)(d + 8192), 16, 0, 0);
    __builtin_amdgcn_global_load_lds((const unsigned*)(Ap + 3 * astep), (LAS3 unsigned*)(d + 12288), 16, 0, 0);
    __builtin_amdgcn_global_load_lds((const unsigned*)(Bp), (LAS3 unsigned*)(d + 16384), 16, 0, 0);
    __builtin_amdgcn_global_load_lds((const unsigned*)(Bp + bstep), (LAS3 unsigned*)(d + 20480), 16, 0, 0);
    Ap += 32; Bp += 32;
    if (++s_kt == nk) { s_kt = 0; s_t += G; if (s_t < ntiles) { tile_rc256(s_t, NT, sm0, sn0);
        Ap = g.A + (size_t)(sm0 + prow) * g.lda + gch * 8; Bp = g.Bt + (size_t)(sn0 + prow) * g.ldb + gch * 8; } }
  };
  int c_t = b, c_kt = 0, cm0, cn0; tile_rc256(c_t, NT, cm0, cn0);
  f32x16 acc[4][2];
#pragma unroll
  for (int i = 0; i < 4; ++i)
#pragma unroll
    for (int j = 0; j < 2; ++j)
#pragma unroll
      for (int r = 0; r < 16; ++r) acc[i][j][r] = 0.f;
  const unsigned swz = (c >> 2) & 3;
  const unsigned aoff = (wr * 128 + c) * 64, boff = 16384 + (wc * 64 + c) * 64;
  const unsigned ko0 = ((0 + h) ^ swz) << 4, ko1 = ((2 + h) ^ swz) << 4;
  float rcur[4] = {1.f, 1.f, 1.f, 1.f};
  if (ASC) {
#pragma unroll
    for (int mt = 0; mt < 4; ++mt) rcur[mt] = seg_rscale(g.asc, 0, cm0 + wr * 128 + mt * 32 + c); }
  stage(0); if (total > 1) stage(1);
  int cslot = 0;
  for (int gi = 0; gi < total; ++gi) {
    if (gi + 1 < total) asm volatile("s_waitcnt vmcnt(6)" ::: "memory");
    else asm volatile("s_waitcnt vmcnt(0)" ::: "memory");
    __builtin_amdgcn_s_barrier(); asm volatile("" ::: "memory");
    if (gi + 2 < total) stage(cslot == 0 ? 2 : cslot - 1);
    if (ASC) { if (c_kt > 0 && (c_kt & 7) == 0) {
#pragma unroll
      for (int mt = 0; mt < 4; ++mt) { const float rn = seg_rscale(g.asc, c_kt >> 3, cm0 + wr * 128 + mt * 32 + c); const float f = rcur[mt] / rn; rcur[mt] = rn;
        acc[mt][0] = acc[mt][0] * f; acc[mt][1] = acc[mt][1] * f; } } }
    const unsigned sb = lbase + cslot * 24576;
    cslot = cslot == 2 ? 0 : cslot + 1;
    bf16x8 fa[4], fb[2], ga[4], gb[2];
    { const unsigned a0 = sb + aoff + ko0, a1 = sb + aoff + ko1, b0 = sb + boff + ko0, b1 = sb + boff + ko1;
      asm volatile("ds_read_b128 %0, %1" : "=v"(fa[0]) : "v"(a0)); asm volatile("ds_read_b128 %0, %1 offset:2048" : "=v"(fa[1]) : "v"(a0));
      asm volatile("ds_read_b128 %0, %1 offset:4096" : "=v"(fa[2]) : "v"(a0)); asm volatile("ds_read_b128 %0, %1 offset:6144" : "=v"(fa[3]) : "v"(a0));
      asm volatile("ds_read_b128 %0, %1" : "=v"(fb[0]) : "v"(b0)); asm volatile("ds_read_b128 %0, %1 offset:2048" : "=v"(fb[1]) : "v"(b0));
      asm volatile("ds_read_b128 %0, %1" : "=v"(ga[0]) : "v"(a1)); asm volatile("ds_read_b128 %0, %1 offset:2048" : "=v"(ga[1]) : "v"(a1));
      asm volatile("ds_read_b128 %0, %1 offset:4096" : "=v"(ga[2]) : "v"(a1)); asm volatile("ds_read_b128 %0, %1 offset:6144" : "=v"(ga[3]) : "v"(a1));
      asm volatile("ds_read_b128 %0, %1" : "=v"(gb[0]) : "v"(b1)); asm volatile("ds_read_b128 %0, %1 offset:2048" : "=v"(gb[1]) : "v"(b1)); }
    asm volatile("s_waitcnt lgkmcnt(6)" : "+v"(fa[0]), "+v"(fa[1]), "+v"(fa[2]), "+v"(fa[3]), "+v"(fb[0]), "+v"(fb[1]));
    __builtin_amdgcn_s_setprio(1);
#pragma unroll
    for (int mt = 0; mt < 4; ++mt)
#pragma unroll
      for (int nt = 0; nt < 2; ++nt) acc[mt][nt] = MFMA(fb[nt], fa[mt], acc[mt][nt]);
    __builtin_amdgcn_s_setprio(0);
    asm volatile("s_waitcnt lgkmcnt(0)" : "+v"(ga[0]), "+v"(ga[1]), "+v"(ga[2]), "+v"(ga[3]), "+v"(gb[0]), "+v"(gb[1]));
    __builtin_amdgcn_s_setprio(1);
#pragma unroll
    for (int mt = 0; mt < 4; ++mt)
#pragma unroll
      for (int nt = 0; nt < 2; ++nt) acc[mt][nt] = MFMA(gb[nt], ga[mt], acc[mt][nt]);
    __builtin_amdgcn_s_setprio(0);
    if (++c_kt == nk) {
      if (ASC) {
#pragma unroll
        for (int mt = 0; mt < 4; ++mt) { acc[mt][0] = acc[mt][0] * rcur[mt]; acc[mt][1] = acc[mt][1] * rcur[mt]; } }
      { int c2_ = c, h2_ = h; asm volatile("" : "+v"(c2_), "+v"(h2_));
        epi(acc, cm0, cn0, wr, wc, c2_, h2_); }
#pragma unroll
      for (int i = 0; i < 4; ++i)
#pragma unroll
        for (int j = 0; j < 2; ++j)
#pragma unroll
          for (int r = 0; r < 16; ++r) acc[i][j][r] = 0.f;
      c_kt = 0; c_t += G;
      if (c_t < ntiles) { tile_rc256(c_t, NT, cm0, cn0);
        if (ASC) {
#pragma unroll
          for (int mt = 0; mt < 4; ++mt) rcur[mt] = seg_rscale(g.asc, 0, cm0 + wr * 128 + mt * 32 + c); } }
    }
  }
}

__device__ __forceinline__ void store_plain(bf16_t* dst, const f32x16& v, int h) {
#pragma unroll
  for (int g = 0; g < 4; ++g) { u32x2 w; w.x = pk2(v[4 * g], v[4 * g + 1]); w.y = pk2(v[4 * g + 2], v[4 * g + 3]); *(u32x2*)(dst + 8 * g + 4 * h) = w; }
}
__device__ __forceinline__ void store_vt(bf16_t* vt, int featbase, int tok, const f32x16& v, int h) {
  const int pt = permtok(tok);
#pragma unroll
  for (int r = 0; r < 16; ++r) vt[(size_t)(featbase + crow(r, h)) * VLD + pt] = f2bf(v[r]);
}
__device__ __forceinline__ void rope32(f32x16& v, const float* c32, const float* s32, int tok, int h) {
  const f32x4 ca = *(const f32x4*)(c32 + tok * 16 + 4 * h), cb = *(const f32x4*)(c32 + tok * 16 + 8 + 4 * h);
  const f32x4 sa = *(const f32x4*)(s32 + tok * 16 + 4 * h), sb = *(const f32x4*)(s32 + tok * 16 + 8 + 4 * h);
#pragma unroll
  for (int i = 0; i < 4; ++i) {
    float x1 = v[i], x2 = v[i + 8]; v[i] = x1 * ca[i] - x2 * sa[i]; v[i + 8] = x2 * ca[i] + x1 * sa[i];
    x1 = v[4 + i]; x2 = v[12 + i]; v[4 + i] = x1 * cb[i] - x2 * sb[i]; v[12 + i] = x2 * cb[i] + x1 * sb[i];
  }
}
__device__ __forceinline__ void rope64(f32x16& v0, f32x16& v1, const float* c64, const float* s64, int tok, int h) {
#pragma unroll
  for (int g = 0; g < 4; ++g) {
    const f32x4 cg4 = *(const f32x4*)(c64 + tok * 32 + 8 * g + 4 * h), sg4 = *(const f32x4*)(s64 + tok * 32 + 8 * g + 4 * h);
#pragma unroll
    for (int i = 0; i < 4; ++i) { const float x1 = v0[4 * g + i], x2 = v1[4 * g + i]; v0[4 * g + i] = x1 * cg4[i] - x2 * sg4[i]; v1[4 * g + i] = x2 * cg4[i] + x1 * sg4[i]; }
  }
}
__device__ __forceinline__ float sumsq16(const f32x16& v) { float s = 0.f;
#pragma unroll
  for (int r = 0; r < 16; ++r) s += v[r] * v[r];
  return s; }
__device__ __forceinline__ void kmax_update(unsigned* slot, float s) {
  s += __shfl_xor(s, 32);
#pragma unroll
  for (int o = 16; o; o >>= 1) s = fmaxf(s, __shfl_xor(s, o));
  if ((threadIdx.x & 63) == 0) atomicMax(slot, __float_as_uint(s));
}
__device__ __forceinline__ float rowscale_ssx(const float* ssx, int tok) {
  const f32x4* sp = (const f32x4*)(ssx + (size_t)tok * 16); const f32x4 a = sp[0], b = sp[1], c = sp[2], d = sp[3];
  const float t = ((a[0] + a[1]) + (a[2] + a[3])) + ((b[0] + b[1]) + (b[2] + b[3])) + ((c[0] + c[1]) + (c[2] + c[3])) + ((d[0] + d[1]) + (d[2] + d[3]));
  return rsqrtf(t * (1.f / 1024.f) + EPS);
}

struct EpiIn { static constexpr int kLds = 0;
  bf16_t* P; bf16_t* Vt; const float* ssx; float* ssa; const float *c32, *s32, *c64, *s64; unsigned* kmax;
  __device__ __forceinline__ void operator()(f32x16 (&acc)[2][2], int m0, int n0, int wr, int wc, int c, int h) const {
    const int g64 = (n0 >> 6) + wc;
    int vtb = -1, kslot = -1, ssl = -1; bool r32 = false, r64 = false;
    if (g64 <= 5) { if (g64 == 3) { r32 = true; kslot = 4; } else ssl = g64; }
    else if (g64 <= 13) { r32 = true; if (g64 >= 10) kslot = 5 + (g64 - 10); }
    else if (g64 <= 17) vtb = (g64 - 14) * 64;
    else if (g64 <= 23) { r64 = true; if (g64 >= 22) kslot = 9 + (g64 - 22); }
    else if (g64 <= 25) vtb = 256 + (g64 - 24) * 64;
    else if (g64 <= 33) { if (g64 >= 30) kslot = 11 + (g64 - 30); }
    else vtb = 384 + (g64 - 34) * 64;
#pragma unroll
    for (int mt = 0; mt < 2; ++mt) {
      const int tok = m0 + wr * 64 + mt * 32 + c;
      const float rr = rowscale_ssx(ssx, tok);
      f32x16 v0 = acc[mt][0] * rr, v1 = acc[mt][1] * rr;
      if (vtb >= 0) { store_vt(Vt, vtb, tok, v0, h); store_vt(Vt, vtb + 32, tok, v1, h); continue; }
      if (r32) { rope32(v0, c32, s32, tok, h); if (g64 != 3) rope32(v1, c32, s32, tok, h); }
      if (r64) rope64(v0, v1, c64, s64, tok, h);
      bf16_t* dst = P + (size_t)tok * NP + g64 * 64;
      store_plain(dst, v0, h); store_plain(dst + 32, v1, h);
      if (kslot >= 0) kmax_update(kmax + kslot, sumsq16(v0) + (g64 == 3 ? 0.f : sumsq16(v1)));
      if (ssl >= 0) { float s = sumsq16(v0) + sumsq16(v1); s += __shfl_xor(s, 32); if (h == 0) ssa[(size_t)tok * 8 + ssl] = s; }
    }
  }
};
struct EpiUq { static constexpr int kLds = 0;
  bf16_t* Qa; const float* ssa; const float *c32, *s32;
  __device__ __forceinline__ void operator()(f32x16 (&acc)[2][2], int m0, int n0, int wr, int wc, int c, int h) const {
    const int g32 = ((n0 >> 6) + wc) * 2;
#pragma unroll
    for (int mt = 0; mt < 2; ++mt) {
      const int tok = m0 + wr * 64 + mt * 32 + c;
      const float* sp = ssa + (size_t)tok * 8; const float rr = rsqrtf((sp[0] + sp[1] + sp[2]) * (1.f / 192.f) + EPS);
#pragma unroll
      for (int nt = 0; nt < 2; ++nt) {
        f32x16 v = acc[mt][nt] * rr;
        if ((g32 + nt) % 3 == 2) rope32(v, c32, s32, tok, h);
        store_plain(Qa + (size_t)tok * 384 + (g32 + nt) * 32, v, h);
      }
    }
  }
};
struct EpiKv { static constexpr int kLds = 0;
  bf16_t* KN; bf16_t* VtA; const float* ssa; unsigned* kmax;
  __device__ __forceinline__ void operator()(f32x16 (&acc)[2][2], int m0, int n0, int wr, int wc, int c, int h) const {
    const int g64 = (n0 >> 6) + wc;
#pragma unroll
    for (int mt = 0; mt < 2; ++mt) {
      const int tok = m0 + wr * 64 + mt * 32 + c;
      const float* sp = ssa + (size_t)tok * 8; const float rr = rsqrtf((sp[4] + sp[5]) * (1.f / 128.f) + EPS);
      const f32x16 v0 = acc[mt][0] * rr, v1 = acc[mt][1] * rr;
      if (g64 < 4) {
        bf16_t* dst = KN + (size_t)tok * 256 + g64 * 64; store_plain(dst, v0, h); store_plain(dst + 32, v1, h);
        kmax_update(kmax + g64, sumsq16(v0) + sumsq16(v1));
      } else { store_vt(VtA, (g64 - 4) * 64, tok, v0, h); store_vt(VtA, (g64 - 4) * 64 + 32, tok, v1, h); }
    }
  }
};
struct EpiRes {
  static constexpr int kLds = 1;
  bf16_t* xb; float* ssx;
  __device__ __forceinline__ void operator()(f32x16 (&acc)[2][2], int m0, int n0, int wr, int wc, int c, int h, char* lds) const {
    char* st = lds + 32768 + (wr * 2 + wc) * 9216;
#pragma unroll
    for (int mt = 0; mt < 2; ++mt)
#pragma unroll
      for (int nt = 0; nt < 2; ++nt)
#pragma unroll
        for (int g = 0; g < 4; ++g) { u32x2 w; w.x = pk2(acc[mt][nt][4 * g], acc[mt][nt][4 * g + 1]); w.y = pk2(acc[mt][nt][4 * g + 2], acc[mt][nt][4 * g + 3]);
          *(u32x2*)(st + (mt * 32 + c) * 144 + (nt * 32 + 8 * g + 4 * h) * 2) = w; }
    const int lane = h * 32 + c, rr = lane >> 3, ch = lane & 7;
#pragma unroll
    for (int j = 0; j < 8; ++j) {
      const int row = j * 8 + rr, tok = m0 + wr * 64 + row;
      const u32x4 a4 = *(const u32x4*)(st + row * 144 + ch * 16);
      bf16_t* xp = xb + (size_t)tok * 1024 + n0 + wc * 64 + ch * 8;
      const u32x4 x4 = *(const u32x4*)xp; u32x4 o4; float s = 0.f;
#pragma unroll
      for (int k = 0; k < 4; ++k) {
        const float f0 = bf2f(x4[k] & 0xffffu) + bf2f(a4[k] & 0xffffu), f1 = __uint_as_float(x4[k] & 0xffff0000u) + __uint_as_float(a4[k] & 0xffff0000u);
        s += f0 * f0 + f1 * f1; o4[k] = pk2(f0, f1); }
      *(u32x4*)xp = o4;
      s += __shfl_xor(s, 1); s += __shfl_xor(s, 2); s += __shfl_xor(s, 4);
      if (ch == 0) ssx[(size_t)tok * 16 + (n0 >> 7) * 2 + wc] = s;
    }
  }
};
struct EpiUp { static constexpr int kLds = 0;
  bf16_t* H; const float* ssx;
  __device__ __forceinline__ void operator()(f32x16 (&acc)[2][2], int m0, int n0, int wr, int wc, int c, int h) const {
#pragma unroll
    for (int mt = 0; mt < 2; ++mt) {
      const int tok = m0 + wr * 64 + mt * 32 + c; const float rr = rowscale_ssx(ssx, tok);
#pragma unroll
      for (int nt = 0; nt < 2; ++nt) {
        f32x16 v;
#pragma unroll
        for (int r = 0; r < 16; ++r) { const float t = fmaxf(acc[mt][nt][r] * rr, 0.f); v[r] = t * t; }
        store_plain(H + (size_t)tok * 4096 + n0 + wc * 64 + nt * 32, v, h);
      }
    }
  }
};

struct EpiUp4 { static constexpr int kLds = 0;
  bf16_t* H; const float* ssx;
  __device__ __forceinline__ void operator()(f32x16 (&acc)[4][2], int m0, int n0, int wr, int wc, int c, int h) const {
#pragma unroll
    for (int mt = 0; mt < 4; ++mt) {
      __builtin_amdgcn_sched_barrier(0);
      const int tok = m0 + wr * 128 + mt * 32 + c; const float rr = rowscale_ssx(ssx, tok);
#pragma unroll
      for (int nt = 0; nt < 2; ++nt) {
        f32x16 v;
#pragma unroll
        for (int r = 0; r < 16; ++r) { const float t = fmaxf(acc[mt][nt][r] * rr, 0.f); v[r] = t * t; }
        store_plain(H + (size_t)tok * 4096 + n0 + wc * 64 + nt * 32, v, h);
      }
    }
  }
};

struct AttnArgs { const bf16_t *P, *Vt, *Qa, *KN, *VtA; bf16_t* mix; float* ssm; const unsigned* kmax;
  const float *lq1, *lk1, *lq2, *lk2, *subln, *sinks, *rpb; float lam_init; };

constexpr int ABUF = 22528, AKOFF = 13312, ATAB = 2 * ABUF;

template <int MODE>
__device__ __forceinline__ void attn_item(char* lds, const AttnArgs& a, int item) {
  constexpr int KSTR = MODE == 0 ? 208 : 144;
  constexpr int NKS = MODE == 0 ? 6 : (MODE == 1 ? 2 : 4);
  constexpr int NKP = MODE == 0 ? 3 : 2;
  constexpr int NQT = MODE == 1 ? 2 : 1;
  int tid_ = threadIdx.x; asm volatile("" : "+v"(tid_));
  const int tid = tid_, lane = tid & 63, wid = tid >> 6, c = lane & 31, h = lane >> 5;
  int hd, sb, se; int qtok[NQT]; const bf16_t* qptr[NQT]; const bf16_t* kbase; const bf16_t* vbase; int k2slot;
  int narow = 0, nars = 0, nahalf = 0, kvh = 0;
  if constexpr (MODE == 0) { hd = item & 3; const int qb = item >> 2; sb = 0; se = 256;
    qtok[0] = qb * 128 + wid * 32 + c; qptr[0] = a.Qa + (size_t)qtok[0] * 384 + hd * 96;
    kbase = a.KN + hd * 64; vbase = a.VtA + (size_t)hd * 64 * VLD; k2slot = hd; }
  else if constexpr (MODE == 1) { hd = item & 3; const int qb = item >> 2; sb = 0; se = 256;
#pragma unroll
    for (int qt = 0; qt < 2; ++qt) { qtok[qt] = qb * 128 + wid * 32 + c; qptr[qt] = a.P + (size_t)qtok[qt] * NP + 384 + hd * 64 + qt * 32; }
    kbase = a.P + 640 + hd * 64; vbase = a.Vt + (size_t)hd * 64 * VLD; k2slot = 5 + hd; }
  else if constexpr (MODE == 2) { hd = item & 3; kvh = hd >> 1; const int qb = item >> 2; sb = max(0, 2 * qb - 2); se = min(256, 2 * qb + 4);
    qtok[0] = qb * 128 + wid * 32 + c; qptr[0] = a.P + (size_t)qtok[0] * NP + 1152 + hd * 64;
    kbase = a.P + 1408 + kvh * 64; vbase = a.Vt + (size_t)(256 + kvh * 64) * VLD; k2slot = 9 + kvh; }
  else { hd = item & 3; const int rg = item >> 2; narow = rg * 2 + (wid >> 1); nahalf = wid & 1; nars = min(max(narow - 4, 0), 248);
    sb = min(max(rg * 2 - 4, 0), 248); se = min(max(rg * 2 - 3, 0), 248) + 8;
    qtok[0] = narow * 64 + nahalf * 32 + c; qptr[0] = a.P + (size_t)qtok[0] * NP + 1664 + hd * 64;
    kbase = a.P + 1920 + hd * 64; vbase = a.Vt + (size_t)(384 + hd * 64) * VLD; k2slot = 11 + hd; }

  bf16x8 qf[NQT][NKS]; float q2max = 0.f;
#pragma unroll
  for (int qt = 0; qt < NQT; ++qt) { float s = 0.f;
#pragma unroll
    for (int ks = 0; ks < NKS; ++ks) { qf[qt][ks] = *(const bf16x8*)(qptr[qt] + ks * 16 + h * 8);
#pragma unroll
      for (int j = 0; j < 8; ++j) { const float f = bf2f((unsigned short)qf[qt][ks][j]); s += f * f; } }
    s += __shfl_xor(s, 32); q2max = fmaxf(q2max, s); }
#pragma unroll
  for (int o = 16; o; o >>= 1) q2max = fmaxf(q2max, __shfl_xor(q2max, o));
  float k2 = __uint_as_float(a.kmax[k2slot]); if (MODE == 0) k2 += __uint_as_float(a.kmax[4]);
  float cb = sqrtf(q2max * k2) * 1.01f + 0.01f;
  if (MODE == 3) {
    float* tab = (float*)(lds + ATAB); const float* rp = a.rpb + hd * 465; float bm = 0.f;
    for (int i = lane; i < 465; i += 64) bm = fmaxf(bm, fabsf(rp[i]));
#pragma unroll
    for (int o = 32; o; o >>= 1) bm = fmaxf(bm, __shfl_xor(bm, o));
    cb += bm * LOG2E;
    for (int i = tid; i < 480; i += 256) { const int dr = i >> 5, dc = i & 31; tab[i] = dc < 31 ? rp[dr * 31 + dc] * LOG2E : 0.f; }
  }
  f32x16 negc;
#pragma unroll
  for (int r = 0; r < 16; ++r) negc[r] = -cb;

  f32x16 O[NQT][2]; float l[NQT];
#pragma unroll
  for (int i = 0; i < NQT; ++i) l[i] = 0.f;
#pragma unroll
  for (int i = 0; i < NQT; ++i)
#pragma unroll
    for (int j = 0; j < 2; ++j)
#pragma unroll
      for (int r = 0; r < 16; ++r) O[i][j][r] = 0.f;

  u32x4 rk[NKP], rv[2];
  auto gload = [&](int st) {
    const int kb = st * 64;
#pragma unroll
    for (int i = 0; i < NKP; ++i) { const int p = tid + 256 * i;
      if (MODE == 0) {
        if (i < 2) { const int row = p >> 3, ch = p & 7; rk[i] = *(const u32x4*)(kbase + (size_t)(kb + row) * 256 + ch * 8); }
        else { const int row = tid >> 2, ch = tid & 3; rk[i] = *(const u32x4*)(a.P + (size_t)(kb + row) * NP + 192 + ch * 8); } }
      else { const int row = p >> 3, ch = p & 7; rk[i] = *(const u32x4*)(kbase + (size_t)(kb + row) * NP + ch * 8); } }
#pragma unroll
    for (int i = 0; i < 2; ++i) { const int p = tid + 256 * i, dv = p >> 3, ch = p & 7; rv[i] = *(const u32x4*)(vbase + (size_t)dv * VLD + kb + ch * 8); }
  };
  auto lstore = [&](int buf) {
    char* b = lds + buf * ABUF;
#pragma unroll
    for (int i = 0; i < NKP; ++i) { const int p = tid + 256 * i;
      if (MODE == 0) { if (i < 2) { const int row = p >> 3, ch = p & 7; *(u32x4*)(b + row * 208 + ch * 16) = rk[i]; } else { const int row = tid >> 2, ch = tid & 3; *(u32x4*)(b + row * 208 + 128 + ch * 16) = rk[i]; } }
      else { const int row = p >> 3, ch = p & 7; *(u32x4*)(b + row * 144 + ch * 16) = rk[i]; } }
#pragma unroll
    for (int i = 0; i < 2; ++i) { const int p = tid + 256 * i, dv = p >> 3, ch = p & 7; *(u32x4*)(b + AKOFF + dv * 144 + ch * 16) = rv[i]; }
  };

  gload(sb); lstore(0); __syncthreads();
  for (int st = sb; st < se; ++st) {
    const int buf = (st - sb) & 1;
    if (st + 1 < se) gload(st + 1);
    __builtin_amdgcn_sched_barrier(0);
    const bool active = MODE != 3 || (st >= nars && st < nars + 8);
    if (active) {
      const char* Kb = lds + buf * ABUF; const char* Vb = Kb + AKOFF;
#pragma unroll
      for (int kt2 = 0; kt2 < 2; ++kt2) {
        f32x16 sc[NQT];
#pragma unroll
        for (int qt = 0; qt < NQT; ++qt) sc[qt] = negc;
        if (MODE != 1) {
#pragma unroll
          for (int ks = 0; ks < NKS; ++ks) { const bf16x8 kf = *(const bf16x8*)(Kb + (kt2 * 32 + c) * KSTR + ks * 32 + h * 16);
#pragma unroll
            for (int qt = 0; qt < NQT; ++qt) sc[qt] = MFMA(kf, qf[qt][ks], sc[qt]); }
        } else {
#pragma unroll
          for (int qt = 0; qt < NQT; ++qt)
#pragma unroll
            for (int ks = 0; ks < NKS; ++ks) { const bf16x8 kf = *(const bf16x8*)(Kb + (kt2 * 32 + c) * KSTR + qt * 64 + ks * 32 + h * 16);
              sc[qt] = MFMA(kf, qf[qt][ks], sc[qt]); }
        }
        if (MODE == 2) {
          const int kb0 = st * 64 + kt2 * 32 - qtok[0];
#pragma unroll
          for (int i = 0; i < 16; ++i) { const int d = kb0 + crow(i, h); const bool ok = d <= 128 && d >= -128;
            sc[0][i] = ok ? sc[0][i] : -INFINITY; }
        }
        if (MODE == 3) {
          const float* trow = (const float*)(lds + ATAB) + (st - narow + 7) * 32;
#pragma unroll
          for (int qt = 0; qt < NQT; ++qt) { const int w = nahalf * 32 + c, cs = min(max(w - 8, 0), 48);
#pragma unroll
            for (int i = 0; i < 16; ++i) { const int kc = kt2 * 32 + crow(i, h); const bool ok = kc >= cs && kc < cs + 16;
              const float bv = trow[(kc - w + 15) & 31]; sc[qt][i] = ok ? sc[qt][i] + bv : -INFINITY; } }
        }
        bf16x8 pf[NQT][2];
#pragma unroll
        for (int qt = 0; qt < NQT; ++qt) {
          float p[16];
#pragma unroll
          for (int i = 0; i < 16; ++i) { p[i] = __builtin_amdgcn_exp2f(sc[qt][i]); l[qt] += p[i]; }
#pragma unroll
          for (int s2 = 0; s2 < 2; ++s2) { u32x4 w; w.x = pk2(p[8 * s2], p[8 * s2 + 1]); w.y = pk2(p[8 * s2 + 2], p[8 * s2 + 3]);
            w.z = pk2(p[8 * s2 + 4], p[8 * s2 + 5]); w.w = pk2(p[8 * s2 + 6], p[8 * s2 + 7]); pf[qt][s2] = __builtin_bit_cast(bf16x8, w); }
        }
#pragma unroll
        for (int dt = 0; dt < 2; ++dt)
#pragma unroll
          for (int s2 = 0; s2 < 2; ++s2) { const bf16x8 vf = *(const bf16x8*)(Vb + (dt * 32 + c) * 144 + kt2 * 64 + s2 * 32 + h * 16);
#pragma unroll
            for (int qt = 0; qt < NQT; ++qt) O[qt][dt] = MFMA(vf, pf[qt][s2], O[qt][dt]); }
      }
    }
    __builtin_amdgcn_sched_barrier(0);
    if (st + 1 < se) lstore(buf ^ 1);
    __syncthreads();
  }

#pragma unroll
  for (int qt = 0; qt < NQT; ++qt) l[qt] += __shfl_xor(l[qt], 32);
  if (MODE == 1) {
    float pa = 0.f, pb = 0.f;
    if (lane < 32) { pa = a.lq1[lane] * a.lk1[lane]; pb = a.lq2[lane] * a.lk2[lane]; }
#pragma unroll
    for (int o = 32; o; o >>= 1) { pa += __shfl_xor(pa, o); pb += __shfl_xor(pb, o); }
    const float lam = expf(pa) - expf(pb) + a.lam_init;
    const float i0 = 1.f / l[0], i1 = lam / l[NQT - 1];
    f32x16 o[2]; float ss = 0.f;
#pragma unroll
    for (int dt = 0; dt < 2; ++dt)
#pragma unroll
      for (int r = 0; r < 16; ++r) { o[dt][r] = O[0][dt][r] * i0 - O[NQT - 1][dt][r] * i1; ss += o[dt][r] * o[dt][r]; }
    ss += __shfl_xor(ss, 32);
    const float rn = rsqrtf(ss * (1.f / 64.f) + EPS) * (1.f - a.lam_init);
#pragma unroll
    for (int dt = 0; dt < 2; ++dt) {
#pragma unroll
      for (int g = 0; g < 4; ++g) { const f32x4 gg = *(const f32x4*)(a.subln + dt * 32 + 8 * g + 4 * h);
#pragma unroll
        for (int i = 0; i < 4; ++i) o[dt][4 * g + i] *= rn * gg[i]; }
      store_plain(a.mix + (size_t)qtok[0] * 1024 + 256 + hd * 64 + dt * 32, o[dt], h);
    }
  } else {
#pragma unroll
    for (int qt = 0; qt < NQT; ++qt) {
      int head, colb, seg;
      if (MODE == 0) { head = hd; colb = hd * 64; seg = 0; }
      else if (MODE == 2) { head = hd; colb = 512 + head * 64; seg = 1; l[qt] += __builtin_amdgcn_exp2f(a.sinks[head] * LOG2E - cb); }
      else { head = hd; colb = 768 + hd * 64; seg = 2; }
      const float inv = 1.f / l[qt]; float ss = 0.f;
#pragma unroll
      for (int dt = 0; dt < 2; ++dt) { f32x16 o = O[qt][dt] * inv; ss += sumsq16(o); store_plain(a.mix + (size_t)qtok[qt] * 1024 + colb + dt * 32, o, h); }
      ss += __shfl_xor(ss, 32);
      if (h == 0) a.ssm[(size_t)(seg * 4 + head) * S + qtok[qt]] = ss;
    }
  }
}


template <bool B> struct BoolC { static constexpr bool value = B; };
#define SGB(mask, n) __builtin_amdgcn_sched_group_barrier((mask), (n), 0)
template <int MODE>
__device__ __forceinline__ bool attn_pipe(char* lds, const AttnArgs& a, int item) {
  constexpr int KSTR = MODE == 0 ? 208 : 144;
  constexpr int NKS = MODE == 0 ? 6 : 2;
  constexpr int NKP = MODE == 0 ? 3 : 2;
  constexpr int NST = 256;
  constexpr int NQT = MODE == 0 ? 1 : 2;
  int tid_ = threadIdx.x; asm volatile("" : "+v"(tid_));
  const int tid = tid_, lane = tid & 63, wid = tid >> 6, c = lane & 31, h = lane >> 5;
  const int hd = item & 3, qb = item >> 2;
  int qtok[NQT]; const bf16_t* qptr[NQT]; const bf16_t* kbase; const bf16_t* vbase; int k2slot;
  if constexpr (MODE == 0) {
    qtok[0] = qb * 128 + wid * 32 + c; qptr[0] = a.Qa + (size_t)qtok[0] * 384 + hd * 96;
    kbase = a.KN + hd * 64; vbase = a.VtA + (size_t)hd * 64 * VLD; k2slot = hd;
  } else {
#pragma unroll
    for (int qt = 0; qt < 2; ++qt) { qtok[qt] = qb * 128 + wid * 32 + c; qptr[qt] = a.P + (size_t)qtok[qt] * NP + 384 + hd * 64 + qt * 32; }
    kbase = a.P + 640 + hd * 64; vbase = a.Vt + (size_t)hd * 64 * VLD; k2slot = 5 + hd;
  }
  bf16x8 qf[NQT][NKS]; float q2max = 0.f;
#pragma unroll
  for (int qt = 0; qt < NQT; ++qt) { float s = 0.f;
#pragma unroll
    for (int ks = 0; ks < NKS; ++ks) { qf[qt][ks] = *(const bf16x8*)(qptr[qt] + ks * 16 + h * 8);
#pragma unroll
      for (int j = 0; j < 8; ++j) { const float f = bf2f((unsigned short)qf[qt][ks][j]); s += f * f; } }
    s += __shfl_xor(s, 32); q2max = fmaxf(q2max, s); }
#pragma unroll
  for (int o = 16; o; o >>= 1) q2max = fmaxf(q2max, __shfl_xor(q2max, o));
  float k2 = __uint_as_float(a.kmax[k2slot]); if (MODE == 0) k2 += __uint_as_float(a.kmax[4]);
  const float cb = sqrtf(q2max * k2) * 1.01f + 0.01f;
  { volatile int* flag = (volatile int*)(lds + 3 * ABUF);
    if (tid == 0) *flag = 0;
    __syncthreads();
    if (cb > 96.f && lane == 0) *flag = 1;
    __syncthreads();
    if (*flag) return false; }
  f32x16 O[NQT][2]; float l[NQT];
#pragma unroll
  for (int i = 0; i < NQT; ++i) { l[i] = 0.f;
#pragma unroll
    for (int j = 0; j < 2; ++j)
#pragma unroll
      for (int r = 0; r < 16; ++r) O[i][j][r] = 0.f; }

  u32x4 rk[NKP], rv[2];
  auto gload = [&](int st) {
    const int kb = st * 64;
#pragma unroll
    for (int i = 0; i < NKP; ++i) { const int p = tid + 256 * i;
      if (MODE == 0) {
        if (i < 2) { const int row = p >> 3, ch = p & 7; rk[i] = *(const u32x4*)(kbase + (size_t)(kb + row) * 256 + ch * 8); }
        else { const int row = tid >> 2, ch = tid & 3; rk[i] = *(const u32x4*)(a.P + (size_t)(kb + row) * NP + 192 + ch * 8); } }
      else { const int row = p >> 3, ch = p & 7; rk[i] = *(const u32x4*)(kbase + (size_t)(kb + row) * NP + ch * 8); } }
#pragma unroll
    for (int i = 0; i < 2; ++i) { const int p = tid + 256 * i, dv = p >> 3, ch = p & 7; rv[i] = *(const u32x4*)(vbase + (size_t)dv * VLD + kb + ch * 8); }
  };
  auto lstore = [&](int buf) {
    char* b = lds + buf * ABUF;
#pragma unroll
    for (int i = 0; i < NKP; ++i) { const int p = tid + 256 * i;
      if (MODE == 0) { if (i < 2) { const int row = p >> 3, ch = p & 7; *(u32x4*)(b + row * 208 + ch * 16) = rk[i]; } else { const int row = tid >> 2, ch = tid & 3; *(u32x4*)(b + row * 208 + 128 + ch * 16) = rk[i]; } }
      else { const int row = p >> 3, ch = p & 7; *(u32x4*)(b + row * 144 + ch * 16) = rk[i]; } }
#pragma unroll
    for (int i = 0; i < 2; ++i) { const int p = tid + 256 * i, dv = p >> 3, ch = p & 7; *(u32x4*)(b + AKOFF + dv * 144 + ch * 16) = rv[i]; }
  };
  const int koff = c * KSTR + h * 16, voff = AKOFF + c * 144 + h * 16;
#define QK_UNIT(dst, Kb, u) { _Pragma("unroll") for (int r_ = 0; r_ < 16; ++r_) dst[r_] = 0.f; \
    _Pragma("unroll") for (int ks = 0; ks < NKS; ++ks) { \
      const bf16x8 kf = *(const bf16x8*)((Kb) + koff + ((u) / NQT) * 32 * KSTR + (MODE == 1 ? ((u) % NQT) * 64 : 0) + ks * 32); \
      dst = MFMA(kf, qf[(u) % NQT][ks], dst); } }
#define EXP_UNIT(src, u, pf) { float p_[16]; \
    _Pragma("unroll") for (int i = 0; i < 16; ++i) { p_[i] = __builtin_amdgcn_exp2f(src[i]); l[(u) % NQT] += p_[i]; } \
    _Pragma("unroll") for (int s2 = 0; s2 < 2; ++s2) { u32x4 w_; w_.x = pk2(p_[8 * s2], p_[8 * s2 + 1]); w_.y = pk2(p_[8 * s2 + 2], p_[8 * s2 + 3]); \
      w_.z = pk2(p_[8 * s2 + 4], p_[8 * s2 + 5]); w_.w = pk2(p_[8 * s2 + 6], p_[8 * s2 + 7]); pf[s2] = __builtin_bit_cast(bf16x8, w_); } }
#define PV_UNIT(Vb, u, pf) { \
    _Pragma("unroll") for (int dt = 0; dt < 2; ++dt) \
    _Pragma("unroll") for (int s2 = 0; s2 < 2; ++s2) { \
      const bf16x8 vf = *(const bf16x8*)((Vb) + voff + dt * 32 * 144 + ((u) / NQT) * 64 + s2 * 32); \
      O[(u) % NQT][dt] = MFMA(vf, pf[s2], O[(u) % NQT][dt]); } }
#define SCHED_ITER(NM) { SGB(0x100, 2); \
    _Pragma("unroll") for (int i_ = 0; i_ < (NM); ++i_) { SGB(0x008, 1); SGB(0x002, (40 + (NM) - 1) / (NM)); if (i_ + 2 < (NM)) SGB(0x100, 1); } }

  gload(0); lstore(0); gload(1); lstore(1); __syncthreads();
  f32x16 sc, sn;
  QK_UNIT(sc, lds, 0);
  int cur = 0;
  for (int st = 0; st < NST; ++st) {
    const int nxt = cur == 2 ? 0 : cur + 1, wr = nxt == 2 ? 0 : nxt + 1;
    if (st + 2 < NST) gload(st + 2);
    const char* Kc = lds + cur * ABUF; const char* Kn = lds + nxt * ABUF;
    bf16x8 pa[2], pb[2];
    __builtin_amdgcn_sched_barrier(0);
    if constexpr (NQT == 2) {
      QK_UNIT(sn, Kc, 1); EXP_UNIT(sc, 0, pa); SCHED_ITER(NKS); sc = sn;
      __builtin_amdgcn_sched_barrier(0);
      QK_UNIT(sn, Kc, 2); EXP_UNIT(sc, 1, pb); PV_UNIT(Kc, 0, pa); SCHED_ITER(NKS + 4); sc = sn;
      __builtin_amdgcn_sched_barrier(0);
      QK_UNIT(sn, Kc, 3); EXP_UNIT(sc, 2, pa); PV_UNIT(Kc, 1, pb); SCHED_ITER(NKS + 4); sc = sn;
      __builtin_amdgcn_sched_barrier(0);
      QK_UNIT(sn, Kn, 0); EXP_UNIT(sc, 3, pb); PV_UNIT(Kc, 2, pa); SCHED_ITER(NKS + 4); sc = sn;
      __builtin_amdgcn_sched_barrier(0);
      PV_UNIT(Kc, 3, pb);
    } else {
      QK_UNIT(sn, Kc, 1); EXP_UNIT(sc, 0, pa); SCHED_ITER(NKS); sc = sn;
      __builtin_amdgcn_sched_barrier(0);
      QK_UNIT(sn, Kn, 0); EXP_UNIT(sc, 1, pb); PV_UNIT(Kc, 0, pa); SCHED_ITER(NKS + 4); sc = sn;
      __builtin_amdgcn_sched_barrier(0);
      PV_UNIT(Kc, 1, pb);
    }
    __builtin_amdgcn_sched_barrier(0);
    if (st + 2 < NST) lstore(wr);
    __syncthreads();
    cur = nxt;
  }
#undef QK_UNIT
#undef EXP_UNIT
#undef PV_UNIT
#undef SCHED_ITER

#pragma unroll
  for (int qt = 0; qt < NQT; ++qt) l[qt] += __shfl_xor(l[qt], 32);
  if constexpr (MODE == 1) {
    float pa = 0.f, pb = 0.f;
    if (lane < 32) { pa = a.lq1[lane] * a.lk1[lane]; pb = a.lq2[lane] * a.lk2[lane]; }
#pragma unroll
    for (int o = 32; o; o >>= 1) { pa += __shfl_xor(pa, o); pb += __shfl_xor(pb, o); }
    const float lam = expf(pa) - expf(pb) + a.lam_init;
    const float i0 = 1.f / l[0], i1 = lam / l[1];
    f32x16 o[2]; float ss = 0.f;
#pragma unroll
    for (int dt = 0; dt < 2; ++dt)
#pragma unroll
      for (int r = 0; r < 16; ++r) { o[dt][r] = O[0][dt][r] * i0 - O[1][dt][r] * i1; ss += o[dt][r] * o[dt][r]; }
    ss += __shfl_xor(ss, 32);
    const float rn = rsqrtf(ss * (1.f / 64.f) + EPS) * (1.f - a.lam_init);
#pragma unroll
    for (int dt = 0; dt < 2; ++dt) {
#pragma unroll
      for (int g = 0; g < 4; ++g) { const f32x4 gg = *(const f32x4*)(a.subln + dt * 32 + 8 * g + 4 * h);
#pragma unroll
        for (int i = 0; i < 4; ++i) o[dt][4 * g + i] *= rn * gg[i]; }
      store_plain(a.mix + (size_t)qtok[0] * 1024 + 256 + hd * 64 + dt * 32, o[dt], h);
    }
  } else {
#pragma unroll
    for (int qt = 0; qt < NQT; ++qt) {
      const float inv = 1.f / l[qt]; float ss = 0.f;
#pragma unroll
      for (int dt = 0; dt < 2; ++dt) { f32x16 o = O[qt][dt] * inv; ss += sumsq16(o); store_plain(a.mix + (size_t)qtok[qt] * 1024 + hd * 64 + dt * 32, o, h); }
      ss += __shfl_xor(ss, 32);
      if (h == 0) a.ssm[(size_t)hd * S + qtok[qt]] = ss;
    }
  }
  return true;
}

template <class F>
__device__ __forceinline__ void conv_tile(float* tl, bf16_t* out, int K, int n0, int k0, const F& f) {
  int tid_ = threadIdx.x; asm volatile("" : "+v"(tid_));
  const int tid = tid_, tx = tid & 63, ty = tid >> 6;
#pragma unroll 4
  for (int i = 0; i < 16; ++i) { const int k = ty + 4 * i; tl[k * 65 + tx] = f(k0 + k, n0 + tx); }
  __syncthreads();
  const int kx2 = (tid & 31) * 2, ny = tid >> 5;
#pragma unroll 4
  for (int i = 0; i < 8; ++i) { const int n = ny + 8 * i; *(unsigned*)(out + (size_t)(n0 + n) * K + k0 + kx2) = pk2(tl[kx2 * 65 + n], tl[(kx2 + 1) * 65 + n]); }
  __syncthreads();
}

__device__ void conv_layer(char* lds, const Params& p, int l) {
  float* tl = (float*)lds; char* ws = p.ws;
  const float* w_in = p.w_in + (size_t)l * 1024 * 2400; const float* g1 = p.norm1_g + l * 1024;
  const float* w_out = p.w_out + (size_t)l * 1024 * 1024; const float* gm = p.g_mla + l * 256; const float* gs = p.g_swa + l * 256; const float* gn = p.g_na + l * 256;
  const float* w_up = p.w_up + (size_t)l * 1024 * 4096; const float* g2 = p.norm2_g + l * 1024;
  const float* w_dn = p.w_down + (size_t)l * 4096 * 1024;
  const float* w_uq = p.w_uq + (size_t)l * 192 * 384; const float* qg = p.qn_g + l * 192;
  const float* w_uk = p.w_uk + (size_t)l * 128 * 256; const float* w_uv = p.w_uv + (size_t)l * 128 * 256; const float* kg = p.kvn_g + l * 128;
  const float sB = 0.17677669529663687f * LOG2E, sC = 0.125f * LOG2E, sA = 0.10206207261596577f * LOG2E;
  for (int t = bid_(); t < 2946; t += gridDim.x) {
    if (t < 608) { const int nt = t >> 4, kt = t & 15;
      conv_tile(tl, (bf16_t*)(ws + OFF_WIN), 1024, nt * 64, kt * 64, [&](int k, int n) -> float {
        int src; if (n < 192) src = n; else if (n < 224) src = 320 + n - 192; else if (n < 256) src = -1; else if (n < 384) src = 192 + n - 256; else src = 352 + n - 384;
        if (src < 0) return 0.f;
        float sc = 1.f; if (n >= 384 && n < 640) sc = sB; else if ((n >= 1152 && n < 1408) || (n >= 1664 && n < 1920)) sc = sC;
        return w_in[(size_t)k * 2400 + src] * g1[k] * sc; });
    } else if (t < 864) { const int u = t - 608, nt = u >> 4, kt = u & 15;
      conv_tile(tl, (bf16_t*)(ws + OFF_WOUT), 1024, nt * 64, kt * 64, [&](int k, int n) -> float {
        const float g = k < 256 ? gm[k] : (k < 512 ? 1.f : (k < 768 ? gs[k - 512] : gn[k - 768]));
        return w_out[(size_t)k * 1024 + n] * g; });
    } else if (t < 1888) { const int u = t - 864, nt = u >> 4, kt = u & 15;
      conv_tile(tl, (bf16_t*)(ws + OFF_WUP), 1024, nt * 64, kt * 64, [&](int k, int n) -> float { return w_up[(size_t)k * 4096 + n] * g2[k]; });
    } else if (t < 2912) { const int u = t - 1888, nt = u >> 6, kt = u & 63;
      conv_tile(tl, (bf16_t*)(ws + OFF_WDN), 4096, nt * 64, kt * 64, [&](int k, int n) -> float { return w_dn[(size_t)k * 1024 + n]; });
    } else if (t < 2930) { const int u = t - 2912, nt = u / 3, kt = u % 3;
      conv_tile(tl, (bf16_t*)(ws + OFF_WUQ), 192, nt * 64, kt * 64, [&](int k, int n) -> float { return w_uq[(size_t)k * 384 + n] * qg[k] * sA; });
    } else { const int u = t - 2930, nt = u >> 1, kt = u & 1;
      conv_tile(tl, (bf16_t*)(ws + OFF_WKV), 128, nt * 64, kt * 64, [&](int k, int n) -> float {
        return (n < 256 ? w_uk[(size_t)k * 256 + n] : w_uv[(size_t)k * 256 + n - 256]) * kg[k]; });
    }
  }
}

__device__ __forceinline__ void gbar(unsigned* base) {
  __syncthreads();
  if (threadIdx.x == 0) {
    __builtin_amdgcn_fence(__ATOMIC_RELEASE, "agent");
    const unsigned g = blockIdx.x & 15u, ng = gridDim.x >> 4;
    unsigned* cnt = base + g * 32; unsigned* root = base + 16 * 32; unsigned* gen = base + (17 + g) * 32;
    const unsigned old = __hip_atomic_load(gen, __ATOMIC_RELAXED, __HIP_MEMORY_SCOPE_AGENT);
    if (__hip_atomic_fetch_add(cnt, 1u, __ATOMIC_RELAXED, __HIP_MEMORY_SCOPE_AGENT) == ng - 1u) {
      __hip_atomic_store(cnt, 0u, __ATOMIC_RELAXED, __HIP_MEMORY_SCOPE_AGENT);
      __builtin_amdgcn_fence(__ATOMIC_RELEASE, "agent");
      if (__hip_atomic_fetch_add(root, 1u, __ATOMIC_RELAXED, __HIP_MEMORY_SCOPE_AGENT) == 15u) {
        __hip_atomic_store(root, 0u, __ATOMIC_RELAXED, __HIP_MEMORY_SCOPE_AGENT);
        __builtin_amdgcn_fence(__ATOMIC_RELEASE, "agent");
        for (unsigned k = 0; k < 16; ++k) __hip_atomic_fetch_add(base + (17 + k) * 32, 1u, __ATOMIC_RELAXED, __HIP_MEMORY_SCOPE_AGENT);
      }
    }
    while (__hip_atomic_load(gen, __ATOMIC_RELAXED, __HIP_MEMORY_SCOPE_AGENT) == old) __builtin_amdgcn_s_sleep(2);
    __builtin_amdgcn_fence(__ATOMIC_ACQUIRE, "agent");
  }
  __syncthreads();
}

__device__ __forceinline__ void sincos_acc(float ang, float& sn, float& cs) {
  const double a = (double)ang; const double n = rint(a * 0.15915494309189535);
  const double r = a - n * 6.283185307179586476925; const double r2 = r * r;
  double s = -1.0 / 51090942171709440000.0;
  s = s * r2 + 1.0 / 121645100408832000.0; s = s * r2 - 1.0 / 355687428096000.0; s = s * r2 + 1.0 / 1307674368000.0; s = s * r2 - 1.0 / 6227020800.0;
  s = s * r2 + 1.0 / 39916800.0; s = s * r2 - 1.0 / 362880.0; s = s * r2 + 1.0 / 5040.0; s = s * r2 - 1.0 / 120.0; s = s * r2 + 1.0 / 6.0; s = s * r2 - 1.0; s = -s * r;
  double c = 1.0 / 1124000727777607680000.0;
  c = c * r2 - 1.0 / 2432902008176640000.0; c = c * r2 + 1.0 / 6402373705728000.0; c = c * r2 - 1.0 / 20922789888000.0; c = c * r2 + 1.0 / 87178291200.0;
  c = c * r2 - 1.0 / 479001600.0; c = c * r2 + 1.0 / 3628800.0; c = c * r2 - 1.0 / 40320.0; c = c * r2 + 1.0 / 720.0; c = c * r2 - 1.0 / 24.0; c = c * r2 + 0.5; c = 1.0 - c * r2;
  sn = (float)s; cs = (float)c;
}

__global__ void __launch_bounds__(256, 2) mega(Params p) {
  cg::grid_group grid = cg::this_grid();
  __shared__ __attribute__((aligned(16))) char lds[73728];
  __shared__ int s_item; __shared__ int s_q[2];
#ifdef PROBE_SEL
  __shared__ unsigned long long s_t[10];
  if (threadIdx.x == 0) { for (int i = 0; i < 9; ++i) s_t[i] = 0; s_t[9] = __builtin_amdgcn_s_memrealtime(); }
#define TSTAMP(k) { if (blockIdx.x == 0 && threadIdx.x == 0) { const unsigned long long t_ = __builtin_amdgcn_s_memrealtime(); s_t[k] += t_ - s_t[9]; s_t[9] = t_; } }
#else
#define TSTAMP(k)
#endif
#define GBAR { size_t wz2_ = 0; asm volatile("" : "+s"(wz2_)); gbar((unsigned*)(p.ws + OFF_CTRL + wz2_) + 1024); }
#define WSPTRS \
  size_t wz_ = 0; asm volatile("" : "+s"(wz_)); char* ws = p.ws + wz_; \
  bf16_t* XB = (bf16_t*)(ws + OFF_XB); bf16_t* MIX = (bf16_t*)(ws + OFF_MIX); bf16_t* P = (bf16_t*)(ws + OFF_P); bf16_t* VT = (bf16_t*)(ws + OFF_VT); \
  bf16_t* QA = (bf16_t*)(ws + OFF_QA); bf16_t* KN = (bf16_t*)(ws + OFF_KN); bf16_t* VTA = (bf16_t*)(ws + OFF_VTA); bf16_t* H = (bf16_t*)(ws + OFF_H); \
  float* C32 = (float*)(ws + OFF_TAB); float* S32 = C32 + S * 16; float* C64 = S32 + S * 16; float* S64 = C64 + S * 32; \
  float* SSX = (float*)(ws + OFF_SSX); float* SSA = (float*)(ws + OFF_SSA); float* SSM = (float*)(ws + OFF_SSM); \
  unsigned* CTRL = (unsigned*)(ws + OFF_CTRL); unsigned* kmax = CTRL + 16 + 16 * l; \
  (void)XB; (void)MIX; (void)P; (void)VT; (void)QA; (void)KN; (void)VTA; (void)H; (void)C32; (void)S32; (void)C64; (void)S64; (void)SSX; (void)SSA; (void)SSM; (void)CTRL; (void)kmax;

  { const int l = 0; WSPTRS
  int tid_ = threadIdx.x; asm volatile("" : "+v"(tid_));
  const int tid = tid_, lane = tid & 63, wid = tid >> 6, gw = bid_() * 4 + wid, nw = gridDim.x * 4;
  if (blockIdx.x == 0) { for (int i = tid; i < 4096; i += 256) CTRL[i] = 0u; }
  for (int row = gw; row < S; row += nw) {
    const f32x4* xr = (const f32x4*)(p.x + (size_t)row * 1024); float s = 0.f;
#pragma unroll
    for (int i = 0; i < 4; ++i) { const f32x4 v = xr[lane + 64 * i]; s += v[0] * v[0] + v[1] * v[1] + v[2] * v[2] + v[3] * v[3];
      u32x2 w; w.x = pk2(v[0], v[1]); w.y = pk2(v[2], v[3]); *(u32x2*)(XB + (size_t)row * 1024 + (lane + 64 * i) * 4) = w; }
#pragma unroll
    for (int o = 32; o; o >>= 1) s += __shfl_xor(s, o);
    if (lane < 16) SSX[(size_t)row * 16 + lane] = lane == 0 ? s : 0.f;
  }
  for (int idx = bid_() * 256 + tid; idx < S * 48; idx += gridDim.x * 256) {
    const int pos = idx / 48, i = idx - pos * 48; float sn, cs;
    if (i < 16) { const float inv = 1.0f / powf(10000.f, (float)(2 * i) / 32.f); sincos_acc((float)pos * inv, sn, cs); C32[pos * 16 + i] = cs; S32[pos * 16 + i] = sn; }
    else { const int j = i - 16; const float inv = 1.0f / powf(10000.f, (float)(2 * j) / 64.f); sincos_acc((float)pos * inv, sn, cs); C64[pos * 32 + j] = cs; S64[pos * 32 + j] = sn; }
  }
  }

#pragma unroll 1
  for (int l = 0; l < 4; ++l) {
    conv_layer(lds, p, l);
    if (l == 0) grid.sync(); else GBAR;
    TSTAMP(0)
    { WSPTRS GemmArgs g{XB, 1024, (const bf16_t*)(ws + OFF_WIN), 1024, 1024, nullptr};
      EpiIn e{P, VT, SSX, SSA, C32, S32, C64, S64, kmax};
      bool st_ = false;
      for (int t = bid_(); t < 128 * 19; t += gridDim.x) { const int u = remap8(t, 128 * 19); const int tn = t + (int)gridDim.x; const bool hn = tn < 128 * 19; const int un = hn ? remap8(tn, 128 * 19) : 0;
        gemm_tile<false>(lds, g, (u / 19) * 128, (u % 19) * 128, e, st_, hn ? (un / 19) * 128 : -1, (un % 19) * 128); st_ = hn; } }
    GBAR; TSTAMP(1)
    { WSPTRS GemmArgs gq{P, NP, (const bf16_t*)(ws + OFF_WUQ), 192, 192, nullptr}; EpiUq eq{QA, SSA, C32, S32};
      GemmArgs gk{P + 256, NP, (const bf16_t*)(ws + OFF_WKV), 128, 128, nullptr}; EpiKv ek{KN, VTA, SSA, kmax};
      for (int t = bid_(); t < 896; t += gridDim.x) { const int u = remap8(t, 896);
        if (u < 384) gemm_tile<false>(lds, gq, (u / 3) * 128, (u % 3) * 128, eq);
        else { const int v = u - 384; gemm_tile<false>(lds, gk, (v >> 2) * 128, (v & 3) * 128, ek); } } }
    GBAR; TSTAMP(2)
    { WSPTRS AttnArgs a{P, VT, QA, KN, VTA, MIX, SSM, kmax, p.lq1 + l * 32, p.lk1 + l * 32, p.lq2 + l * 32, p.lk2 + l * 32, p.subln_g + l * 64, p.sinks + l * 4,
                 p.rpb + l * 4 * 465, p.lam_init[l]};
      unsigned* ctr = CTRL + 128 + 32 * l;
      if (threadIdx.x == 0) { int z_ = 0; asm volatile("" : "+v"(z_)); s_q[0] = z_; s_q[1] = z_; }
      for (;;) {
        if (threadIdx.x == 0) {
          const int xcc = (int)(__builtin_amdgcn_s_getreg((3 << 11) | 20) & 7u);
          const int pq_ = s_q[0]; int pass = pq_ >> 3, dq = pq_ & 7;
          int it = -1;
          if (((blockIdx.x >> 8) & 1u) && s_q[1] < 2) { const int idx = (int)atomicAdd(ctr + 16, 1u); if (idx < 1024) { it = 2048 + idx; s_q[1] = s_q[1] + 1; } else s_q[1] = 2; }
          if (it < 0)
          while (pass < 2) {
            const int ep = pass ^ (int)((blockIdx.x >> 8) & 1u);
            const int q = (xcc + dq) & 7; const int idx = (int)atomicAdd(ctr + ep * 8 + q, 1u);
            if (idx < 64) { it = ep * 1024 + (((((q >> 2) * 64 + idx) << 2)) | (q & 3)); break; }
            if (++dq == 8) { dq = 0; ++pass; }
          }
          if (it < 0) { const int idx = (int)atomicAdd(ctr + 16, 1u); it = idx < 1024 ? 2048 + idx : -1; }
          s_item = it; s_q[0] = pass * 8 + dq;
        }
        __syncthreads(); const int item = s_item; __syncthreads();
        if (item < 0) break;
        if (item < 1024) { if (!attn_pipe<1>(lds, a, item)) attn_item<1>(lds, a, item); }
        else if (item < 2048) { if (!attn_pipe<0>(lds, a, item - 1024)) attn_item<0>(lds, a, item - 1024); }
        else if (item < 2560) attn_item<2>(lds, a, item - 2048);
        else attn_item<3>(lds, a, item - 2560);
      } }
    TSTAMP(7)
    GBAR; TSTAMP(3)
    { WSPTRS GemmArgs g{MIX, 1024, (const bf16_t*)(ws + OFF_WOUT), 1024, 1024, SSM};
      EpiRes e{XB, SSX};
      bool st_ = false;
      for (int t = bid_(); t < 1024; t += gridDim.x) { const int u = remap8(t, 1024); const int tn = t + (int)gridDim.x; const bool hn = tn < 1024; const int un = hn ? remap8(tn, 1024) : 0;
        gemm_tile<true>(lds, g, (u >> 3) * 128, (u & 7) * 128, e, st_, hn ? (un >> 3) * 128 : -1, (un & 7) * 128); st_ = hn; } }
    GBAR; TSTAMP(4)
    { WSPTRS GemmArgs g{XB, 1024, (const bf16_t*)(ws + OFF_WUP), 1024, 1024, nullptr}; EpiUp4 e{H, SSX};
      gemm_stream<false>(lds, g, 32, 2048, e); }
    GBAR; TSTAMP(5)
    { WSPTRS GemmArgs g{H, 4096, (const bf16_t*)(ws + OFF_WDN), 4096, 4096, nullptr}; EpiRes e{XB, SSX};
      bool st_ = false;
      for (int t = bid_(); t < 1024; t += gridDim.x) { const int u = remap8(t, 1024); const int tn = t + (int)gridDim.x; const bool hn = tn < 1024; const int un = hn ? remap8(tn, 1024) : 0;
        gemm_tile<false>(lds, g, (u >> 3) * 128, (u & 7) * 128, e, st_, hn ? (un >> 3) * 128 : -1, (un & 7) * 128); st_ = hn; } }
    GBAR; TSTAMP(6)
  }
  const int l = 0; WSPTRS
  int tid_ = threadIdx.x; asm volatile("" : "+v"(tid_));
  const int lane = tid_ & 63, gw = bid_() * 4 + (tid_ >> 6), nw = gridDim.x * 4;
  for (int row = gw; row < S; row += nw) {
    const float rr = rowscale_ssx(SSX, row);
    const u32x2* xr = (const u32x2*)(XB + (size_t)row * 1024); f32x4* orow = (f32x4*)(p.out + (size_t)row * 1024);
#pragma unroll
    for (int i = 0; i < 4; ++i) { const u32x2 w = xr[lane + 64 * i]; const f32x4 g = ((const f32x4*)p.fin_g)[lane + 64 * i]; f32x4 v;
      v[0] = bf2f(w.x & 0xffffu); v[1] = __uint_as_float(w.x & 0xffff0000u); v[2] = bf2f(w.y & 0xffffu); v[3] = __uint_as_float(w.y & 0xffff0000u);
      orow[lane + 64 * i] = v * rr * g; }
  }
#ifdef PROBE_SEL
  { const int l = 0; WSPTRS
    if (blockIdx.x == 0 && threadIdx.x == 0) {
      unsigned long long tot = 0, sel = 0;
      for (int i = 0; i < 9; ++i) { tot += s_t[i]; if ((PROBE_SEL >> i) & 1) sel += s_t[i]; }
      ((float*)CTRL)[500] = (float)((double)sel / (double)tot);
    }
    grid.sync();
    const float fr = ((const float*)CTRL)[500];
    for (int row = gw; row < 64; row += nw) {
      f32x4* xr = (f32x4*)(p.out + (size_t)row * 1024);
      for (int i = 0; i < 4; ++i) { f32x4 v = xr[lane + 64 * i]; const float d = 0.05f * fr; v[0] += d; v[1] -= d; v[2] += d; v[3] -= d; xr[lane + 64 * i] = v; }
    }
  }
#endif
}

extern "C" void kernel_launch(void* const* d_in, const int* in_sizes, int n_in, void* d_out, int out_size,
                              void* d_ws, size_t ws_size, hipStream_t stream) {
  static int grid_blocks = 0;
  if (!grid_blocks) {
    int dev = 0, cus = 0, per_cu = 0;
    (void)hipGetDevice(&dev);
    (void)hipDeviceGetAttribute(&cus, hipDeviceAttributeMultiprocessorCount, dev);
    (void)hipOccupancyMaxActiveBlocksPerMultiprocessor(&per_cu, mega, 256, 0);
    per_cu = 2;
    grid_blocks = cus * per_cu;
  }
  Params p{};
  const float** pp = (const float**)&p;
  for (int i = 0; i < 23; ++i) pp[i] = (const float*)d_in[i];
  p.out = (float*)d_out; p.ws = (char*)d_ws;
  for (int l = 0; l < 4; ++l) p.lam_init[l] = (float)(0.8 - 0.6 * exp(-0.3 * (double)l));
  void* args[] = {&p};
  hipError_t e = hipLaunchCooperativeKernel((void*)mega, dim3(grid_blocks), dim3(256), args, 0, stream);
  if (e != hipSuccess) fprintf(stderr, "cooperative launch failed: %s (grid %d)\n", hipGetErrorString(e), grid_blocks);
}
```

```cpp
#include <hip/hip_runtime.h>
#include <hip/hip_cooperative_groups.h>
#include <cstdio>
#include <cmath>
namespace cg = cooperative_groups;

typedef unsigned short bf16_t;
typedef short bf16x8 __attribute__((ext_vector_type(8)));
typedef float f32x16 __attribute__((ext_vector_type(16)));
typedef float f32x4 __attribute__((ext_vector_type(4)));
typedef float f32x2 __attribute__((ext_vector_type(2)));
typedef unsigned u32x2 __attribute__((ext_vector_type(2)));
typedef unsigned u32x4 __attribute__((ext_vector_type(4)));
typedef __bf16 bf2_t __attribute__((ext_vector_type(2)));

constexpr int S = 16384, NP = 2432, VLD = S + 128;
constexpr float EPS = 1e-6f, LOG2E = 1.4426950408889634f;

constexpr size_t OFF_WIN = 0;
constexpr size_t OFF_WOUT = OFF_WIN + (size_t)NP * 1024 * 2;
constexpr size_t OFF_WUP = OFF_WOUT + (size_t)1024 * 1024 * 2;
constexpr size_t OFF_WDN = OFF_WUP + (size_t)4096 * 1024 * 2;
constexpr size_t OFF_WUQ = OFF_WDN + (size_t)4096 * 1024 * 2;
constexpr size_t OFF_WKV = OFF_WUQ + (size_t)384 * 192 * 2;
constexpr size_t OFF_XB = OFF_WKV + (size_t)512 * 128 * 2;
constexpr size_t OFF_MIX = OFF_XB + (size_t)S * 1024 * 2;
constexpr size_t OFF_R1 = OFF_MIX + (size_t)S * 1024 * 2;
constexpr size_t OFF_P = OFF_R1;
constexpr size_t OFF_VT = OFF_P + (size_t)S * NP * 2;
constexpr size_t OFF_QA = OFF_VT + (size_t)640 * VLD * 2;
constexpr size_t OFF_KN = OFF_QA + (size_t)S * 384 * 2;
constexpr size_t OFF_VTA = OFF_KN + (size_t)S * 256 * 2;
constexpr size_t OFF_H = OFF_R1;
constexpr size_t OFF_TAB = OFF_R1 + (size_t)S * 4096 * 2;
constexpr size_t OFF_SSX = OFF_TAB + (size_t)S * 96 * 4;
constexpr size_t OFF_SSA = OFF_SSX + (size_t)S * 16 * 4;
constexpr size_t OFF_SSM = OFF_SSA + (size_t)S * 8 * 4;
constexpr size_t OFF_CTRL = OFF_SSM + (size_t)12 * S * 4;
static_assert(OFF_VTA + (size_t)256 * VLD * 2 <= OFF_TAB, "overlay");

struct Params {
  const float *x, *norm1_g, *w_in, *qn_g, *w_uq, *kvn_g, *w_uk, *w_uv, *lq1, *lk1, *lq2, *lk2, *subln_g, *sinks, *rpb,
      *g_mla, *g_swa, *g_na, *w_out, *norm2_g, *w_up, *w_down, *fin_g;
  float* out; char* ws; float lam_init[4];
};

__device__ __forceinline__ unsigned pk2(float a, float b) { bf2_t r = __builtin_convertvector((f32x2){a, b}, bf2_t); return __builtin_bit_cast(unsigned, r); }
__device__ __forceinline__ bf16_t f2bf(float a) { return (bf16_t)(pk2(a, 0.f) & 0xffffu); }
__device__ __forceinline__ float bf2f(unsigned v) { return __uint_as_float(v << 16); }
__device__ __forceinline__ int crow(int r, int h) { return (r & 3) + 8 * (r >> 2) + 4 * h; }
__device__ __forceinline__ int permtok(int t) { return (t & ~12) | ((t & 4) << 1) | ((t & 8) >> 1); }
__device__ __forceinline__ int remap8(int t, int T) { return (t & 7) * (T >> 3) + (t >> 3); }
__device__ __forceinline__ int bid_() { int b = blockIdx.x; asm volatile("" : "+s"(b)); return b; }
#define MFMA(a, b, c) __builtin_amdgcn_mfma_f32_32x32x16_bf16((a), (b), (c), 0, 0, 0)

struct GemmArgs { const bf16_t* A; int lda; const bf16_t* Bt; int ldb; int K; const float* asc; };

#define LAS3 __attribute__((address_space(3)))
template <int V> struct IntC { static constexpr int value = V; };
__device__ __forceinline__ float seg_rscale(const float* asc, int seg, int tok) {
  if (seg == 1) return 1.f;
  const int idx = seg == 0 ? 0 : (seg == 2 ? 1 : 2);
  const float* sp = asc + (size_t)idx * 4 * S + tok;
  return rsqrtf((sp[0] + sp[S] + sp[2 * S] + sp[3 * S]) * (1.f / 256.f) + EPS);
}
template <bool ASC, class Epi>
__device__ __forceinline__ void gemm_tile(char* lds, const GemmArgs& g, int m0, int n0, const Epi& epi, bool staged = false, int nm0 = -1, int nn0 = 0) {
  int tid_ = threadIdx.x; asm volatile("" : "+v"(tid_));
  const int tid = tid_, lane = tid & 63, wid = __builtin_amdgcn_readfirstlane(tid >> 6), wr = wid >> 1, wc = wid & 1, c = lane & 31, h = lane >> 5;
  f32x16 acc[2][2];
#pragma unroll
  for (int i = 0; i < 2; ++i)
#pragma unroll
    for (int j = 0; j < 2; ++j)
#pragma unroll
      for (int r = 0; r < 16; ++r) acc[i][j][r] = 0.f;
  const int prow = tid >> 3, gch = (tid & 7) ^ ((prow >> 1) & 7);
  const bf16_t* Ap; Ap = g.A + (size_t)(m0 + prow) * g.lda + gch * 8;
  const bf16_t* Bp; Bp = g.Bt + (size_t)(n0 + prow) * g.ldb + gch * 8;
  (void)0;
  const size_t astep = (size_t)32 * g.lda, bstep = (size_t)32 * g.ldb;
  LAS3 char* l3 = (LAS3 char*)lds;
  const int nk = g.K >> 6;
  auto stage = [&](int kt, auto BUFC) {
    constexpr int buf = decltype(BUFC)::value;
#pragma unroll
    for (int i = 0; i < 4; ++i) {
      __builtin_amdgcn_global_load_lds((const unsigned*)(Ap + i * astep + kt * 64), (LAS3 unsigned*)(l3 + buf * 32768 + (256 * i + 64 * wid) * 16), 16, 0, 0);
      __builtin_amdgcn_global_load_lds((const unsigned*)(Bp + i * bstep + kt * 64), (LAS3 unsigned*)(l3 + buf * 32768 + 16384 + (256 * i + 64 * wid) * 16), 16, 0, 0);
    }
  };
  const int swz = (c >> 1) & 7;
  const unsigned lbase = (unsigned)(size_t)l3;
  const unsigned aoff = (wr * 64 + c) * 128, boff = 16384 + (wc * 64 + c) * 128;
  unsigned kofs[4];
#pragma unroll
  for (int ks = 0; ks < 4; ++ks) kofs[ks] = ((2 * ks + h) ^ swz) << 4;
  float rcur[2] = {1.f, 1.f};
  if (ASC) { rcur[0] = seg_rscale(g.asc, 0, m0 + wr * 64 + c); rcur[1] = seg_rscale(g.asc, 0, m0 + wr * 64 + 32 + c); }
  if (!staged) stage(0, IntC<0>{});
  asm volatile("s_waitcnt vmcnt(0)" ::: "memory"); __syncthreads();
  auto body = [&](int kt, auto BUFC) {
    constexpr int buf = decltype(BUFC)::value;
    if (kt + 1 < nk) stage(kt + 1, IntC<1 - buf>{});
    if (ASC) { if (kt > 0 && (kt & 3) == 0) {
#pragma unroll
      for (int mt = 0; mt < 2; ++mt) { const float rn = seg_rscale(g.asc, kt >> 2, m0 + wr * 64 + mt * 32 + c); const float f = rcur[mt] / rn; rcur[mt] = rn;
        acc[mt][0] = acc[mt][0] * f; acc[mt][1] = acc[mt][1] * f; } } }
    bf16x8 fr[2][4];
#define GRD(set, ks) { const unsigned aa_ = lbase + buf * 32768 + aoff + kofs[ks], bb_ = lbase + buf * 32768 + boff + kofs[ks]; \
      asm volatile("ds_read_b128 %0, %1" : "=v"(fr[set][0]) : "v"(aa_)); asm volatile("ds_read_b128 %0, %1 offset:4096" : "=v"(fr[set][1]) : "v"(aa_)); \
      asm volatile("ds_read_b128 %0, %1" : "=v"(fr[set][2]) : "v"(bb_)); asm volatile("ds_read_b128 %0, %1 offset:4096" : "=v"(fr[set][3]) : "v"(bb_)); }
    GRD(0, 0);
#pragma unroll
    for (int ks = 0; ks < 4; ++ks) {
      if (ks < 3) { GRD((ks + 1) & 1, ks + 1); asm volatile("s_waitcnt lgkmcnt(4)" : "+v"(fr[ks & 1][0]), "+v"(fr[ks & 1][1]), "+v"(fr[ks & 1][2]), "+v"(fr[ks & 1][3])); }
      else asm volatile("s_waitcnt lgkmcnt(0)" : "+v"(fr[ks & 1][0]), "+v"(fr[ks & 1][1]), "+v"(fr[ks & 1][2]), "+v"(fr[ks & 1][3]));
      __builtin_amdgcn_s_setprio(1);
#pragma unroll
      for (int mt = 0; mt < 2; ++mt)
#pragma unroll
        for (int nt = 0; nt < 2; ++nt) acc[mt][nt] = MFMA(fr[ks & 1][2 + nt], fr[ks & 1][mt], acc[mt][nt]);
      __builtin_amdgcn_s_setprio(0);
    }
#undef GRD
    asm volatile("s_waitcnt vmcnt(0)" ::: "memory"); __builtin_amdgcn_s_barrier(); asm volatile("" ::: "memory");
  };
  for (int kt = 0; kt < nk; kt += 2) { body(kt, IntC<0>{}); if (kt + 1 < nk) body(kt + 1, IntC<1>{}); }
  if constexpr (Epi::kLds) {
    if (ASC) {
#pragma unroll
      for (int mt = 0; mt < 2; ++mt) { acc[mt][0] = acc[mt][0] * rcur[mt]; acc[mt][1] = acc[mt][1] * rcur[mt]; } }
    epi(acc, m0, n0, wr, wc, c, h, lds);
    if (nm0 >= 0) { Ap = g.A + (size_t)(nm0 + prow) * g.lda + gch * 8; Bp = g.Bt + (size_t)(nn0 + prow) * g.ldb + gch * 8; stage(0, IntC<0>{}); }
  } else {
  if (nm0 >= 0) {
    Ap = g.A + (size_t)(nm0 + prow) * g.lda + gch * 8; Bp = g.Bt + (size_t)(nn0 + prow) * g.ldb + gch * 8;
    stage(0, IntC<0>{});
  }
  if (ASC) {
#pragma unroll
    for (int mt = 0; mt < 2; ++mt) { acc[mt][0] = acc[mt][0] * rcur[mt]; acc[mt][1] = acc[mt][1] * rcur[mt]; } }
  epi(acc, m0, n0, wr, wc, c, h);
  }
}

__device__ __forceinline__ void tile_rc256(int t, int NT, int& m0, int& n0) {
  const int x = t & 7, j = t >> 3;
  m0 = (x * 8 + (j & 7)) * 256; n0 = (j >> 3) * 128; (void)NT;
}
template <bool ASC, class Epi>
__device__ __forceinline__ void gemm_stream(char* lds, const GemmArgs& g, int NT, int ntiles, const Epi& epi) {
  int tid_ = threadIdx.x; asm volatile("" : "+v"(tid_));
  const int tid = tid_, lane = tid & 63, wid = __builtin_amdgcn_readfirstlane(tid >> 6), wr = wid >> 1, wc = wid & 1, c = lane & 31, h = lane >> 5;
  const int b = bid_(), G = (int)gridDim.x;
  __builtin_amdgcn_s_barrier();
  if (b >= ntiles) return;
  const int nk = g.K >> 5, my_tiles = (ntiles - b + G - 1) / G, total = my_tiles * nk;
  LAS3 char* l3 = (LAS3 char*)lds;
  const unsigned lbase = (unsigned)(size_t)l3;
  const int prow = tid >> 2, gch = (tid & 3) ^ ((tid >> 4) & 3);
  int s_t = b, s_kt = 0, sm0, sn0; tile_rc256(s_t, NT, sm0, sn0);
  const bf16_t* Ap = g.A + (size_t)(sm0 + prow) * g.lda + gch * 8;
  const bf16_t* Bp = g.Bt + (size_t)(sn0 + prow) * g.ldb + gch * 8;
  const size_t astep = (size_t)64 * g.lda, bstep = (size_t)64 * g.ldb;
  auto stage = [&](int slot) {
    LAS3 char* d = l3 + slot * 24576 + wid * 1024;
    __builtin_amdgcn_global_load_lds((const unsigned*)(Ap), (LAS3 unsigned*)(d), 16, 0, 0);
    __builtin_amdgcn_global_load_lds((const unsigned*)(Ap + astep), (LAS3 unsigned*)(d + 4096), 16, 0, 0);
    __builtin_amdgcn_global_load_lds((const unsigned*)(Ap + 2 * astep), (LAS3 unsigned*)(d + 8192), 16, 0, 0);
    __builtin_amdgcn_global_load_lds((const unsigned*)(Ap + 3 * astep), (LAS3 unsigned*)(d + 12288), 16, 0, 0);
    __builtin_amdgcn_global_load_lds((const unsigned*)(Bp), (LAS3 unsigned*)(d + 16384), 16, 0, 0);
    __builtin_amdgcn_global_load_lds((const unsigned*)(Bp + bstep), (LAS3 unsigned*)(d + 20480), 16, 0, 0);
    Ap += 32; Bp += 32;
    if (++s_kt == nk) { s_kt = 0; s_t += G; if (s_t < ntiles) { tile_rc256(s_t, NT, sm0, sn0);
        Ap = g.A + (size_t)(sm0 + prow) * g.lda + gch * 8; Bp = g.Bt + (size_t)(sn0 + prow) * g.ldb + gch * 8; } }
  };
  int c_t = b, c_kt = 0, cm0, cn0; tile_rc256(c_t, NT, cm0, cn0);
  f32x16 acc[4][2];
#pragma unroll
  for (int i = 0; i < 4; ++i)
#pragma unroll
    for (int j = 0; j < 2; ++j)
#pragma unroll
      for (int r = 0; r < 16; ++r) acc[i][j][r] = 0.f;
  const unsigned swz = (c >> 2) & 3;
  const unsigned aoff = (wr * 128 + c) * 64, boff = 16384 + (wc * 64 + c) * 64;
  const unsigned ko0 = ((0 + h) ^ swz) << 4, ko1 = ((2 + h) ^ swz) << 4;
  float rcur[4] = {1.f, 1.f, 1.f, 1.f};
  if (ASC) {
#pragma unroll
    for (int mt = 0; mt < 4; ++mt) rcur[mt] = seg_rscale(g.asc, 0, cm0 + wr * 128 + mt * 32 + c); }
  stage(0); if (total > 1) stage(1);
  int cslot = 0;
  for (int gi = 0; gi < total; ++gi) {
    if (gi + 1 < total) asm volatile("s_waitcnt vmcnt(6)" ::: "memory");
    else asm volatile("s_waitcnt vmcnt(0)" ::: "memory");
    __builtin_amdgcn_s_barrier(); asm volatile("" ::: "memory");
    if (gi + 2 < total) stage(cslot == 0 ? 2 : cslot - 1);
    if (ASC) { if (c_kt > 0 && (c_kt & 7) == 0) {
#pragma unroll
      for (int mt = 0; mt < 4; ++mt) { const float rn = seg_rscale(g.asc, c_kt >> 3, cm0 + wr * 128 + mt * 32 + c); const float f = rcur[mt] / rn; rcur[mt] = rn;
        acc[mt][0] = acc[mt][0] * f; acc[mt][1] = acc[mt][1] * f; } } }
    const unsigned sb = lbase + cslot * 24576;
    cslot = cslot == 2 ? 0 : cslot + 1;
    bf16x8 fa[4], fb[2], ga[4], gb[2];
    { const unsigned a0 = sb + aoff + ko0, a1 = sb + aoff + ko1, b0 = sb + boff + ko0, b1 = sb + boff + ko1;
      asm volatile("ds_read_b128 %0, %1" : "=v"(fa[0]) : "v"(a0)); asm volatile("ds_read_b128 %0, %1 offset:2048" : "=v"(fa[1]) : "v"(a0));
      asm volatile("ds_read_b128 %0, %1 offset:4096" : "=v"(fa[2]) : "v"(a0)); asm volatile("ds_read_b128 %0, %1 offset:6144" : "=v"(fa[3]) : "v"(a0));
      asm volatile("ds_read_b128 %0, %1" : "=v"(fb[0]) : "v"(b0)); asm volatile("ds_read_b128 %0, %1 offset:2048" : "=v"(fb[1]) : "v"(b0));
      asm volatile("ds_read_b128 %0, %1" : "=v"(ga[0]) : "v"(a1)); asm volatile("ds_read_b128 %0, %1 offset:2048" : "=v"(ga[1]) : "v"(a1));
      asm volatile("ds_read_b128 %0, %1 offset:4096" : "=v"(ga[2]) : "v"(a1)); asm volatile("ds_read_b128 %0, %1 offset:6144" : "=v"(ga[3]) : "v"(a1));
      asm volatile("ds_read_b128 %0, %1" : "=v"(gb[0]) : "v"(b1)); asm volatile("ds_read_b128 %0, %1 offset:2048" : "=v"(gb[1]) : "v"(b1)); }
    asm volatile("s_waitcnt lgkmcnt(6)" : "+v"(fa[0]), "+v"(fa[1]), "+v"(fa[2]), "+v"(fa[3]), "+v"(fb[0]), "+v"(fb[1]));
    __builtin_amdgcn_s_setprio(1);
#pragma unroll
    for (int mt = 0; mt < 4; ++mt)
#pragma unroll
      for (int nt = 0; nt < 2; ++nt) acc[mt][nt] = MFMA(fb[nt], fa[mt], acc[mt][nt]);
    __builtin_amdgcn_s_setprio(0);
    asm volatile("s_waitcnt lgkmcnt(0)" : "+v"(ga[0]), "+v"(ga[1]), "+v"(ga[2]), "+v"(ga[3]), "+v"(gb[0]), "+v"(gb[1]));
    __builtin_amdgcn_s_setprio(1);
#pragma unroll
    for (int mt = 0; mt < 4; ++mt)
#pragma unroll
      for (int nt = 0; nt < 2; ++nt) acc[mt][nt] = MFMA(gb[nt], ga[mt], acc[mt][nt]);
    __builtin_amdgcn_s_setprio(0);
    if (++c_kt == nk) {
      if (ASC) {
#pragma unroll
        for (int mt = 0; mt < 4; ++mt) { acc[mt][0] = acc[mt][0] * rcur[mt]; acc[mt][1] = acc[mt][1] * rcur[mt]; } }
      { int c2_ = c, h2_ = h; asm volatile("" : "+v"(c2_), "+v"(h2_));
        epi(acc, cm0, cn0, wr, wc, c2_, h2_); }
#pragma unroll
      for (int i = 0; i < 4; ++i)
#pragma unroll
        for (int j = 0; j < 2; ++j)
#pragma unroll
          for (int r = 0; r < 16; ++r) acc[i][j][r] = 0.f;
      c_kt = 0; c_t += G;
      if (c_t < ntiles) { tile_rc256(c_t, NT, cm0, cn0);
        if (ASC) {
#pragma unroll
          for (int mt = 0; mt < 4; ++mt) rcur[mt] = seg_rscale(g.asc, 0, cm0 + wr * 128 + mt * 32 + c); } }
    }
  }
}

__device__ __forceinline__ void store_plain(bf16_t* dst, const f32x16& v, int h) {
#pragma unroll
  for (int g = 0; g < 4; ++g) { u32x2 w; w.x = pk2(v[4 * g], v[4 * g + 1]); w.y = pk2(v[4 * g + 2], v[4 * g + 3]); *(u32x2*)(dst + 8 * g + 4 * h) = w; }
}
__device__ __forceinline__ void store_vt(bf16_t* vt, int featbase, int tok, const f32x16& v, int h) {
  const int pt = permtok(tok);
#pragma unroll
  for (int r = 0; r < 16; ++r) vt[(size_t)(featbase + crow(r, h)) * VLD + pt] = f2bf(v[r]);
}
__device__ __forceinline__ void rope32(f32x16& v, const float* c32, const float* s32, int tok, int h) {
  const f32x4 ca = *(const f32x4*)(c32 + tok * 16 + 4 * h), cb = *(const f32x4*)(c32 + tok * 16 + 8 + 4 * h);
  const f32x4 sa = *(const f32x4*)(s32 + tok * 16 + 4 * h), sb = *(const f32x4*)(s32 + tok * 16 + 8 + 4 * h);
#pragma unroll
  for (int i = 0; i < 4; ++i) {
    float x1 = v[i], x2 = v[i + 8]; v[i] = x1 * ca[i] - x2 * sa[i]; v[i + 8] = x2 * ca[i] + x1 * sa[i];
    x1 = v[4 + i]; x2 = v[12 + i]; v[4 + i] = x1 * cb[i] - x2 * sb[i]; v[12 + i] = x2 * cb[i] + x1 * sb[i];
  }
}
__device__ __forceinline__ void rope64(f32x16& v0, f32x16& v1, const float* c64, const float* s64, int tok, int h) {
#pragma unroll
  for (int g = 0; g < 4; ++g) {
    const f32x4 cg4 = *(const f32x4*)(c64 + tok * 32 + 8 * g + 4 * h), sg4 = *(const f32x4*)(s64 + tok * 32 + 8 * g + 4 * h);
#pragma unroll
    for (int i = 0; i < 4; ++i) { const float x1 = v0[4 * g + i], x2 = v1[4 * g + i]; v0[4 * g + i] = x1 * cg4[i] - x2 * sg4[i]; v1[4 * g + i] = x2 * cg4[i] + x1 * sg4[i]; }
  }
}
__device__ __forceinline__ float sumsq16(const f32x16& v) { float s = 0.f;
#pragma unroll
  for (int r = 0; r < 16; ++r) s += v[r] * v[r];
  return s; }
__device__ __forceinline__ void kmax_update(unsigned* slot, float s) {
  s += __shfl_xor(s, 32);
#pragma unroll
  for (int o = 16; o; o >>= 1) s = fmaxf(s, __shfl_xor(s, o));
  if ((threadIdx.x & 63) == 0) atomicMax(slot, __float_as_uint(s));
}
__device__ __forceinline__ float rowscale_ssx(const float* ssx, int tok) {
  const f32x4* sp = (const f32x4*)(ssx + (size_t)tok * 16); const f32x4 a = sp[0], b = sp[1], c = sp[2], d = sp[3];
  const float t = ((a[0] + a[1]) + (a[2] + a[3])) + ((b[0] + b[1]) + (b[2] + b[3])) + ((c[0] + c[1]) + (c[2] + c[3])) + ((d[0] + d[1]) + (d[2] + d[3]));
  return rsqrtf(t * (1.f / 1024.f) + EPS);
}

struct EpiIn { static constexpr int kLds = 0;
  bf16_t* P; bf16_t* Vt; const float* ssx; float* ssa; const float *c32, *s32, *c64, *s64; unsigned* kmax;
  __device__ __forceinline__ void operator()(f32x16 (&acc)[2][2], int m0, int n0, int wr, int wc, int c, int h) const {
    const int g64 = (n0 >> 6) + wc;
    int vtb = -1, kslot = -1, ssl = -1; bool r32 = false, r64 = false;
    if (g64 <= 5) { if (g64 == 3) { r32 = true; kslot = 4; } else ssl = g64; }
    else if (g64 <= 13) { r32 = true; if (g64 >= 10) kslot = 5 + (g64 - 10); }
    else if (g64 <= 17) vtb = (g64 - 14) * 64;
    else if (g64 <= 23) { r64 = true; if (g64 >= 22) kslot = 9 + (g64 - 22); }
    else if (g64 <= 25) vtb = 256 + (g64 - 24) * 64;
    else if (g64 <= 33) { if (g64 >= 30) kslot = 11 + (g64 - 30); }
    else vtb = 384 + (g64 - 34) * 64;
#pragma unroll
    for (int mt = 0; mt < 2; ++mt) {
      const int tok = m0 + wr * 64 + mt * 32 + c;
      const float rr = rowscale_ssx(ssx, tok);
      f32x16 v0 = acc[mt][0] * rr, v1 = acc[mt][1] * rr;
      if (vtb >= 0) { store_vt(Vt, vtb, tok, v0, h); store_vt(Vt, vtb + 32, tok, v1, h); continue; }
      if (r32) { rope32(v0, c32, s32, tok, h); if (g64 != 3) rope32(v1, c32, s32, tok, h); }
      if (r64) rope64(v0, v1, c64, s64, tok, h);
      bf16_t* dst = P + (size_t)tok * NP + g64 * 64;
      store_plain(dst, v0, h); store_plain(dst + 32, v1, h);
      if (kslot >= 0) kmax_update(kmax + kslot, sumsq16(v0) + (g64 == 3 ? 0.f : sumsq16(v1)));
      if (ssl >= 0) { float s = sumsq16(v0) + sumsq16(v1); s += __shfl_xor(s, 32); if (h == 0) ssa[(size_t)tok * 8 + ssl] = s; }
    }
  }
};
struct EpiUq { static constexpr int kLds = 0;
  bf16_t* Qa; const float* ssa; const float *c32, *s32;
  __device__ __forceinline__ void operator()(f32x16 (&acc)[2][2], int m0, int n0, int wr, int wc, int c, int h) const {
    const int g32 = ((n0 >> 6) + wc) * 2;
#pragma unroll
    for (int mt = 0; mt < 2; ++mt) {
      const int tok = m0 + wr * 64 + mt * 32 + c;
      const float* sp = ssa + (size_t)tok * 8; const float rr = rsqrtf((sp[0] + sp[1] + sp[2]) * (1.f / 192.f) + EPS);
#pragma unroll
      for (int nt = 0; nt < 2; ++nt) {
        f32x16 v = acc[mt][nt] * rr;
        if ((g32 + nt) % 3 == 2) rope32(v, c32, s32, tok, h);
        store_plain(Qa + (size_t)tok * 384 + (g32 + nt) * 32, v, h);
      }
    }
  }
};
struct EpiKv { static constexpr int kLds = 0;
  bf16_t* KN; bf16_t* VtA; const float* ssa; unsigned* kmax;
  __device__ __forceinline__ void operator()(f32x16 (&acc)[2][2], int m0, int n0, int wr, int wc, int c, int h) const {
    const int g64 = (n0 >> 6) + wc;
#pragma unroll
    for (int mt = 0; mt < 2; ++mt) {
      const int tok = m0 + wr * 64 + mt * 32 + c;
      const float* sp = ssa + (size_t)tok * 8; const float rr = rsqrtf((sp[4] + sp[5]) * (1.f / 128.f) + EPS);
      const f32x16 v0 = acc[mt][0] * rr, v1 = acc[mt][1] * rr;
      if (g64 < 4) {
        bf16_t* dst = KN + (size_t)tok * 256 + g64 * 64; store_plain(dst, v0, h); store_plain(dst + 32, v1, h);
        kmax_update(kmax + g64, sumsq16(v0) + sumsq16(v1));
      } else { store_vt(VtA, (g64 - 4) * 64, tok, v0, h); store_vt(VtA, (g64 - 4) * 64 + 32, tok, v1, h); }
    }
  }
};
struct EpiRes {
  static constexpr int kLds = 1;
  bf16_t* xb; float* ssx;
  __device__ __forceinline__ void operator()(f32x16 (&acc)[2][2], int m0, int n0, int wr, int wc, int c, int h, char* lds) const {
    char* st = lds + 32768 + (wr * 2 + wc) * 9216;
#pragma unroll
    for (int mt = 0; mt < 2; ++mt)
#pragma unroll
      for (int nt = 0; nt < 2; ++nt)
#pragma unroll
        for (int g = 0; g < 4; ++g) { u32x2 w; w.x = pk2(acc[mt][nt][4 * g], acc[mt][nt][4 * g + 1]); w.y = pk2(acc[mt][nt][4 * g + 2], acc[mt][nt][4 * g + 3]);
          *(u32x2*)(st + (mt * 32 + c) * 144 + (nt * 32 + 8 * g + 4 * h) * 2) = w; }
    const int lane = h * 32 + c, rr = lane >> 3, ch = lane & 7;
#pragma unroll
    for (int j = 0; j < 8; ++j) {
      const int row = j * 8 + rr, tok = m0 + wr * 64 + row;
      const u32x4 a4 = *(const u32x4*)(st + row * 144 + ch * 16);
      bf16_t* xp = xb + (size_t)tok * 1024 + n0 + wc * 64 + ch * 8;
      const u32x4 x4 = *(const u32x4*)xp; u32x4 o4; float s = 0.f;
#pragma unroll
      for (int k = 0; k < 4; ++k) {
        const float f0 = bf2f(x4[k] & 0xffffu) + bf2f(a4[k] & 0xffffu), f1 = __uint_as_float(x4[k] & 0xffff0000u) + __uint_as_float(a4[k] & 0xffff0000u);
        s += f0 * f0 + f1 * f1; o4[k] = pk2(f0, f1); }
      *(u32x4*)xp = o4;
      s += __shfl_xor(s, 1); s += __shfl_xor(s, 2); s += __shfl_xor(s, 4);
      if (ch == 0) ssx[(size_t)tok * 16 + (n0 >> 7) * 2 + wc] = s;
    }
  }
};
struct EpiUp {
  static constexpr int kLds = 1;
  bf16_t* H; const float* ssx;
  __device__ __forceinline__ void operator()(f32x16 (&acc)[2][2], int m0, int n0, int wr, int wc, int c, int h, char* lds) const {
    char* st = lds + 32768 + (wr * 2 + wc) * 9216;
#pragma unroll
    for (int mt = 0; mt < 2; ++mt) {
      const int tok = m0 + wr * 64 + mt * 32 + c; const float rr = rowscale_ssx(ssx, tok);
#pragma unroll
      for (int nt = 0; nt < 2; ++nt)
#pragma unroll
        for (int g = 0; g < 4; ++g) { float t[4];
#pragma unroll
          for (int i = 0; i < 4; ++i) { const float u = fmaxf(acc[mt][nt][4 * g + i] * rr, 0.f); t[i] = u * u; }
          u32x2 w; w.x = pk2(t[0], t[1]); w.y = pk2(t[2], t[3]);
          *(u32x2*)(st + (mt * 32 + c) * 144 + (nt * 32 + 8 * g + 4 * h) * 2) = w; }
    }
    const int lane = h * 32 + c, rr8 = lane >> 3, ch = lane & 7;
#pragma unroll
    for (int j = 0; j < 8; ++j) { const int row = j * 8 + rr8;
      const u32x4 a4 = *(const u32x4*)(st + row * 144 + ch * 16);
      *(u32x4*)(H + (size_t)(m0 + wr * 64 + row) * 4096 + n0 + wc * 64 + ch * 8) = a4; }
  }
};

struct EpiUp4 { static constexpr int kLds = 0;
  bf16_t* H; const float* ssx;
  __device__ __forceinline__ void operator()(f32x16 (&acc)[4][2], int m0, int n0, int wr, int wc, int c, int h) const {
#pragma unroll
    for (int mt = 0; mt < 4; ++mt) {
      __builtin_amdgcn_sched_barrier(0);
      const int tok = m0 + wr * 128 + mt * 32 + c; const float rr = rowscale_ssx(ssx, tok);
#pragma unroll
      for (int nt = 0; nt < 2; ++nt) {
        f32x16 v;
#pragma unroll
        for (int r = 0; r < 16; ++r) { const float t = fmaxf(acc[mt][nt][r] * rr, 0.f); v[r] = t * t; }
        store_plain(H + (size_t)tok * 4096 + n0 + wc * 64 + nt * 32, v, h);
      }
    }
  }
};

struct AttnArgs { const bf16_t *P, *Vt, *Qa, *KN, *VtA; bf16_t* mix; float* ssm; const unsigned* kmax;
  const float *lq1, *lk1, *lq2, *lk2, *subln, *sinks, *rpb; float lam_init; };

constexpr int ABUF = 22528, AKOFF = 13312, ATAB = 2 * ABUF;

template <int MODE>
__device__ __forceinline__ void attn_item(char* lds, const AttnArgs& a, int item) {
  constexpr int KSTR = MODE == 0 ? 208 : 144;
  constexpr int NKS = MODE == 0 ? 6 : (MODE == 1 ? 2 : 4);
  constexpr int NKP = MODE == 0 ? 3 : 2;
  constexpr int NQT = MODE == 1 ? 2 : 1;
  int tid_ = threadIdx.x; asm volatile("" : "+v"(tid_));
  const int tid = tid_, lane = tid & 63, wid = tid >> 6, c = lane & 31, h = lane >> 5;
  int hd, sb, se; int qtok[NQT]; const bf16_t* qptr[NQT]; const bf16_t* kbase; const bf16_t* vbase; int k2slot;
  int narow = 0, nars = 0, nahalf = 0, kvh = 0;
  if constexpr (MODE == 0) { hd = item & 3; const int qb = item >> 2; sb = 0; se = 256;
    qtok[0] = qb * 128 + wid * 32 + c; qptr[0] = a.Qa + (size_t)qtok[0] * 384 + hd * 96;
    kbase = a.KN + hd * 64; vbase = a.VtA + (size_t)hd * 64 * VLD; k2slot = hd; }
  else if constexpr (MODE == 1) { hd = item & 3; const int qb = item >> 2; sb = 0; se = 256;
#pragma unroll
    for (int qt = 0; qt < 2; ++qt) { qtok[qt] = qb * 128 + wid * 32 + c; qptr[qt] = a.P + (size_t)qtok[qt] * NP + 384 + hd * 64 + qt * 32; }
    kbase = a.P + 640 + hd * 64; vbase = a.Vt + (size_t)hd * 64 * VLD; k2slot = 5 + hd; }
  else if constexpr (MODE == 2) { hd = item & 3; kvh = hd >> 1; const int qb = item >> 2; sb = max(0, 2 * qb - 2); se = min(256, 2 * qb + 4);
    qtok[0] = qb * 128 + wid * 32 + c; qptr[0] = a.P + (size_t)qtok[0] * NP + 1152 + hd * 64;
    kbase = a.P + 1408 + kvh * 64; vbase = a.Vt + (size_t)(256 + kvh * 64) * VLD; k2slot = 9 + kvh; }
  else { hd = item & 3; const int rg = item >> 2; narow = rg * 2 + (wid >> 1); nahalf = wid & 1; nars = min(max(narow - 4, 0), 248);
    sb = min(max(rg * 2 - 4, 0), 248); se = min(max(rg * 2 - 3, 0), 248) + 8;
    qtok[0] = narow * 64 + nahalf * 32 + c; qptr[0] = a.P + (size_t)qtok[0] * NP + 1664 + hd * 64;
    kbase = a.P + 1920 + hd * 64; vbase = a.Vt + (size_t)(384 + hd * 64) * VLD; k2slot = 11 + hd; }

  bf16x8 qf[NQT][NKS]; float q2max = 0.f;
#pragma unroll
  for (int qt = 0; qt < NQT; ++qt) { float s = 0.f;
#pragma unroll
    for (int ks = 0; ks < NKS; ++ks) { qf[qt][ks] = *(const bf16x8*)(qptr[qt] + ks * 16 + h * 8);
#pragma unroll
      for (int j = 0; j < 8; ++j) { const float f = bf2f((unsigned short)qf[qt][ks][j]); s += f * f; } }
    s += __shfl_xor(s, 32); q2max = fmaxf(q2max, s); }
#pragma unroll
  for (int o = 16; o; o >>= 1) q2max = fmaxf(q2max, __shfl_xor(q2max, o));
  float k2 = __uint_as_float(a.kmax[k2slot]); if (MODE == 0) k2 += __uint_as_float(a.kmax[4]);
  float cb = sqrtf(q2max * k2) * 1.01f + 0.01f;
  if (MODE == 3) {
    float* tab = (float*)(lds + ATAB); const float* rp = a.rpb + hd * 465; float bm = 0.f;
    for (int i = lane; i < 465; i += 64) bm = fmaxf(bm, fabsf(rp[i]));
#pragma unroll
    for (int o = 32; o; o >>= 1) bm = fmaxf(bm, __shfl_xor(bm, o));
    cb += bm * LOG2E;
    for (int i = tid; i < 480; i += 256) { const int dr = i >> 5, dc = i & 31; tab[i] = dc < 31 ? rp[dr * 31 + dc] * LOG2E : 0.f; }
  }
  f32x16 negc;
#pragma unroll
  for (int r = 0; r < 16; ++r) negc[r] = -cb;

  f32x16 O[NQT][2]; float l[NQT];
#pragma unroll
  for (int i = 0; i < NQT; ++i) l[i] = 0.f;
#pragma unroll
  for (int i = 0; i < NQT; ++i)
#pragma unroll
    for (int j = 0; j < 2; ++j)
#pragma unroll
      for (int r = 0; r < 16; ++r) O[i][j][r] = 0.f;

  u32x4 rk[NKP], rv[2];
  auto gload = [&](int st) {
    const int kb = st * 64;
#pragma unroll
    for (int i = 0; i < NKP; ++i) { const int p = tid + 256 * i;
      if (MODE == 0) {
        if (i < 2) { const int row = p >> 3, ch = p & 7; rk[i] = *(const u32x4*)(kbase + (size_t)(kb + row) * 256 + ch * 8); }
        else { const int row = tid >> 2, ch = tid & 3; rk[i] = *(const u32x4*)(a.P + (size_t)(kb + row) * NP + 192 + ch * 8); } }
      else { const int row = p >> 3, ch = p & 7; rk[i] = *(const u32x4*)(kbase + (size_t)(kb + row) * NP + ch * 8); } }
#pragma unroll
    for (int i = 0; i < 2; ++i) { const int p = tid + 256 * i, dv = p >> 3, ch = p & 7; rv[i] = *(const u32x4*)(vbase + (size_t)dv * VLD + kb + ch * 8); }
  };
  auto lstore = [&](int buf) {
    char* b = lds + buf * ABUF;
#pragma unroll
    for (int i = 0; i < NKP; ++i) { const int p = tid + 256 * i;
      if (MODE == 0) { if (i < 2) { const int row = p >> 3, ch = p & 7; *(u32x4*)(b + row * 208 + ch * 16) = rk[i]; } else { const int row = tid >> 2, ch = tid & 3; *(u32x4*)(b + row * 208 + 128 + ch * 16) = rk[i]; } }
      else { const int row = p >> 3, ch = p & 7; *(u32x4*)(b + row * 144 + ch * 16) = rk[i]; } }
#pragma unroll
    for (int i = 0; i < 2; ++i) { const int p = tid + 256 * i, dv = p >> 3, ch = p & 7; *(u32x4*)(b + AKOFF + dv * 144 + ch * 16) = rv[i]; }
  };

  gload(sb); lstore(0); __syncthreads();
  for (int st = sb; st < se; ++st) {
    const int buf = (st - sb) & 1;
    if (st + 1 < se) gload(st + 1);
    __builtin_amdgcn_sched_barrier(0);
    const bool active = MODE != 3 || (st >= nars && st < nars + 8);
    if (active) {
      const char* Kb = lds + buf * ABUF; const char* Vb = Kb + AKOFF;
#pragma unroll
      for (int kt2 = 0; kt2 < 2; ++kt2) {
        f32x16 sc[NQT];
#pragma unroll
        for (int qt = 0; qt < NQT; ++qt) sc[qt] = negc;
        if (MODE != 1) {
#pragma unroll
          for (int ks = 0; ks < NKS; ++ks) { const bf16x8 kf = *(const bf16x8*)(Kb + (kt2 * 32 + c) * KSTR + ks * 32 + h * 16);
#pragma unroll
            for (int qt = 0; qt < NQT; ++qt) sc[qt] = MFMA(kf, qf[qt][ks], sc[qt]); }
        } else {
#pragma unroll
          for (int qt = 0; qt < NQT; ++qt)
#pragma unroll
            for (int ks = 0; ks < NKS; ++ks) { const bf16x8 kf = *(const bf16x8*)(Kb + (kt2 * 32 + c) * KSTR + qt * 64 + ks * 32 + h * 16);
              sc[qt] = MFMA(kf, qf[qt][ks], sc[qt]); }
        }
        if (MODE == 2) {
          const int kb0 = st * 64 + kt2 * 32 - qtok[0];
#pragma unroll
          for (int i = 0; i < 16; ++i) { const int d = kb0 + crow(i, h); const bool ok = d <= 128 && d >= -128;
            sc[0][i] = ok ? sc[0][i] : -INFINITY; }
        }
        if (MODE == 3) {
          const float* trow = (const float*)(lds + ATAB) + (st - narow + 7) * 32;
#pragma unroll
          for (int qt = 0; qt < NQT; ++qt) { const int w = nahalf * 32 + c, cs = min(max(w - 8, 0), 48);
#pragma unroll
            for (int i = 0; i < 16; ++i) { const int kc = kt2 * 32 + crow(i, h); const bool ok = kc >= cs && kc < cs + 16;
              const float bv = trow[(kc - w + 15) & 31]; sc[qt][i] = ok ? sc[qt][i] + bv : -INFINITY; } }
        }
        bf16x8 pf[NQT][2];
#pragma unroll
        for (int qt = 0; qt < NQT; ++qt) {
          float p[16];
#pragma unroll
          for (int i = 0; i < 16; ++i) { p[i] = __builtin_amdgcn_exp2f(sc[qt][i]); l[qt] += p[i]; }
#pragma unroll
          for (int s2 = 0; s2 < 2; ++s2) { u32x4 w; w.x = pk2(p[8 * s2], p[8 * s2 + 1]); w.y = pk2(p[8 * s2 + 2], p[8 * s2 + 3]);
            w.z = pk2(p[8 * s2 + 4], p[8 * s2 + 5]); w.w = pk2(p[8 * s2 + 6], p[8 * s2 + 7]); pf[qt][s2] = __builtin_bit_cast(bf16x8, w); }
        }
#pragma unroll
        for (int dt = 0; dt < 2; ++dt)
#pragma unroll
          for (int s2 = 0; s2 < 2; ++s2) { const bf16x8 vf = *(const bf16x8*)(Vb + (dt * 32 + c) * 144 + kt2 * 64 + s2 * 32 + h * 16);
#pragma unroll
            for (int qt = 0; qt < NQT; ++qt) O[qt][dt] = MFMA(vf, pf[qt][s2], O[qt][dt]); }
      }
    }
    __builtin_amdgcn_sched_barrier(0);
    if (st + 1 < se) lstore(buf ^ 1);
    __syncthreads();
  }

#pragma unroll
  for (int qt = 0; qt < NQT; ++qt) l[qt] += __shfl_xor(l[qt], 32);
  if (MODE == 1) {
    float pa = 0.f, pb = 0.f;
    if (lane < 32) { pa = a.lq1[lane] * a.lk1[lane]; pb = a.lq2[lane] * a.lk2[lane]; }
#pragma unroll
    for (int o = 32; o; o >>= 1) { pa += __shfl_xor(pa, o); pb += __shfl_xor(pb, o); }
    const float lam = expf(pa) - expf(pb) + a.lam_init;
    const float i0 = 1.f / l[0], i1 = lam / l[NQT - 1];
    f32x16 o[2]; float ss = 0.f;
#pragma unroll
    for (int dt = 0; dt < 2; ++dt)
#pragma unroll
      for (int r = 0; r < 16; ++r) { o[dt][r] = O[0][dt][r] * i0 - O[NQT - 1][dt][r] * i1; ss += o[dt][r] * o[dt][r]; }
    ss += __shfl_xor(ss, 32);
    const float rn = rsqrtf(ss * (1.f / 64.f) + EPS) * (1.f - a.lam_init);
#pragma unroll
    for (int dt = 0; dt < 2; ++dt) {
#pragma unroll
      for (int g = 0; g < 4; ++g) { const f32x4 gg = *(const f32x4*)(a.subln + dt * 32 + 8 * g + 4 * h);
#pragma unroll
        for (int i = 0; i < 4; ++i) o[dt][4 * g + i] *= rn * gg[i]; }
      store_plain(a.mix + (size_t)qtok[0] * 1024 + 256 + hd * 64 + dt * 32, o[dt], h);
    }
  } else {
#pragma unroll
    for (int qt = 0; qt < NQT; ++qt) {
      int head, colb, seg;
      if (MODE == 0) { head = hd; colb = hd * 64; seg = 0; }
      else if (MODE == 2) { head = hd; colb = 512 + head * 64; seg = 1; l[qt] += __builtin_amdgcn_exp2f(a.sinks[head] * LOG2E - cb); }
      else { head = hd; colb = 768 + hd * 64; seg = 2; }
      const float inv = 1.f / l[qt]; float ss = 0.f;
#pragma unroll
      for (int dt = 0; dt < 2; ++dt) { f32x16 o = O[qt][dt] * inv; ss += sumsq16(o); store_plain(a.mix + (size_t)qtok[qt] * 1024 + colb + dt * 32, o, h); }
      ss += __shfl_xor(ss, 32);
      if (h == 0) a.ssm[(size_t)(seg * 4 + head) * S + qtok[qt]] = ss;
    }
  }
}


template <bool B> struct BoolC { static constexpr bool value = B; };
#define SGB(mask, n) __builtin_amdgcn_sched_group_barrier((mask), (n), 0)
template <int MODE>
__device__ __forceinline__ bool attn_pipe(char* lds, const AttnArgs& a, int item) {
  constexpr int KSTR = MODE == 0 ? 208 : 144;
  constexpr int NKS = MODE == 0 ? 6 : 2;
  constexpr int NKP = MODE == 0 ? 3 : 2;
  constexpr int NST = 256;
  constexpr int NQT = MODE == 0 ? 1 : 2;
  int tid_ = threadIdx.x; asm volatile("" : "+v"(tid_));
  const int tid = tid_, lane = tid & 63, wid = tid >> 6, c = lane & 31, h = lane >> 5;
  const int hd = item & 3, qb = item >> 2;
  int qtok[NQT]; const bf16_t* qptr[NQT]; const bf16_t* kbase; const bf16_t* vbase; int k2slot;
  if constexpr (MODE == 0) {
    qtok[0] = qb * 128 + wid * 32 + c; qptr[0] = a.Qa + (size_t)qtok[0] * 384 + hd * 96;
    kbase = a.KN + hd * 64; vbase = a.VtA + (size_t)hd * 64 * VLD; k2slot = hd;
  } else {
#pragma unroll
    for (int qt = 0; qt < 2; ++qt) { qtok[qt] = qb * 128 + wid * 32 + c; qptr[qt] = a.P + (size_t)qtok[qt] * NP + 384 + hd * 64 + qt * 32; }
    kbase = a.P + 640 + hd * 64; vbase = a.Vt + (size_t)hd * 64 * VLD; k2slot = 5 + hd;
  }
  bf16x8 qf[NQT][NKS]; float q2max = 0.f;
#pragma unroll
  for (int qt = 0; qt < NQT; ++qt) { float s = 0.f;
#pragma unroll
    for (int ks = 0; ks < NKS; ++ks) { qf[qt][ks] = *(const bf16x8*)(qptr[qt] + ks * 16 + h * 8);
#pragma unroll
      for (int j = 0; j < 8; ++j) { const float f = bf2f((unsigned short)qf[qt][ks][j]); s += f * f; } }
    s += __shfl_xor(s, 32); q2max = fmaxf(q2max, s); }
#pragma unroll
  for (int o = 16; o; o >>= 1) q2max = fmaxf(q2max, __shfl_xor(q2max, o));
  float k2 = __uint_as_float(a.kmax[k2slot]); if (MODE == 0) k2 += __uint_as_float(a.kmax[4]);
  const float cb = sqrtf(q2max * k2) * 1.01f + 0.01f;
  { volatile int* flag = (volatile int*)(lds + 3 * ABUF);
    if (tid == 0) *flag = 0;
    __syncthreads();
    if (cb > 96.f && lane == 0) *flag = 1;
    __syncthreads();
    if (*flag) return false; }
  f32x16 O[NQT][2]; float l[NQT];
#pragma unroll
  for (int i = 0; i < NQT; ++i) { l[i] = 0.f;
#pragma unroll
    for (int j = 0; j < 2; ++j)
#pragma unroll
      for (int r = 0; r < 16; ++r) O[i][j][r] = 0.f; }

  u32x4 rk[NKP], rv[2];
  auto gload = [&](int st) {
    const int kb = st * 64;
#pragma unroll
    for (int i = 0; i < NKP; ++i) { const int p = tid + 256 * i;
      if (MODE == 0) {
        if (i < 2) { const int row = p >> 3, ch = p & 7; rk[i] = *(const u32x4*)(kbase + (size_t)(kb + row) * 256 + ch * 8); }
        else { const int row = tid >> 2, ch = tid & 3; rk[i] = *(const u32x4*)(a.P + (size_t)(kb + row) * NP + 192 + ch * 8); } }
      else { const int row = p >> 3, ch = p & 7; rk[i] = *(const u32x4*)(kbase + (size_t)(kb + row) * NP + ch * 8); } }
#pragma unroll
    for (int i = 0; i < 2; ++i) { const int p = tid + 256 * i, dv = p >> 3, ch = p & 7; rv[i] = *(const u32x4*)(vbase + (size_t)dv * VLD + kb + ch * 8); }
  };
  auto lstore = [&](int buf) {
    char* b = lds + buf * ABUF;
#pragma unroll
    for (int i = 0; i < NKP; ++i) { const int p = tid + 256 * i;
      if (MODE == 0) { if (i < 2) { const int row = p >> 3, ch = p & 7; *(u32x4*)(b + row * 208 + ch * 16) = rk[i]; } else { const int row = tid >> 2, ch = tid & 3; *(u32x4*)(b + row * 208 + 128 + ch * 16) = rk[i]; } }
      else { const int row = p >> 3, ch = p & 7; *(u32x4*)(b + row * 144 + ch * 16) = rk[i]; } }
#pragma unroll
    for (int i = 0; i < 2; ++i) { const int p = tid + 256 * i, dv = p >> 3, ch = p & 7; *(u32x4*)(b + AKOFF + dv * 144 + ch * 16) = rv[i]; }
  };
  const int koff = c * KSTR + h * 16, voff = AKOFF + c * 144 + h * 16;
#define QK_UNIT(dst, Kb, u) { _Pragma("unroll") for (int r_ = 0; r_ < 16; ++r_) dst[r_] = 0.f; \
    _Pragma("unroll") for (int ks = 0; ks < NKS; ++ks) { \
      const bf16x8 kf = *(const bf16x8*)((Kb) + koff + ((u) / NQT) * 32 * KSTR + (MODE == 1 ? ((u) % NQT) * 64 : 0) + ks * 32); \
      dst = MFMA(kf, qf[(u) % NQT][ks], dst); } }
#define EXP_UNIT(src, u, pf) { float p_[16]; \
    _Pragma("unroll") for (int i = 0; i < 16; ++i) { p_[i] = __builtin_amdgcn_exp2f(src[i]); l[(u) % NQT] += p_[i]; } \
    _Pragma("unroll") for (int s2 = 0; s2 < 2; ++s2) { u32x4 w_; w_.x = pk2(p_[8 * s2], p_[8 * s2 + 1]); w_.y = pk2(p_[8 * s2 + 2], p_[8 * s2 + 3]); \
      w_.z = pk2(p_[8 * s2 + 4], p_[8 * s2 + 5]); w_.w = pk2(p_[8 * s2 + 6], p_[8 * s2 + 7]); pf[s2] = __builtin_bit_cast(bf16x8, w_); } }
#define PV_UNIT(Vb, u, pf) { \
    _Pragma("unroll") for (int dt = 0; dt < 2; ++dt) \
    _Pragma("unroll") for (int s2 = 0; s2 < 2; ++s2) { \
      const bf16x8 vf = *(const bf16x8*)((Vb) + voff + dt * 32 * 144 + ((u) / NQT) * 64 + s2 * 32); \
      O[(u) % NQT][dt] = MFMA(vf, pf[s2], O[(u) % NQT][dt]); } }
#define SCHED_ITER(NM) { SGB(0x100, 2); \
    _Pragma("unroll") for (int i_ = 0; i_ < (NM); ++i_) { SGB(0x008, 1); SGB(0x002, (40 + (NM) - 1) / (NM)); if (i_ + 2 < (NM)) SGB(0x100, 1); } }

  gload(0); lstore(0); gload(1); lstore(1); __syncthreads();
  f32x16 sc, sn;
  QK_UNIT(sc, lds, 0);
  int cur = 0;
  for (int st = 0; st < NST; ++st) {
    const int nxt = cur == 2 ? 0 : cur + 1, wr = nxt == 2 ? 0 : nxt + 1;
    if (st + 2 < NST) gload(st + 2);
    const char* Kc = lds + cur * ABUF; const char* Kn = lds + nxt * ABUF;
    bf16x8 pa[2], pb[2];
    __builtin_amdgcn_sched_barrier(0);
    if constexpr (NQT == 2) {
      QK_UNIT(sn, Kc, 1); EXP_UNIT(sc, 0, pa); SCHED_ITER(NKS); sc = sn;
      __builtin_amdgcn_sched_barrier(0);
      QK_UNIT(sn, Kc, 2); EXP_UNIT(sc, 1, pb); PV_UNIT(Kc, 0, pa); SCHED_ITER(NKS + 4); sc = sn;
      __builtin_amdgcn_sched_barrier(0);
      QK_UNIT(sn, Kc, 3); EXP_UNIT(sc, 2, pa); PV_UNIT(Kc, 1, pb); SCHED_ITER(NKS + 4); sc = sn;
      __builtin_amdgcn_sched_barrier(0);
      QK_UNIT(sn, Kn, 0); EXP_UNIT(sc, 3, pb); PV_UNIT(Kc, 2, pa); SCHED_ITER(NKS + 4); sc = sn;
      __builtin_amdgcn_sched_barrier(0);
      PV_UNIT(Kc, 3, pb);
    } else {
      QK_UNIT(sn, Kc, 1); EXP_UNIT(sc, 0, pa); SCHED_ITER(NKS); sc = sn;
      __builtin_amdgcn_sched_barrier(0);
      QK_UNIT(sn, Kn, 0); EXP_UNIT(sc, 1, pb); PV_UNIT(Kc, 0, pa); SCHED_ITER(NKS + 4); sc = sn;
      __builtin_amdgcn_sched_barrier(0);
      PV_UNIT(Kc, 1, pb);
    }
    __builtin_amdgcn_sched_barrier(0);
    if (st + 2 < NST) lstore(wr);
    __syncthreads();
    cur = nxt;
  }
#undef QK_UNIT
#undef EXP_UNIT
#undef PV_UNIT
#undef SCHED_ITER

#pragma unroll
  for (int qt = 0; qt < NQT; ++qt) l[qt] += __shfl_xor(l[qt], 32);
  if constexpr (MODE == 1) {
    float pa = 0.f, pb = 0.f;
    if (lane < 32) { pa = a.lq1[lane] * a.lk1[lane]; pb = a.lq2[lane] * a.lk2[lane]; }
#pragma unroll
    for (int o = 32; o; o >>= 1) { pa += __shfl_xor(pa, o); pb += __shfl_xor(pb, o); }
    const float lam = expf(pa) - expf(pb) + a.lam_init;
    const float i0 = 1.f / l[0], i1 = lam / l[1];
    f32x16 o[2]; float ss = 0.f;
#pragma unroll
    for (int dt = 0; dt < 2; ++dt)
#pragma unroll
      for (int r = 0; r < 16; ++r) { o[dt][r] = O[0][dt][r] * i0 - O[1][dt][r] * i1; ss += o[dt][r] * o[dt][r]; }
    ss += __shfl_xor(ss, 32);
    const float rn = rsqrtf(ss * (1.f / 64.f) + EPS) * (1.f - a.lam_init);
#pragma unroll
    for (int dt = 0; dt < 2; ++dt) {
#pragma unroll
      for (int g = 0; g < 4; ++g) { const f32x4 gg = *(const f32x4*)(a.subln + dt * 32 + 8 * g + 4 * h);
#pragma unroll
        for (int i = 0; i < 4; ++i) o[dt][4 * g + i] *= rn * gg[i]; }
      store_plain(a.mix + (size_t)qtok[0] * 1024 + 256 + hd * 64 + dt * 32, o[dt], h);
    }
  } else {
#pragma unroll
    for (int qt = 0; qt < NQT; ++qt) {
      const float inv = 1.f / l[qt]; float ss = 0.f;
#pragma unroll
      for (int dt = 0; dt < 2; ++dt) { f32x16 o = O[qt][dt] * inv; ss += sumsq16(o); store_plain(a.mix + (size_t)qtok[qt] * 1024 + hd * 64 + dt * 32, o, h); }
      ss += __shfl_xor(ss, 32);
      if (h == 0) a.ssm[(size_t)hd * S + qtok[qt]] = ss;
    }
  }
  return true;
}

template <class F>
__device__ __forceinline__ void conv_tile(float* tl, bf16_t* out, int K, int n0, int k0, const F& f) {
  int tid_ = threadIdx.x; asm volatile("" : "+v"(tid_));
  const int tid = tid_, tx = tid & 63, ty = tid >> 6;
#pragma unroll 4
  for (int i = 0; i < 16; ++i) { const int k = ty + 4 * i; tl[k * 65 + tx] = f(k0 + k, n0 + tx); }
  __syncthreads();
  const int kx2 = (tid & 31) * 2, ny = tid >> 5;
#pragma unroll 4
  for (int i = 0; i < 8; ++i) { const int n = ny + 8 * i; *(unsigned*)(out + (size_t)(n0 + n) * K + k0 + kx2) = pk2(tl[kx2 * 65 + n], tl[(kx2 + 1) * 65 + n]); }
  __syncthreads();
}

__device__ void conv_layer(char* lds, const Params& p, int l) {
  float* tl = (float*)lds; char* ws = p.ws;
  const float* w_in = p.w_in + (size_t)l * 1024 * 2400; const float* g1 = p.norm1_g + l * 1024;
  const float* w_out = p.w_out + (size_t)l * 1024 * 1024; const float* gm = p.g_mla + l * 256; const float* gs = p.g_swa + l * 256; const float* gn = p.g_na + l * 256;
  const float* w_up = p.w_up + (size_t)l * 1024 * 4096; const float* g2 = p.norm2_g + l * 1024;
  const float* w_dn = p.w_down + (size_t)l * 4096 * 1024;
  const float* w_uq = p.w_uq + (size_t)l * 192 * 384; const float* qg = p.qn_g + l * 192;
  const float* w_uk = p.w_uk + (size_t)l * 128 * 256; const float* w_uv = p.w_uv + (size_t)l * 128 * 256; const float* kg = p.kvn_g + l * 128;
  const float sB = 0.17677669529663687f * LOG2E, sC = 0.125f * LOG2E, sA = 0.10206207261596577f * LOG2E;
  for (int t = bid_(); t < 2946; t += gridDim.x) {
    if (t < 608) { const int nt = t >> 4, kt = t & 15;
      conv_tile(tl, (bf16_t*)(ws + OFF_WIN), 1024, nt * 64, kt * 64, [&](int k, int n) -> float {
        int src; if (n < 192) src = n; else if (n < 224) src = 320 + n - 192; else if (n < 256) src = -1; else if (n < 384) src = 192 + n - 256; else src = 352 + n - 384;
        if (src < 0) return 0.f;
        float sc = 1.f; if (n >= 384 && n < 640) sc = sB; else if ((n >= 1152 && n < 1408) || (n >= 1664 && n < 1920)) sc = sC;
        return w_in[(size_t)k * 2400 + src] * g1[k] * sc; });
    } else if (t < 864) { const int u = t - 608, nt = u >> 4, kt = u & 15;
      conv_tile(tl, (bf16_t*)(ws + OFF_WOUT), 1024, nt * 64, kt * 64, [&](int k, int n) -> float {
        const float g = k < 256 ? gm[k] : (k < 512 ? 1.f : (k < 768 ? gs[k - 512] : gn[k - 768]));
        return w_out[(size_t)k * 1024 + n] * g; });
    } else if (t < 1888) { const int u = t - 864, nt = u >> 4, kt = u & 15;
      conv_tile(tl, (bf16_t*)(ws + OFF_WUP), 1024, nt * 64, kt * 64, [&](int k, int n) -> float { return w_up[(size_t)k * 4096 + n] * g2[k]; });
    } else if (t < 2912) { const int u = t - 1888, nt = u >> 6, kt = u & 63;
      conv_tile(tl, (bf16_t*)(ws + OFF_WDN), 4096, nt * 64, kt * 64, [&](int k, int n) -> float { return w_dn[(size_t)k * 1024 + n]; });
    } else if (t < 2930) { const int u = t - 2912, nt = u / 3, kt = u % 3;
      conv_tile(tl, (bf16_t*)(ws + OFF_WUQ), 192, nt * 64, kt * 64, [&](int k, int n) -> float { return w_uq[(size_t)k * 384 + n] * qg[k] * sA; });
    } else { const int u = t - 2930, nt = u >> 1, kt = u & 1;
      conv_tile(tl, (bf16_t*)(ws + OFF_WKV), 128, nt * 64, kt * 64, [&](int k, int n) -> float {
        return (n < 256 ? w_uk[(size_t)k * 256 + n] : w_uv[(size_t)k * 256 + n - 256]) * kg[k]; });
    }
  }
}

__device__ __forceinline__ void gbar(unsigned* base) {
  __syncthreads();
  if (threadIdx.x == 0) {
    __builtin_amdgcn_fence(__ATOMIC_RELEASE, "agent");
    const unsigned g = blockIdx.x & 15u, ng = gridDim.x >> 4;
    unsigned* cnt = base + g * 32; unsigned* root = base + 16 * 32; unsigned* gen = base + (17 + g) * 32;
    const unsigned old = __hip_atomic_load(gen, __ATOMIC_RELAXED, __HIP_MEMORY_SCOPE_AGENT);
    if (__hip_atomic_fetch_add(cnt, 1u, __ATOMIC_RELAXED, __HIP_MEMORY_SCOPE_AGENT) == ng - 1u) {
      __hip_atomic_store(cnt, 0u, __ATOMIC_RELAXED, __HIP_MEMORY_SCOPE_AGENT);
      __builtin_amdgcn_fence(__ATOMIC_RELEASE, "agent");
      if (__hip_atomic_fetch_add(root, 1u, __ATOMIC_RELAXED, __HIP_MEMORY_SCOPE_AGENT) == 15u) {
        __hip_atomic_store(root, 0u, __ATOMIC_RELAXED, __HIP_MEMORY_SCOPE_AGENT);
        __builtin_amdgcn_fence(__ATOMIC_RELEASE, "agent");
        for (unsigned k = 0; k < 16; ++k) __hip_atomic_fetch_add(base + (17 + k) * 32, 1u, __ATOMIC_RELAXED, __HIP_MEMORY_SCOPE_AGENT);
      }
    }
    while (__hip_atomic_load(gen, __ATOMIC_RELAXED, __HIP_MEMORY_SCOPE_AGENT) == old) __builtin_amdgcn_s_sleep(2);
    __builtin_amdgcn_fence(__ATOMIC_ACQUIRE, "agent");
  }
  __syncthreads();
}

__device__ __forceinline__ void sincos_acc(float ang, float& sn, float& cs) {
  const double a = (double)ang; const double n = rint(a * 0.15915494309189535);
  const double r = a - n * 6.283185307179586476925; const double r2 = r * r;
  double s = -1.0 / 51090942171709440000.0;
  s = s * r2 + 1.0 / 121645100408832000.0; s = s * r2 - 1.0 / 355687428096000.0; s = s * r2 + 1.0 / 1307674368000.0; s = s * r2 - 1.0 / 6227020800.0;
  s = s * r2 + 1.0 / 39916800.0; s = s * r2 - 1.0 / 362880.0; s = s * r2 + 1.0 / 5040.0; s = s * r2 - 1.0 / 120.0; s = s * r2 + 1.0 / 6.0; s = s * r2 - 1.0; s = -s * r;
  double c = 1.0 / 1124000727777607680000.0;
  c = c * r2 - 1.0 / 2432902008176640000.0; c = c * r2 + 1.0 / 6402373705728000.0; c = c * r2 - 1.0 / 20922789888000.0; c = c * r2 + 1.0 / 87178291200.0;
  c = c * r2 - 1.0 / 479001600.0; c = c * r2 + 1.0 / 3628800.0; c = c * r2 - 1.0 / 40320.0; c = c * r2 + 1.0 / 720.0; c = c * r2 - 1.0 / 24.0; c = c * r2 + 0.5; c = 1.0 - c * r2;
  sn = (float)s; cs = (float)c;
}

__global__ void __launch_bounds__(256, 2) mega(Params p) {
  cg::grid_group grid = cg::this_grid();
  __shared__ __attribute__((aligned(16))) char lds[73728];
  __shared__ int s_item; __shared__ int s_q[2];
#ifdef PROBE_SEL
  __shared__ unsigned long long s_t[10];
  if (threadIdx.x == 0) { for (int i = 0; i < 9; ++i) s_t[i] = 0; s_t[9] = __builtin_amdgcn_s_memrealtime(); }
#define TSTAMP(k) { if (blockIdx.x == 0 && threadIdx.x == 0) { const unsigned long long t_ = __builtin_amdgcn_s_memrealtime(); s_t[k] += t_ - s_t[9]; s_t[9] = t_; } }
#else
#define TSTAMP(k)
#endif
#define GBAR { size_t wz2_ = 0; asm volatile("" : "+s"(wz2_)); gbar((unsigned*)(p.ws + OFF_CTRL + wz2_) + 1024); }
#define WSPTRS \
  size_t wz_ = 0; asm volatile("" : "+s"(wz_)); char* ws = p.ws + wz_; \
  bf16_t* XB = (bf16_t*)(ws + OFF_XB); bf16_t* MIX = (bf16_t*)(ws + OFF_MIX); bf16_t* P = (bf16_t*)(ws + OFF_P); bf16_t* VT = (bf16_t*)(ws + OFF_VT); \
  bf16_t* QA = (bf16_t*)(ws + OFF_QA); bf16_t* KN = (bf16_t*)(ws + OFF_KN); bf16_t* VTA = (bf16_t*)(ws + OFF_VTA); bf16_t* H = (bf16_t*)(ws + OFF_H); \
  float* C32 = (float*)(ws + OFF_TAB); float* S32 = C32 + S * 16; float* C64 = S32 + S * 16; float* S64 = C64 + S * 32; \
  float* SSX = (float*)(ws + OFF_SSX); float* SSA = (float*)(ws + OFF_SSA); float* SSM = (float*)(ws + OFF_SSM); \
  unsigned* CTRL = (unsigned*)(ws + OFF_CTRL); unsigned* kmax = CTRL + 16 + 16 * l; \
  (void)XB; (void)MIX; (void)P; (void)VT; (void)QA; (void)KN; (void)VTA; (void)H; (void)C32; (void)S32; (void)C64; (void)S64; (void)SSX; (void)SSA; (void)SSM; (void)CTRL; (void)kmax;

  { const int l = 0; WSPTRS
  int tid_ = threadIdx.x; asm volatile("" : "+v"(tid_));
  const int tid = tid_, lane = tid & 63, wid = tid >> 6, gw = bid_() * 4 + wid, nw = gridDim.x * 4;
  if (blockIdx.x == 0) { for (int i = tid; i < 4096; i += 256) CTRL[i] = 0u; }
  for (int row = gw; row < S; row += nw) {
    const f32x4* xr = (const f32x4*)(p.x + (size_t)row * 1024); float s = 0.f;
#pragma unroll
    for (int i = 0; i < 4; ++i) { const f32x4 v = xr[lane + 64 * i]; s += v[0] * v[0] + v[1] * v[1] + v[2] * v[2] + v[3] * v[3];
      u32x2 w; w.x = pk2(v[0], v[1]); w.y = pk2(v[2], v[3]); *(u32x2*)(XB + (size_t)row * 1024 + (lane + 64 * i) * 4) = w; }
#pragma unroll
    for (int o = 32; o; o >>= 1) s += __shfl_xor(s, o);
    if (lane < 16) SSX[(size_t)row * 16 + lane] = lane == 0 ? s : 0.f;
  }
  for (int idx = bid_() * 256 + tid; idx < S * 48; idx += gridDim.x * 256) {
    const int pos = idx / 48, i = idx - pos * 48; float sn, cs;
    if (i < 16) { const float inv = 1.0f / powf(10000.f, (float)(2 * i) / 32.f); sincos_acc((float)pos * inv, sn, cs); C32[pos * 16 + i] = cs; S32[pos * 16 + i] = sn; }
    else { const int j = i - 16; const float inv = 1.0f / powf(10000.f, (float)(2 * j) / 64.f); sincos_acc((float)pos * inv, sn, cs); C64[pos * 32 + j] = cs; S64[pos * 32 + j] = sn; }
  }
  }

#pragma unroll 1
  for (int l = 0; l < 4; ++l) {
    conv_layer(lds, p, l);
    if (l == 0) grid.sync(); else GBAR;
    TSTAMP(0)
    { WSPTRS GemmArgs g{XB, 1024, (const bf16_t*)(ws + OFF_WIN), 1024, 1024, nullptr};
      EpiIn e{P, VT, SSX, SSA, C32, S32, C64, S64, kmax};
      bool st_ = false;
      for (int t = bid_(); t < 128 * 19; t += gridDim.x) { const int u = remap8(t, 128 * 19); const int tn = t + (int)gridDim.x; const bool hn = tn < 128 * 19; const int un = hn ? remap8(tn, 128 * 19) : 0;
        gemm_tile<false>(lds, g, (u / 19) * 128, (u % 19) * 128, e, st_, hn ? (un / 19) * 128 : -1, (un % 19) * 128); st_ = hn; } }
    GBAR; TSTAMP(1)
    { WSPTRS GemmArgs gq{P, NP, (const bf16_t*)(ws + OFF_WUQ), 192, 192, nullptr}; EpiUq eq{QA, SSA, C32, S32};
      GemmArgs gk{P + 256, NP, (const bf16_t*)(ws + OFF_WKV), 128, 128, nullptr}; EpiKv ek{KN, VTA, SSA, kmax};
      for (int t = bid_(); t < 896; t += gridDim.x) { const int u = remap8(t, 896);
        if (u < 384) gemm_tile<false>(lds, gq, (u / 3) * 128, (u % 3) * 128, eq);
        else { const int v = u - 384; gemm_tile<false>(lds, gk, (v >> 2) * 128, (v & 3) * 128, ek); } } }
    GBAR; TSTAMP(2)
    { WSPTRS AttnArgs a{P, VT, QA, KN, VTA, MIX, SSM, kmax, p.lq1 + l * 32, p.lk1 + l * 32, p.lq2 + l * 32, p.lk2 + l * 32, p.subln_g + l * 64, p.sinks + l * 4,
                 p.rpb + l * 4 * 465, p.lam_init[l]};
      unsigned* ctr = CTRL + 128 + 32 * l;
      if (threadIdx.x == 0) { int z_ = 0; asm volatile("" : "+v"(z_)); s_q[0] = z_; s_q[1] = z_; }
      for (;;) {
        if (threadIdx.x == 0) {
          const int xcc = (int)(__builtin_amdgcn_s_getreg((3 << 11) | 20) & 7u);
          const int pq_ = s_q[0]; int pass = pq_ >> 3, dq = pq_ & 7;
          int it = -1;
          if (((blockIdx.x >> 8) & 1u) && s_q[1] < 2) { const int idx = (int)atomicAdd(ctr + 16, 1u); if (idx < 1024) { it = 2048 + idx; s_q[1] = s_q[1] + 1; } else s_q[1] = 2; }
          if (it < 0)
          while (pass < 2) {
            const int ep = pass ^ (int)((blockIdx.x >> 8) & 1u);
            const int q = (xcc + dq) & 7; const int idx = (int)atomicAdd(ctr + ep * 8 + q, 1u);
            if (idx < 64) { it = ep * 1024 + (((((q >> 2) * 64 + idx) << 2)) | (q & 3)); break; }
            if (++dq == 8) { dq = 0; ++pass; }
          }
          if (it < 0) { const int idx = (int)atomicAdd(ctr + 16, 1u); it = idx < 1024 ? 2048 + idx : -1; }
          s_item = it; s_q[0] = pass * 8 + dq;
        }
        __syncthreads(); const int item = s_item; __syncthreads();
        if (item < 0) break;
        if (item < 1024) { if (!attn_pipe<1>(lds, a, item)) attn_item<1>(lds, a, item); }
        else if (item < 2048) { if (!attn_pipe<0>(lds, a, item - 1024)) attn_item<0>(lds, a, item - 1024); }
        else if (item < 2560) attn_item<2>(lds, a, item - 2048);
        else attn_item<3>(lds, a, item - 2560);
      } }
    TSTAMP(7)
    GBAR; TSTAMP(3)
    { WSPTRS GemmArgs g{MIX, 1024, (const bf16_t*)(ws + OFF_WOUT), 1024, 1024, SSM};
      EpiRes e{XB, SSX};
      bool st_ = false;
      for (int t = bid_(); t < 1024; t += gridDim.x) { const int u = remap8(t, 1024); const int tn = t + (int)gridDim.x; const bool hn = tn < 1024; const int un = hn ? remap8(tn, 1024) : 0;
        gemm_tile<true>(lds, g, (u >> 3) * 128, (u & 7) * 128, e, st_, hn ? (un >> 3) * 128 : -1, (un & 7) * 128); st_ = hn; } }
    GBAR; TSTAMP(4)
    { WSPTRS GemmArgs g{XB, 1024, (const bf16_t*)(ws + OFF_WUP), 1024, 1024, nullptr}; EpiUp e{H, SSX};
      bool st_ = false;
      for (int t = bid_(); t < 4096; t += gridDim.x) { const int u = remap8(t, 4096); const int tn = t + (int)gridDim.x; const bool hn = tn < 4096; const int un = hn ? remap8(tn, 4096) : 0;
        gemm_tile<false>(lds, g, (u >> 5) * 128, (u & 31) * 128, e, st_, hn ? (un >> 5) * 128 : -1, (un & 31) * 128); st_ = hn; } }
    GBAR; TSTAMP(5)
    { WSPTRS GemmArgs g{H, 4096, (const bf16_t*)(ws + OFF_WDN), 4096, 4096, nullptr}; EpiRes e{XB, SSX};
      bool st_ = false;
      for (int t = bid_(); t < 1024; t += gridDim.x) { const int u = remap8(t, 1024); const int tn = t + (int)gridDim.x; const bool hn = tn < 1024; const int un = hn ? remap8(tn, 1024) : 0;
        gemm_tile<false>(lds, g, (u >> 3) * 128, (u & 7) * 128, e, st_, hn ? (un >> 3) * 128 : -1, (un & 7) * 128); st_ = hn; } }
    GBAR; TSTAMP(6)
  }
  const int l = 0; WSPTRS
  int tid_ = threadIdx.x; asm volatile("" : "+v"(tid_));
  const int lane = tid_ & 63, gw = bid_() * 4 + (tid_ >> 6), nw = gridDim.x * 4;
  for (int row = gw; row < S; row += nw) {
    const float rr = rowscale_ssx(SSX, row);
    const u32x2* xr = (const u32x2*)(XB + (size_t)row * 1024); f32x4* orow = (f32x4*)(p.out + (size_t)row * 1024);
#pragma unroll
    for (int i = 0; i < 4; ++i) { const u32x2 w = xr[lane + 64 * i]; const f32x4 g = ((const f32x4*)p.fin_g)[lane + 64 * i]; f32x4 v;
      v[0] = bf2f(w.x & 0xffffu); v[1] = __uint_as_float(w.x & 0xffff0000u); v[2] = bf2f(w.y & 0xffffu); v[3] = __uint_as_float(w.y & 0xffff0000u);
      orow[lane + 64 * i] = v * rr * g; }
  }
#ifdef PROBE_SEL
  { const int l = 0; WSPTRS
    if (blockIdx.x == 0 && threadIdx.x == 0) {
      unsigned long long tot = 0, sel = 0;
      for (int i = 0; i < 9; ++i) { tot += s_t[i]; if ((PROBE_SEL >> i) & 1) sel += s_t[i]; }
      ((float*)CTRL)[500] = (float)((double)sel / (double)tot);
    }
    grid.sync();
    const float fr = ((const float*)CTRL)[500];
    for (int row = gw; row < 64; row += nw) {
      f32x4* xr = (f32x4*)(p.out + (size_t)row * 1024);
      for (int i = 0; i < 4; ++i) { f32x4 v = xr[lane + 64 * i]; const float d = 0.05f * fr; v[0] += d; v[1] -= d; v[2] += d; v[3] -= d; xr[lane + 64 * i] = v; }
    }
  }
#endif
}

extern "C" void kernel_launch(void* const* d_in, const int* in_sizes, int n_in, void* d_out, int out_size,
                              void* d_ws, size_t ws_size, hipStream_t stream) {
  static int grid_blocks = 0;
  if (!grid_blocks) {
    int dev = 0, cus = 0, per_cu = 0;
    (void)hipGetDevice(&dev);
    (void)hipDeviceGetAttribute(&cus, hipDeviceAttributeMultiprocessorCount, dev);
    (void)hipOccupancyMaxActiveBlocksPerMultiprocessor(&per_cu, mega, 256, 0);
    per_cu = 2;
    grid_blocks = cus * per_cu;
  }
  Params p{};
  const float** pp = (const float**)&p;
  for (int i = 0; i < 23; ++i) pp[i] = (const float*)d_in[i];
  p.out = (float*)d_out; p.ws = (char*)d_ws;
  for (int l = 0; l < 4; ++l) p.lam_init[l] = (float)(0.8 - 0.6 * exp(-0.3 * (double)l));
  void* args[] = {&p};
  hipError_t e = hipLaunchCooperativeKernel((void*)mega, dim3(grid_blocks), dim3(256), args, 0, stream);
  if (e != hipSuccess) fprintf(stderr, "cooperative launch failed: %s (grid %d)\n", hipGetErrorString(e), grid_blocks);
}
```

```cpp
#include <hip/hip_runtime.h>
#include <hip/hip_cooperative_groups.h>
#include <cstdio>
#include <cmath>
namespace cg = cooperative_groups;

typedef unsigned short bf16_t;
typedef short bf16x8 __attribute__((ext_vector_type(8)));
typedef float f32x16 __attribute__((ext_vector_type(16)));
typedef float f32x4 __attribute__((ext_vector_type(4)));
typedef float f32x2 __attribute__((ext_vector_type(2)));
typedef unsigned u32x2 __attribute__((ext_vector_type(2)));
typedef unsigned u32x4 __attribute__((ext_vector_type(4)));
typedef __bf16 bf2_t __attribute__((ext_vector_type(2)));

constexpr int S = 16384, NP = 2432, VLD = S + 128;
constexpr float EPS = 1e-6f, LOG2E = 1.4426950408889634f;

constexpr size_t OFF_WIN = 0;
constexpr size_t OFF_WOUT = OFF_WIN + (size_t)NP * 1024 * 2;
constexpr size_t OFF_WUP = OFF_WOUT + (size_t)1024 * 1024 * 2;
constexpr size_t OFF_WDN = OFF_WUP + (size_t)4096 * 1024 * 2;
constexpr size_t OFF_WUQ = OFF_WDN + (size_t)4096 * 1024 * 2;
constexpr size_t OFF_WKV = OFF_WUQ + (size_t)384 * 192 * 2;
constexpr size_t OFF_XB = OFF_WKV + (size_t)512 * 128 * 2;
constexpr size_t OFF_MIX = OFF_XB + (size_t)S * 1024 * 2;
constexpr size_t OFF_R1 = OFF_MIX + (size_t)S * 1024 * 2;
constexpr size_t OFF_P = OFF_R1;
constexpr size_t OFF_VT = OFF_P + (size_t)S * NP * 2;
constexpr size_t OFF_QA = OFF_VT + (size_t)640 * VLD * 2;
constexpr size_t OFF_KN = OFF_QA + (size_t)S * 384 * 2;
constexpr size_t OFF_VTA = OFF_KN + (size_t)S * 256 * 2;
constexpr size_t OFF_H = OFF_R1;
constexpr size_t OFF_TAB = OFF_R1 + (size_t)S * 4096 * 2;
constexpr size_t OFF_SSX = OFF_TAB + (size_t)S * 96 * 4;
constexpr size_t OFF_SSA = OFF_SSX + (size_t)S * 16 * 4;
constexpr size_t OFF_SSM = OFF_SSA + (size_t)S * 8 * 4;
constexpr size_t OFF_CTRL = OFF_SSM + (size_t)12 * S * 4;
static_assert(OFF_VTA + (size_t)256 * VLD * 2 <= OFF_TAB, "overlay");

struct Params {
  const float *x, *norm1_g, *w_in, *qn_g, *w_uq, *kvn_g, *w_uk, *w_uv, *lq1, *lk1, *lq2, *lk2, *subln_g, *sinks, *rpb,
      *g_mla, *g_swa, *g_na, *w_out, *norm2_g, *w_up, *w_down, *fin_g;
  float* out; char* ws; float lam_init[4];
};

__device__ __forceinline__ unsigned pk2(float a, float b) { bf2_t r = __builtin_convertvector((f32x2){a, b}, bf2_t); return __builtin_bit_cast(unsigned, r); }
__device__ __forceinline__ bf16_t f2bf(float a) { return (bf16_t)(pk2(a, 0.f) & 0xffffu); }
__device__ __forceinline__ float bf2f(unsigned v) { return __uint_as_float(v << 16); }
__device__ __forceinline__ int crow(int r, int h) { return (r & 3) + 8 * (r >> 2) + 4 * h; }
__device__ __forceinline__ int permtok(int t) { return (t & ~12) | ((t & 4) << 1) | ((t & 8) >> 1); }
__device__ __forceinline__ int remap8(int t, int T) { return (t & 7) * (T >> 3) + (t >> 3); }
__device__ __forceinline__ int bid_() { int b = blockIdx.x; asm volatile("" : "+s"(b)); return b; }
#define MFMA(a, b, c) __builtin_amdgcn_mfma_f32_32x32x16_bf16((a), (b), (c), 0, 0, 0)

struct GemmArgs { const bf16_t* A; int lda; const bf16_t* Bt; int ldb; int K; const float* asc; };

#define LAS3 __attribute__((address_space(3)))
template <int V> struct IntC { static constexpr int value = V; };
__device__ __forceinline__ float seg_rscale(const float* asc, int seg, int tok) {
  if (seg == 1) return 1.f;
  const int idx = seg == 0 ? 0 : (seg == 2 ? 1 : 2);
  const float* sp = asc + (size_t)idx * 4 * S + tok;
  return rsqrtf((sp[0] + sp[S] + sp[2 * S] + sp[3 * S]) * (1.f / 256.f) + EPS);
}
template <bool ASC, class Epi>
__device__ __forceinline__ void gemm_tile(char* lds, const GemmArgs& g, int m0, int n0, const Epi& epi, bool staged = false, int nm0 = -1, int nn0 = 0) {
  int tid_ = threadIdx.x; asm volatile("" : "+v"(tid_));
  const int tid = tid_, lane = tid & 63, wid = __builtin_amdgcn_readfirstlane(tid >> 6), wr = wid >> 1, wc = wid & 1, c = lane & 31, h = lane >> 5;
  f32x16 acc[2][2];
#pragma unroll
  for (int i = 0; i < 2; ++i)
#pragma unroll
    for (int j = 0; j < 2; ++j)
#pragma unroll
      for (int r = 0; r < 16; ++r) acc[i][j][r] = 0.f;
  const int prow = tid >> 3, gch = (tid & 7) ^ ((prow >> 1) & 7);
  const bf16_t* Ap; Ap = g.A + (size_t)(m0 + prow) * g.lda + gch * 8;
  const bf16_t* Bp; Bp = g.Bt + (size_t)(n0 + prow) * g.ldb + gch * 8;
  (void)0;
  const size_t astep = (size_t)32 * g.lda, bstep = (size_t)32 * g.ldb;
  LAS3 char* l3 = (LAS3 char*)lds;
  const int nk = g.K >> 6;
  auto stage = [&](int kt, auto BUFC) {
    constexpr int buf = decltype(BUFC)::value;
#pragma unroll
    for (int i = 0; i < 4; ++i) {
      __builtin_amdgcn_global_load_lds((const unsigned*)(Ap + i * astep + kt * 64), (LAS3 unsigned*)(l3 + buf * 32768 + (256 * i + 64 * wid) * 16), 16, 0, 0);
      __builtin_amdgcn_global_load_lds((const unsigned*)(Bp + i * bstep + kt * 64), (LAS3 unsigned*)(l3 + buf * 32768 + 16384 + (256 * i + 64 * wid) * 16), 16, 0, 0);
    }
  };
  const int swz = (c >> 1) & 7;
  const unsigned lbase = (unsigned)(size_t)l3;
  const unsigned aoff = (wr * 64 + c) * 128, boff = 16384 + (wc * 64 + c) * 128;
  unsigned kofs[4];
#pragma unroll
  for (int ks = 0; ks < 4; ++ks) kofs[ks] = ((2 * ks + h) ^ swz) << 4;
  float rcur[2] = {1.f, 1.f};
  if (ASC) { rcur[0] = seg_rscale(g.asc, 0, m0 + wr * 64 + c); rcur[1] = seg_rscale(g.asc, 0, m0 + wr * 64 + 32 + c); }
  if (!staged) stage(0, IntC<0>{});
  asm volatile("s_waitcnt vmcnt(0)" ::: "memory"); __syncthreads();
  auto body = [&](int kt, auto BUFC) {
    constexpr int buf = decltype(BUFC)::value;
    if (kt + 1 < nk) stage(kt + 1, IntC<1 - buf>{});
    if (ASC) { if (kt > 0 && (kt & 3) == 0) {
#pragma unroll
      for (int mt = 0; mt < 2; ++mt) { const float rn = seg_rscale(g.asc, kt >> 2, m0 + wr * 64 + mt * 32 + c); const float f = rcur[mt] / rn; rcur[mt] = rn;
        acc[mt][0] = acc[mt][0] * f; acc[mt][1] = acc[mt][1] * f; } } }
    bf16x8 fr[2][4];
#define GRD(set, ks) { const unsigned aa_ = lbase + buf * 32768 + aoff + kofs[ks], bb_ = lbase + buf * 32768 + boff + kofs[ks]; \
      asm volatile("ds_read_b128 %0, %1" : "=v"(fr[set][0]) : "v"(aa_)); asm volatile("ds_read_b128 %0, %1 offset:4096" : "=v"(fr[set][1]) : "v"(aa_)); \
      asm volatile("ds_read_b128 %0, %1" : "=v"(fr[set][2]) : "v"(bb_)); asm volatile("ds_read_b128 %0, %1 offset:4096" : "=v"(fr[set][3]) : "v"(bb_)); }
    GRD(0, 0);
#pragma unroll
    for (int ks = 0; ks < 4; ++ks) {
      if (ks < 3) { GRD((ks + 1) & 1, ks + 1); asm volatile("s_waitcnt lgkmcnt(4)" : "+v"(fr[ks & 1][0]), "+v"(fr[ks & 1][1]), "+v"(fr[ks & 1][2]), "+v"(fr[ks & 1][3])); }
      else asm volatile("s_waitcnt lgkmcnt(0)" : "+v"(fr[ks & 1][0]), "+v"(fr[ks & 1][1]), "+v"(fr[ks & 1][2]), "+v"(fr[ks & 1][3]));
      __builtin_amdgcn_s_setprio(1);
#pragma unroll
      for (int mt = 0; mt < 2; ++mt)
#pragma unroll
        for (int nt = 0; nt < 2; ++nt) acc[mt][nt] = MFMA(fr[ks & 1][2 + nt], fr[ks & 1][mt], acc[mt][nt]);
      __builtin_amdgcn_s_setprio(0);
    }
#undef GRD
    asm volatile("s_waitcnt vmcnt(0)" ::: "memory"); __builtin_amdgcn_s_barrier(); asm volatile("" ::: "memory");
  };
  for (int kt = 0; kt < nk; kt += 2) { body(kt, IntC<0>{}); if (kt + 1 < nk) body(kt + 1, IntC<1>{}); }
  if constexpr (Epi::kLds) {
    if (ASC) {
#pragma unroll
      for (int mt = 0; mt < 2; ++mt) { acc[mt][0] = acc[mt][0] * rcur[mt]; acc[mt][1] = acc[mt][1] * rcur[mt]; } }
    epi(acc, m0, n0, wr, wc, c, h, lds);
    if (nm0 >= 0) { Ap = g.A + (size_t)(nm0 + prow) * g.lda + gch * 8; Bp = g.Bt + (size_t)(nn0 + prow) * g.ldb + gch * 8; stage(0, IntC<0>{}); }
  } else {
  if (nm0 >= 0) {
    Ap = g.A + (size_t)(nm0 + prow) * g.lda + gch * 8; Bp = g.Bt + (size_t)(nn0 + prow) * g.ldb + gch * 8;
    stage(0, IntC<0>{});
  }
  if (ASC) {
#pragma unroll
    for (int mt = 0; mt < 2; ++mt) { acc[mt][0] = acc[mt][0] * rcur[mt]; acc[mt][1] = acc[mt][1] * rcur[mt]; } }
  epi(acc, m0, n0, wr, wc, c, h);
  }
}

__device__ __forceinline__ void tile_rc256(int t, int NT, int& m0, int& n0) {
  const int x = t & 7, j = t >> 3;
  m0 = (x * 8 + (j & 7)) * 256; n0 = (j >> 3) * 128; (void)NT;
}
template <bool ASC, class Epi>
__device__ __forceinline__ void gemm_stream(char* lds, const GemmArgs& g, int NT, int ntiles, const Epi& epi) {
  int tid_ = threadIdx.x; asm volatile("" : "+v"(tid_));
  const int tid = tid_, lane = tid & 63, wid = __builtin_amdgcn_readfirstlane(tid >> 6), wr = wid >> 1, wc = wid & 1, c = lane & 31, h = lane >> 5;
  const int b = bid_(), G = (int)gridDim.x;
  __builtin_amdgcn_s_barrier();
  if (b >= ntiles) return;
  const int nk = g.K >> 5, my_tiles = (ntiles - b + G - 1) / G, total = my_tiles * nk;
  LAS3 char* l3 = (LAS3 char*)lds;
  const unsigned lbase = (unsigned)(size_t)l3;
  const int prow = tid >> 2, gch = (tid & 3) ^ ((tid >> 4) & 3);
  int s_t = b, s_kt = 0, sm0, sn0; tile_rc256(s_t, NT, sm0, sn0);
  const bf16_t* Ap = g.A + (size_t)(sm0 + prow) * g.lda + gch * 8;
  const bf16_t* Bp = g.Bt + (size_t)(sn0 + prow) * g.ldb + gch * 8;
  const size_t astep = (size_t)64 * g.lda, bstep = (size_t)64 * g.ldb;
  auto stage = [&](int slot) {
    LAS3 char* d = l3 + slot * 24576 + wid * 1024;
    __builtin_amdgcn_global_load_lds((const unsigned*)(Ap), (LAS3 unsigned*)(d), 16, 0, 0);
    __builtin_amdgcn_global_load_lds((const unsigned*)(Ap + astep), (LAS3 unsigned*)(d + 4096), 16, 0, 0);
    __builtin_amdgcn_global_load_lds((const unsigned*)(Ap + 2 * astep), (LAS3 unsigned*)(d + 8192), 16, 0, 0);
    __builtin_amdgcn_global_load_lds((const unsigned*)(Ap + 3 * astep), (LAS3 unsigned*)(d + 12288), 16, 0, 0);
    __builtin_amdgcn_global_load_lds((const unsigned*)(Bp), (LAS3 unsigned*)(d + 16384), 16, 0, 0);
    __builtin_amdgcn_global_load_lds((const unsigned*)(Bp + bstep), (LAS3 unsigned*)(d + 20480), 16, 0, 0);
    Ap += 32; Bp += 32;
    if (++s_kt == nk) { s_kt = 0; s_t += G; if (s_t < ntiles) { tile_rc256(s_t, NT, sm0, sn0);
        Ap = g.A + (size_t)(sm0 + prow) * g.lda + gch * 8; Bp = g.Bt + (size_t)(sn0 + prow) * g.ldb + gch * 8; } }
  };
  int c_t = b, c_kt = 0, cm0, cn0; tile_rc256(c_t, NT, cm0, cn0);
  f32x16 acc[4][2];
#pragma unroll
  for (int i = 0; i < 4; ++i)
#pragma unroll
    for (int j = 0; j < 2; ++j)
#pragma unroll
      for (int r = 0; r < 16; ++r) acc[i][j][r] = 0.f;
  const unsigned swz = (c >> 2) & 3;
  const unsigned aoff = (wr * 128 + c) * 64, boff = 16384 + (wc * 64 + c) * 64;
  const unsigned ko0 = ((0 + h) ^ swz) << 4, ko1 = ((2 + h) ^ swz) << 4;
  float rcur[4] = {1.f, 1.f, 1.f, 1.f};
  if (ASC) {
#pragma unroll
    for (int mt = 0; mt < 4; ++mt) rcur[mt] = seg_rscale(g.asc, 0, cm0 + wr * 128 + mt * 32 + c); }
  stage(0); if (total > 1) stage(1);
  int cslot = 0;
  for (int gi = 0; gi < total; ++gi) {
    if (gi + 1 < total) asm volatile("s_waitcnt vmcnt(6)" ::: "memory");
    else asm volatile("s_waitcnt vmcnt(0)" ::: "memory");
    __builtin_amdgcn_s_barrier(); asm volatile("" ::: "memory");
    if (gi + 2 < total) stage(cslot == 0 ? 2 : cslot - 1);
    if (ASC) { if (c_kt > 0 && (c_kt & 7) == 0) {
#pragma unroll
      for (int mt = 0; mt < 4; ++mt) { const float rn = seg_rscale(g.asc, c_kt >> 3, cm0 + wr * 128 + mt * 32 + c); const float f = rcur[mt] / rn; rcur[mt] = rn;
        acc[mt][0] = acc[mt][0] * f; acc[mt][1] = acc[mt][1] * f; } } }
    const unsigned sb = lbase + cslot * 24576;
    cslot = cslot == 2 ? 0 : cslot + 1;
    bf16x8 fa[4], fb[2], ga[4], gb[2];
    { const unsigned a0 = sb + aoff + ko0, a1 = sb + aoff + ko1, b0 = sb + boff + ko0, b1 = sb + boff + ko1;
      asm volatile("ds_read_b128 %0, %1" : "=v"(fa[0]) : "v"(a0)); asm volatile("ds_read_b128 %0, %1 offset:2048" : "=v"(fa[1]) : "v"(a0));
      asm volatile("ds_read_b128 %0, %1 offset:4096" : "=v"(fa[2]) : "v"(a0)); asm volatile("ds_read_b128 %0, %1 offset:6144" : "=v"(fa[3]) : "v"(a0));
      asm volatile("ds_read_b128 %0, %1" : "=v"(fb[0]) : "v"(b0)); asm volatile("ds_read_b128 %0, %1 offset:2048" : "=v"(fb[1]) : "v"(b0));
      asm volatile("ds_read_b128 %0, %1" : "=v"(ga[0]) : "v"(a1)); asm volatile("ds_read_b128 %0, %1 offset:2048" : "=v"(ga[1]) : "v"(a1));
      asm volatile("ds_read_b128 %0, %1 offset:4096" : "=v"(ga[2]) : "v"(a1)); asm volatile("ds_read_b128 %0, %1 offset:6144" : "=v"(ga[3]) : "v"(a1));
      asm volatile("ds_read_b128 %0, %1" : "=v"(gb[0]) : "v"(b1)); asm volatile("ds_read_b128 %0, %1 offset:2048" : "=v"(gb[1]) : "v"(b1)); }
    asm volatile("s_waitcnt lgkmcnt(6)" : "+v"(fa[0]), "+v"(fa[1]), "+v"(fa[2]), "+v"(fa[3]), "+v"(fb[0]), "+v"(fb[1]));
    __builtin_amdgcn_s_setprio(1);
#pragma unroll
    for (int mt = 0; mt < 4; ++mt)
#pragma unroll
      for (int nt = 0; nt < 2; ++nt) acc[mt][nt] = MFMA(fb[nt], fa[mt], acc[mt][nt]);
    __builtin_amdgcn_s_setprio(0);
    asm volatile("s_waitcnt lgkmcnt(0)" : "+v"(ga[0]), "+v"(ga[1]), "+v"(ga[2]), "+v"(ga[3]), "+v"(gb[0]), "+v"(gb[1]));
    __builtin_amdgcn_s_setprio(1);
#pragma unroll
    for (int mt = 0; mt < 4; ++mt)
#pragma unroll
      for (int nt = 0; nt < 2; ++nt) acc[mt][nt] = MFMA(gb[nt], ga[mt], acc[mt][nt]);
    __builtin_amdgcn_s_setprio(0);
    if (++c_kt == nk) {
      if (ASC) {
#pragma unroll
        for (int mt = 0; mt < 4; ++mt) { acc[mt][0] = acc[mt][0] * rcur[mt]; acc[mt][1] = acc[mt][1] * rcur[mt]; } }
      { int c2_ = c, h2_ = h; asm volatile("" : "+v"(c2_), "+v"(h2_));
        epi(acc, cm0, cn0, wr, wc, c2_, h2_); }
#pragma unroll
      for (int i = 0; i < 4; ++i)
#pragma unroll
        for (int j = 0; j < 2; ++j)
#pragma unroll
          for (int r = 0; r < 16; ++r) acc[i][j][r] = 0.f;
      c_kt = 0; c_t += G;
      if (c_t < ntiles) { tile_rc256(c_t, NT, cm0, cn0);
        if (ASC) {
#pragma unroll
          for (int mt = 0; mt < 4; ++mt) rcur[mt] = seg_rscale(g.asc, 0, cm0 + wr * 128 + mt * 32 + c); } }
    }
  }
}

__device__ __forceinline__ void store_plain(bf16_t* dst, const f32x16& v, int h) {
#pragma unroll
  for (int g = 0; g < 4; ++g) { u32x2 w; w.x = pk2(v[4 * g], v[4 * g + 1]); w.y = pk2(v[4 * g + 2], v[4 * g + 3]); *(u32x2*)(dst + 8 * g + 4 * h) = w; }
}
__device__ __forceinline__ void store_vt(bf16_t* vt, int featbase, int tok, const f32x16& v, int h) {
  const int pt = permtok(tok);
#pragma unroll
  for (int r = 0; r < 16; ++r) vt[(size_t)(featbase + crow(r, h)) * VLD + pt] = f2bf(v[r]);
}
__device__ __forceinline__ void rope32(f32x16& v, const float* c32, const float* s32, int tok, int h) {
  const f32x4 ca = *(const f32x4*)(c32 + tok * 16 + 4 * h), cb = *(const f32x4*)(c32 + tok * 16 + 8 + 4 * h);
  const f32x4 sa = *(const f32x4*)(s32 + tok * 16 + 4 * h), sb = *(const f32x4*)(s32 + tok * 16 + 8 + 4 * h);
#pragma unroll
  for (int i = 0; i < 4; ++i) {
    float x1 = v[i], x2 = v[i + 8]; v[i] = x1 * ca[i] - x2 * sa[i]; v[i + 8] = x2 * ca[i] + x1 * sa[i];
    x1 = v[4 + i]; x2 = v[12 + i]; v[4 + i] = x1 * cb[i] - x2 * sb[i]; v[12 + i] = x2 * cb[i] + x1 * sb[i];
  }
}
__device__ __forceinline__ void rope64(f32x16& v0, f32x16& v1, const float* c64, const float* s64, int tok, int h) {
#pragma unroll
  for (int g = 0; g < 4; ++g) {
    const f32x4 cg4 = *(const f32x4*)(c64 + tok * 32 + 8 * g + 4 * h), sg4 = *(const f32x4*)(s64 + tok * 32 + 8 * g + 4 * h);
#pragma unroll
    for (int i = 0; i < 4; ++i) { const float x1 = v0[4 * g + i], x2 = v1[4 * g + i]; v0[4 * g + i] = x1 * cg4[i] - x2 * sg4[i]; v1[4 * g + i] = x2 * cg4[i] + x1 * sg4[i]; }
  }
}
__device__ __forceinline__ float sumsq16(const f32x16& v) { float s = 0.f;
#pragma unroll
  for (int r = 0; r < 16; ++r) s += v[r] * v[r];
  return s; }
__device__ __forceinline__ void kmax_update(unsigned* slot, float s) {
  s += __shfl_xor(s, 32);
#pragma unroll
  for (int o = 16; o; o >>= 1) s = fmaxf(s, __shfl_xor(s, o));
  if ((threadIdx.x & 63) == 0) atomicMax(slot, __float_as_uint(s));
}
__device__ __forceinline__ float rowscale_ssx(const float* ssx, int tok) {
  const f32x4* sp = (const f32x4*)(ssx + (size_t)tok * 16); const f32x4 a = sp[0], b = sp[1], c = sp[2], d = sp[3];
  const float t = ((a[0] + a[1]) + (a[2] + a[3])) + ((b[0] + b[1]) + (b[2] + b[3])) + ((c[0] + c[1]) + (c[2] + c[3])) + ((d[0] + d[1]) + (d[2] + d[3]));
  return rsqrtf(t * (1.f / 1024.f) + EPS);
}

struct EpiIn { static constexpr int kLds = 1;
  bf16_t* P; bf16_t* Vt; const float* ssx; float* ssa; const float *c32, *s32, *c64, *s64; unsigned* kmax;
  __device__ __forceinline__ void operator()(f32x16 (&acc)[2][2], int m0, int n0, int wr, int wc, int c, int h, char* lds) const {
    const int g64 = (n0 >> 6) + wc;
    char* st = lds + 32768 + (wr * 2 + wc) * 9216;
    int vtb = -1, kslot = -1, ssl = -1; bool r32 = false, r64 = false;
    if (g64 <= 5) { if (g64 == 3) { r32 = true; kslot = 4; } else ssl = g64; }
    else if (g64 <= 13) { r32 = true; if (g64 >= 10) kslot = 5 + (g64 - 10); }
    else if (g64 <= 17) vtb = (g64 - 14) * 64;
    else if (g64 <= 23) { r64 = true; if (g64 >= 22) kslot = 9 + (g64 - 22); }
    else if (g64 <= 25) vtb = 256 + (g64 - 24) * 64;
    else if (g64 <= 33) { if (g64 >= 30) kslot = 11 + (g64 - 30); }
    else vtb = 384 + (g64 - 34) * 64;
#pragma unroll
    for (int mt = 0; mt < 2; ++mt) {
      const int tok = m0 + wr * 64 + mt * 32 + c;
      const float rr = rowscale_ssx(ssx, tok);
      f32x16 v0 = acc[mt][0] * rr, v1 = acc[mt][1] * rr;
      if (vtb >= 0) { store_vt(Vt, vtb, tok, v0, h); store_vt(Vt, vtb + 32, tok, v1, h); continue; }
      if (r32) { rope32(v0, c32, s32, tok, h); if (g64 != 3) rope32(v1, c32, s32, tok, h); }
      if (r64) rope64(v0, v1, c64, s64, tok, h);
      { char* sp = st + (mt * 32 + c) * 144 + 8 * h;
#pragma unroll
        for (int g = 0; g < 4; ++g) { u32x2 w; w.x = pk2(v0[4 * g], v0[4 * g + 1]); w.y = pk2(v0[4 * g + 2], v0[4 * g + 3]); *(u32x2*)(sp + 16 * g) = w;
          u32x2 w1; w1.x = pk2(v1[4 * g], v1[4 * g + 1]); w1.y = pk2(v1[4 * g + 2], v1[4 * g + 3]); *(u32x2*)(sp + 64 + 16 * g) = w1; } }
      if (kslot >= 0) kmax_update(kmax + kslot, sumsq16(v0) + (g64 == 3 ? 0.f : sumsq16(v1)));
      if (ssl >= 0) { float s = sumsq16(v0) + sumsq16(v1); s += __shfl_xor(s, 32); if (h == 0) ssa[(size_t)tok * 8 + ssl] = s; }
    }
    if (vtb < 0) {
      const int lane = h * 32 + c, rr8 = lane >> 3, ch = lane & 7;
#pragma unroll
      for (int j = 0; j < 8; ++j) { const int row = j * 8 + rr8;
        const u32x4 a4 = *(const u32x4*)(st + row * 144 + ch * 16);
        *(u32x4*)(P + (size_t)(m0 + wr * 64 + row) * NP + g64 * 64 + ch * 8) = a4; }
    }
  }
};
struct EpiUq { static constexpr int kLds = 0;
  bf16_t* Qa; const float* ssa; const float *c32, *s32;
  __device__ __forceinline__ void operator()(f32x16 (&acc)[2][2], int m0, int n0, int wr, int wc, int c, int h) const {
    const int g32 = ((n0 >> 6) + wc) * 2;
#pragma unroll
    for (int mt = 0; mt < 2; ++mt) {
      const int tok = m0 + wr * 64 + mt * 32 + c;
      const float* sp = ssa + (size_t)tok * 8; const float rr = rsqrtf((sp[0] + sp[1] + sp[2]) * (1.f / 192.f) + EPS);
#pragma unroll
      for (int nt = 0; nt < 2; ++nt) {
        f32x16 v = acc[mt][nt] * rr;
        if ((g32 + nt) % 3 == 2) rope32(v, c32, s32, tok, h);
        store_plain(Qa + (size_t)tok * 384 + (g32 + nt) * 32, v, h);
      }
    }
  }
};
struct EpiKv { static constexpr int kLds = 0;
  bf16_t* KN; bf16_t* VtA; const float* ssa; unsigned* kmax;
  __device__ __forceinline__ void operator()(f32x16 (&acc)[2][2], int m0, int n0, int wr, int wc, int c, int h) const {
    const int g64 = (n0 >> 6) + wc;
#pragma unroll
    for (int mt = 0; mt < 2; ++mt) {
      const int tok = m0 + wr * 64 + mt * 32 + c;
      const float* sp = ssa + (size_t)tok * 8; const float rr = rsqrtf((sp[4] + sp[5]) * (1.f / 128.f) + EPS);
      const f32x16 v0 = acc[mt][0] * rr, v1 = acc[mt][1] * rr;
      if (g64 < 4) {
        bf16_t* dst = KN + (size_t)tok * 256 + g64 * 64; store_plain(dst, v0, h); store_plain(dst + 32, v1, h);
        kmax_update(kmax + g64, sumsq16(v0) + sumsq16(v1));
      } else { store_vt(VtA, (g64 - 4) * 64, tok, v0, h); store_vt(VtA, (g64 - 4) * 64 + 32, tok, v1, h); }
    }
  }
};
struct EpiRes {
  static constexpr int kLds = 1;
  bf16_t* xb; float* ssx;
  __device__ __forceinline__ void operator()(f32x16 (&acc)[2][2], int m0, int n0, int wr, int wc, int c, int h, char* lds) const {
    char* st = lds + 32768 + (wr * 2 + wc) * 9216;
#pragma unroll
    for (int mt = 0; mt < 2; ++mt)
#pragma unroll
      for (int nt = 0; nt < 2; ++nt)
#pragma unroll
        for (int g = 0; g < 4; ++g) { u32x2 w; w.x = pk2(acc[mt][nt][4 * g], acc[mt][nt][4 * g + 1]); w.y = pk2(acc[mt][nt][4 * g + 2], acc[mt][nt][4 * g + 3]);
          *(u32x2*)(st + (mt * 32 + c) * 144 + (nt * 32 + 8 * g + 4 * h) * 2) = w; }
    const int lane = h * 32 + c, rr = lane >> 3, ch = lane & 7;
#pragma unroll
    for (int j = 0; j < 8; ++j) {
      const int row = j * 8 + rr, tok = m0 + wr * 64 + row;
      const u32x4 a4 = *(const u32x4*)(st + row * 144 + ch * 16);
      bf16_t* xp = xb + (size_t)tok * 1024 + n0 + wc * 64 + ch * 8;
      const u32x4 x4 = *(const u32x4*)xp; u32x4 o4; float s = 0.f;
#pragma unroll
      for (int k = 0; k < 4; ++k) {
        const float f0 = bf2f(x4[k] & 0xffffu) + bf2f(a4[k] & 0xffffu), f1 = __uint_as_float(x4[k] & 0xffff0000u) + __uint_as_float(a4[k] & 0xffff0000u);
        s += f0 * f0 + f1 * f1; o4[k] = pk2(f0, f1); }
      *(u32x4*)xp = o4;
      s += __shfl_xor(s, 1); s += __shfl_xor(s, 2); s += __shfl_xor(s, 4);
      if (ch == 0) ssx[(size_t)tok * 16 + (n0 >> 7) * 2 + wc] = s;
    }
  }
};
struct EpiUp {
  static constexpr int kLds = 1;
  bf16_t* H; const float* ssx;
  __device__ __forceinline__ void operator()(f32x16 (&acc)[2][2], int m0, int n0, int wr, int wc, int c, int h, char* lds) const {
    char* st = lds + 32768 + (wr * 2 + wc) * 9216;
#pragma unroll
    for (int mt = 0; mt < 2; ++mt) {
      const int tok = m0 + wr * 64 + mt * 32 + c; const float rr = rowscale_ssx(ssx, tok);
#pragma unroll
      for (int nt = 0; nt < 2; ++nt)
#pragma unroll
        for (int g = 0; g < 4; ++g) { float t[4];
#pragma unroll
          for (int i = 0; i < 4; ++i) { const float u = fmaxf(acc[mt][nt][4 * g + i] * rr, 0.f); t[i] = u * u; }
          u32x2 w; w.x = pk2(t[0], t[1]); w.y = pk2(t[2], t[3]);
          *(u32x2*)(st + (mt * 32 + c) * 144 + (nt * 32 + 8 * g + 4 * h) * 2) = w; }
    }
    const int lane = h * 32 + c, rr8 = lane >> 3, ch = lane & 7;
#pragma unroll
    for (int j = 0; j < 8; ++j) { const int row = j * 8 + rr8;
      const u32x4 a4 = *(const u32x4*)(st + row * 144 + ch * 16);
      *(u32x4*)(H + (size_t)(m0 + wr * 64 + row) * 4096 + n0 + wc * 64 + ch * 8) = a4; }
  }
};

struct EpiUp4 { static constexpr int kLds = 0;
  bf16_t* H; const float* ssx;
  __device__ __forceinline__ void operator()(f32x16 (&acc)[4][2], int m0, int n0, int wr, int wc, int c, int h) const {
#pragma unroll
    for (int mt = 0; mt < 4; ++mt) {
      __builtin_amdgcn_sched_barrier(0);
      const int tok = m0 + wr * 128 + mt * 32 + c; const float rr = rowscale_ssx(ssx, tok);
#pragma unroll
      for (int nt = 0; nt < 2; ++nt) {
        f32x16 v;
#pragma unroll
        for (int r = 0; r < 16; ++r) { const float t = fmaxf(acc[mt][nt][r] * rr, 0.f); v[r] = t * t; }
        store_plain(H + (size_t)tok * 4096 + n0 + wc * 64 + nt * 32, v, h);
      }
    }
  }
};

struct AttnArgs { const bf16_t *P, *Vt, *Qa, *KN, *VtA; bf16_t* mix; float* ssm; const unsigned* kmax;
  const float *lq1, *lk1, *lq2, *lk2, *subln, *sinks, *rpb; float lam_init; };

constexpr int ABUF = 22528, AKOFF = 13312, ATAB = 2 * ABUF;

template <int MODE>
__device__ __forceinline__ void attn_item(char* lds, const AttnArgs& a, int item) {
  constexpr int KSTR = MODE == 0 ? 208 : 144;
  constexpr int NKS = MODE == 0 ? 6 : (MODE == 1 ? 2 : 4);
  constexpr int NKP = MODE == 0 ? 3 : 2;
  constexpr int NQT = MODE == 1 ? 2 : 1;
  int tid_ = threadIdx.x; asm volatile("" : "+v"(tid_));
  const int tid = tid_, lane = tid & 63, wid = tid >> 6, c = lane & 31, h = lane >> 5;
  int hd, sb, se; int qtok[NQT]; const bf16_t* qptr[NQT]; const bf16_t* kbase; const bf16_t* vbase; int k2slot;
  int narow = 0, nars = 0, nahalf = 0, kvh = 0;
  if constexpr (MODE == 0) { hd = item & 3; const int qb = item >> 2; sb = 0; se = 256;
    qtok[0] = qb * 128 + wid * 32 + c; qptr[0] = a.Qa + (size_t)qtok[0] * 384 + hd * 96;
    kbase = a.KN + hd * 64; vbase = a.VtA + (size_t)hd * 64 * VLD; k2slot = hd; }
  else if constexpr (MODE == 1) { hd = item & 3; const int qb = item >> 2; sb = 0; se = 256;
#pragma unroll
    for (int qt = 0; qt < 2; ++qt) { qtok[qt] = qb * 128 + wid * 32 + c; qptr[qt] = a.P + (size_t)qtok[qt] * NP + 384 + hd * 64 + qt * 32; }
    kbase = a.P + 640 + hd * 64; vbase = a.Vt + (size_t)hd * 64 * VLD; k2slot = 5 + hd; }
  else if constexpr (MODE == 2) { hd = item & 3; kvh = hd >> 1; const int qb = item >> 2; sb = max(0, 2 * qb - 2); se = min(256, 2 * qb + 4);
    qtok[0] = qb * 128 + wid * 32 + c; qptr[0] = a.P + (size_t)qtok[0] * NP + 1152 + hd * 64;
    kbase = a.P + 1408 + kvh * 64; vbase = a.Vt + (size_t)(256 + kvh * 64) * VLD; k2slot = 9 + kvh; }
  else { hd = item & 3; const int rg = item >> 2; narow = rg * 2 + (wid >> 1); nahalf = wid & 1; nars = min(max(narow - 4, 0), 248);
    sb = min(max(rg * 2 - 4, 0), 248); se = min(max(rg * 2 - 3, 0), 248) + 8;
    qtok[0] = narow * 64 + nahalf * 32 + c; qptr[0] = a.P + (size_t)qtok[0] * NP + 1664 + hd * 64;
    kbase = a.P + 1920 + hd * 64; vbase = a.Vt + (size_t)(384 + hd * 64) * VLD; k2slot = 11 + hd; }

  bf16x8 qf[NQT][NKS]; float q2max = 0.f;
#pragma unroll
  for (int qt = 0; qt < NQT; ++qt) { float s = 0.f;
#pragma unroll
    for (int ks = 0; ks < NKS; ++ks) { qf[qt][ks] = *(const bf16x8*)(qptr[qt] + ks * 16 + h * 8);
#pragma unroll
      for (int j = 0; j < 8; ++j) { const float f = bf2f((unsigned short)qf[qt][ks][j]); s += f * f; } }
    s += __shfl_xor(s, 32); q2max = fmaxf(q2max, s); }
#pragma unroll
  for (int o = 16; o; o >>= 1) q2max = fmaxf(q2max, __shfl_xor(q2max, o));
  float k2 = __uint_as_float(a.kmax[k2slot]); if (MODE == 0) k2 += __uint_as_float(a.kmax[4]);
  float cb = sqrtf(q2max * k2) * 1.01f + 0.01f;
  if (MODE == 3) {
    float* tab = (float*)(lds + ATAB); const float* rp = a.rpb + hd * 465; float bm = 0.f;
    for (int i = lane; i < 465; i += 64) bm = fmaxf(bm, fabsf(rp[i]));
#pragma unroll
    for (int o = 32; o; o >>= 1) bm = fmaxf(bm, __shfl_xor(bm, o));
    cb += bm * LOG2E;
    for (int i = tid; i < 480; i += 256) { const int dr = i >> 5, dc = i & 31; tab[i] = dc < 31 ? rp[dr * 31 + dc] * LOG2E : 0.f; }
  }
  f32x16 negc;
#pragma unroll
  for (int r = 0; r < 16; ++r) negc[r] = -cb;

  f32x16 O[NQT][2]; float l[NQT];
#pragma unroll
  for (int i = 0; i < NQT; ++i) l[i] = 0.f;
#pragma unroll
  for (int i = 0; i < NQT; ++i)
#pragma unroll
    for (int j = 0; j < 2; ++j)
#pragma unroll
      for (int r = 0; r < 16; ++r) O[i][j][r] = 0.f;

  u32x4 rk[NKP], rv[2];
  auto gload = [&](int st) {
    const int kb = st * 64;
#pragma unroll
    for (int i = 0; i < NKP; ++i) { const int p = tid + 256 * i;
      if (MODE == 0) {
        if (i < 2) { const int row = p >> 3, ch = p & 7; rk[i] = *(const u32x4*)(kbase + (size_t)(kb + row) * 256 + ch * 8); }
        else { const int row = tid >> 2, ch = tid & 3; rk[i] = *(const u32x4*)(a.P + (size_t)(kb + row) * NP + 192 + ch * 8); } }
      else { const int row = p >> 3, ch = p & 7; rk[i] = *(const u32x4*)(kbase + (size_t)(kb + row) * NP + ch * 8); } }
#pragma unroll
    for (int i = 0; i < 2; ++i) { const int p = tid + 256 * i, dv = p >> 3, ch = p & 7; rv[i] = *(const u32x4*)(vbase + (size_t)dv * VLD + kb + ch * 8); }
  };
  auto lstore = [&](int buf) {
    char* b = lds + buf * ABUF;
#pragma unroll
    for (int i = 0; i < NKP; ++i) { const int p = tid + 256 * i;
      if (MODE == 0) { if (i < 2) { const int row = p >> 3, ch = p & 7; *(u32x4*)(b + row * 208 + ch * 16) = rk[i]; } else { const int row = tid >> 2, ch = tid & 3; *(u32x4*)(b + row * 208 + 128 + ch * 16) = rk[i]; } }
      else { const int row = p >> 3, ch = p & 7; *(u32x4*)(b + row * 144 + ch * 16) = rk[i]; } }
#pragma unroll
    for (int i = 0; i < 2; ++i) { const int p = tid + 256 * i, dv = p >> 3, ch = p & 7; *(u32x4*)(b + AKOFF + dv * 144 + ch * 16) = rv[i]; }
  };

  gload(sb); lstore(0); __syncthreads();
  for (int st = sb; st < se; ++st) {
    const int buf = (st - sb) & 1;
    if (st + 1 < se) gload(st + 1);
    __builtin_amdgcn_sched_barrier(0);
    const bool active = MODE != 3 || (st >= nars && st < nars + 8);
    if (active) {
      const char* Kb = lds + buf * ABUF; const char* Vb = Kb + AKOFF;
#pragma unroll
      for (int kt2 = 0; kt2 < 2; ++kt2) {
        f32x16 sc[NQT];
#pragma unroll
        for (int qt = 0; qt < NQT; ++qt) sc[qt] = negc;
        if (MODE != 1) {
#pragma unroll
          for (int ks = 0; ks < NKS; ++ks) { const bf16x8 kf = *(const bf16x8*)(Kb + (kt2 * 32 + c) * KSTR + ks * 32 + h * 16);
#pragma unroll
            for (int qt = 0; qt < NQT; ++qt) sc[qt] = MFMA(kf, qf[qt][ks], sc[qt]); }
        } else {
#pragma unroll
          for (int qt = 0; qt < NQT; ++qt)
#pragma unroll
            for (int ks = 0; ks < NKS; ++ks) { const bf16x8 kf = *(const bf16x8*)(Kb + (kt2 * 32 + c) * KSTR + qt * 64 + ks * 32 + h * 16);
              sc[qt] = MFMA(kf, qf[qt][ks], sc[qt]); }
        }
        if (MODE == 2) {
          const int kb0 = st * 64 + kt2 * 32 - qtok[0];
#pragma unroll
          for (int i = 0; i < 16; ++i) { const int d = kb0 + crow(i, h); const bool ok = d <= 128 && d >= -128;
            sc[0][i] = ok ? sc[0][i] : -INFINITY; }
        }
        if (MODE == 3) {
          const float* trow = (const float*)(lds + ATAB) + (st - narow + 7) * 32;
#pragma unroll
          for (int qt = 0; qt < NQT; ++qt) { const int w = nahalf * 32 + c, cs = min(max(w - 8, 0), 48);
#pragma unroll
            for (int i = 0; i < 16; ++i) { const int kc = kt2 * 32 + crow(i, h); const bool ok = kc >= cs && kc < cs + 16;
              const float bv = trow[(kc - w + 15) & 31]; sc[qt][i] = ok ? sc[qt][i] + bv : -INFINITY; } }
        }
        bf16x8 pf[NQT][2];
#pragma unroll
        for (int qt = 0; qt < NQT; ++qt) {
          float p[16];
#pragma unroll
          for (int i = 0; i < 16; ++i) { p[i] = __builtin_amdgcn_exp2f(sc[qt][i]); l[qt] += p[i]; }
#pragma unroll
          for (int s2 = 0; s2 < 2; ++s2) { u32x4 w; w.x = pk2(p[8 * s2], p[8 * s2 + 1]); w.y = pk2(p[8 * s2 + 2], p[8 * s2 + 3]);
            w.z = pk2(p[8 * s2 + 4], p[8 * s2 + 5]); w.w = pk2(p[8 * s2 + 6], p[8 * s2 + 7]); pf[qt][s2] = __builtin_bit_cast(bf16x8, w); }
        }
#pragma unroll
        for (int dt = 0; dt < 2; ++dt)
#pragma unroll
          for (int s2 = 0; s2 < 2; ++s2) { const bf16x8 vf = *(const bf16x8*)(Vb + (dt * 32 + c) * 144 + kt2 * 64 + s2 * 32 + h * 16);
#pragma unroll
            for (int qt = 0; qt < NQT; ++qt) O[qt][dt] = MFMA(vf, pf[qt][s2], O[qt][dt]); }
      }
    }
    __builtin_amdgcn_sched_barrier(0);
    if (st + 1 < se) lstore(buf ^ 1);
    __syncthreads();
  }

#pragma unroll
  for (int qt = 0; qt < NQT; ++qt) l[qt] += __shfl_xor(l[qt], 32);
  if (MODE == 1) {
    float pa = 0.f, pb = 0.f;
    if (lane < 32) { pa = a.lq1[lane] * a.lk1[lane]; pb = a.lq2[lane] * a.lk2[lane]; }
#pragma unroll
    for (int o = 32; o; o >>= 1) { pa += __shfl_xor(pa, o); pb += __shfl_xor(pb, o); }
    const float lam = expf(pa) - expf(pb) + a.lam_init;
    const float i0 = 1.f / l[0], i1 = lam / l[NQT - 1];
    f32x16 o[2]; float ss = 0.f;
#pragma unroll
    for (int dt = 0; dt < 2; ++dt)
#pragma unroll
      for (int r = 0; r < 16; ++r) { o[dt][r] = O[0][dt][r] * i0 - O[NQT - 1][dt][r] * i1; ss += o[dt][r] * o[dt][r]; }
    ss += __shfl_xor(ss, 32);
    const float rn = rsqrtf(ss * (1.f / 64.f) + EPS) * (1.f - a.lam_init);
#pragma unroll
    for (int dt = 0; dt < 2; ++dt) {
#pragma unroll
      for (int g = 0; g < 4; ++g) { const f32x4 gg = *(const f32x4*)(a.subln + dt * 32 + 8 * g + 4 * h);
#pragma unroll
        for (int i = 0; i < 4; ++i) o[dt][4 * g + i] *= rn * gg[i]; }
      store_plain(a.mix + (size_t)qtok[0] * 1024 + 256 + hd * 64 + dt * 32, o[dt], h);
    }
  } else {
#pragma unroll
    for (int qt = 0; qt < NQT; ++qt) {
      int head, colb, seg;
      if (MODE == 0) { head = hd; colb = hd * 64; seg = 0; }
      else if (MODE == 2) { head = hd; colb = 512 + head * 64; seg = 1; l[qt] += __builtin_amdgcn_exp2f(a.sinks[head] * LOG2E - cb); }
      else { head = hd; colb = 768 + hd * 64; seg = 2; }
      const float inv = 1.f / l[qt]; float ss = 0.f;
#pragma unroll
      for (int dt = 0; dt < 2; ++dt) { f32x16 o = O[qt][dt] * inv; ss += sumsq16(o); store_plain(a.mix + (size_t)qtok[qt] * 1024 + colb + dt * 32, o, h); }
      ss += __shfl_xor(ss, 32);
      if (h == 0) a.ssm[(size_t)(seg * 4 + head) * S + qtok[qt]] = ss;
    }
  }
}


template <bool B> struct BoolC { static constexpr bool value = B; };
#define SGB(mask, n) __builtin_amdgcn_sched_group_barrier((mask), (n), 0)
template <int MODE>
__device__ __forceinline__ bool attn_pipe(char* lds, const AttnArgs& a, int item) {
  constexpr int KSTR = MODE == 0 ? 208 : 144;
  constexpr int NKS = MODE == 0 ? 6 : 2;
  constexpr int NKP = MODE == 0 ? 3 : 2;
  constexpr int NST = 256;
  constexpr int NQT = MODE == 0 ? 1 : 2;
  int tid_ = threadIdx.x; asm volatile("" : "+v"(tid_));
  const int tid = tid_, lane = tid & 63, wid = tid >> 6, c = lane & 31, h = lane >> 5;
  const int hd = item & 3, qb = item >> 2;
  int qtok[NQT]; const bf16_t* qptr[NQT]; const bf16_t* kbase; const bf16_t* vbase; int k2slot;
  if constexpr (MODE == 0) {
    qtok[0] = qb * 128 + wid * 32 + c; qptr[0] = a.Qa + (size_t)qtok[0] * 384 + hd * 96;
    kbase = a.KN + hd * 64; vbase = a.VtA + (size_t)hd * 64 * VLD; k2slot = hd;
  } else {
#pragma unroll
    for (int qt = 0; qt < 2; ++qt) { qtok[qt] = qb * 128 + wid * 32 + c; qptr[qt] = a.P + (size_t)qtok[qt] * NP + 384 + hd * 64 + qt * 32; }
    kbase = a.P + 640 + hd * 64; vbase = a.Vt + (size_t)hd * 64 * VLD; k2slot = 5 + hd;
  }
  bf16x8 qf[NQT][NKS]; float q2max = 0.f;
#pragma unroll
  for (int qt = 0; qt < NQT; ++qt) { float s = 0.f;
#pragma unroll
    for (int ks = 0; ks < NKS; ++ks) { qf[qt][ks] = *(const bf16x8*)(qptr[qt] + ks * 16 + h * 8);
#pragma unroll
      for (int j = 0; j < 8; ++j) { const float f = bf2f((unsigned short)qf[qt][ks][j]); s += f * f; } }
    s += __shfl_xor(s, 32); q2max = fmaxf(q2max, s); }
#pragma unroll
  for (int o = 16; o; o >>= 1) q2max = fmaxf(q2max, __shfl_xor(q2max, o));
  float k2 = __uint_as_float(a.kmax[k2slot]); if (MODE == 0) k2 += __uint_as_float(a.kmax[4]);
  const float cb = sqrtf(q2max * k2) * 1.01f + 0.01f;
  { volatile int* flag = (volatile int*)(lds + 3 * ABUF);
    if (tid == 0) *flag = 0;
    __syncthreads();
    if (cb > 96.f && lane == 0) *flag = 1;
    __syncthreads();
    if (*flag) return false; }
  f32x16 O[NQT][2]; float l[NQT];
#pragma unroll
  for (int i = 0; i < NQT; ++i) { l[i] = 0.f;
#pragma unroll
    for (int j = 0; j < 2; ++j)
#pragma unroll
      for (int r = 0; r < 16; ++r) O[i][j][r] = 0.f; }

  u32x4 rk[NKP], rv[2];
  auto gload = [&](int st) {
    const int kb = st * 64;
#pragma unroll
    for (int i = 0; i < NKP; ++i) { const int p = tid + 256 * i;
      if (MODE == 0) {
        if (i < 2) { const int row = p >> 3, ch = p & 7; rk[i] = *(const u32x4*)(kbase + (size_t)(kb + row) * 256 + ch * 8); }
        else { const int row = tid >> 2, ch = tid & 3; rk[i] = *(const u32x4*)(a.P + (size_t)(kb + row) * NP + 192 + ch * 8); } }
      else { const int row = p >> 3, ch = p & 7; rk[i] = *(const u32x4*)(kbase + (size_t)(kb + row) * NP + ch * 8); } }
#pragma unroll
    for (int i = 0; i < 2; ++i) { const int p = tid + 256 * i, dv = p >> 3, ch = p & 7; rv[i] = *(const u32x4*)(vbase + (size_t)dv * VLD + kb + ch * 8); }
  };
  auto lstore = [&](int buf) {
    char* b = lds + buf * ABUF;
#pragma unroll
    for (int i = 0; i < NKP; ++i) { const int p = tid + 256 * i;
      if (MODE == 0) { if (i < 2) { const int row = p >> 3, ch = p & 7; *(u32x4*)(b + row * 208 + ch * 16) = rk[i]; } else { const int row = tid >> 2, ch = tid & 3; *(u32x4*)(b + row * 208 + 128 + ch * 16) = rk[i]; } }
      else { const int row = p >> 3, ch = p & 7; *(u32x4*)(b + row * 144 + ch * 16) = rk[i]; } }
#pragma unroll
    for (int i = 0; i < 2; ++i) { const int p = tid + 256 * i, dv = p >> 3, ch = p & 7; *(u32x4*)(b + AKOFF + dv * 144 + ch * 16) = rv[i]; }
  };
  const int koff = c * KSTR + h * 16, voff = AKOFF + c * 144 + h * 16;
#define QK_UNIT(dst, Kb, u) { _Pragma("unroll") for (int r_ = 0; r_ < 16; ++r_) dst[r_] = 0.f; \
    _Pragma("unroll") for (int ks = 0; ks < NKS; ++ks) { \
      const bf16x8 kf = *(const bf16x8*)((Kb) + koff + ((u) / NQT) * 32 * KSTR + (MODE == 1 ? ((u) % NQT) * 64 : 0) + ks * 32); \
      dst = MFMA(kf, qf[(u) % NQT][ks], dst); } }
#define EXP_UNIT(src, u, pf) { float p_[16]; \
    _Pragma("unroll") for (int i = 0; i < 16; ++i) { p_[i] = __builtin_amdgcn_exp2f(src[i]); l[(u) % NQT] += p_[i]; } \
    _Pragma("unroll") for (int s2 = 0; s2 < 2; ++s2) { u32x4 w_; w_.x = pk2(p_[8 * s2], p_[8 * s2 + 1]); w_.y = pk2(p_[8 * s2 + 2], p_[8 * s2 + 3]); \
      w_.z = pk2(p_[8 * s2 + 4], p_[8 * s2 + 5]); w_.w = pk2(p_[8 * s2 + 6], p_[8 * s2 + 7]); pf[s2] = __builtin_bit_cast(bf16x8, w_); } }
#define PV_UNIT(Vb, u, pf) { \
    _Pragma("unroll") for (int dt = 0; dt < 2; ++dt) \
    _Pragma("unroll") for (int s2 = 0; s2 < 2; ++s2) { \
      const bf16x8 vf = *(const bf16x8*)((Vb) + voff + dt * 32 * 144 + ((u) / NQT) * 64 + s2 * 32); \
      O[(u) % NQT][dt] = MFMA(vf, pf[s2], O[(u) % NQT][dt]); } }
#define SCHED_ITER(NM) { SGB(0x100, 2); \
    _Pragma("unroll") for (int i_ = 0; i_ < (NM); ++i_) { SGB(0x008, 1); SGB(0x002, (40 + (NM) - 1) / (NM)); if (i_ + 2 < (NM)) SGB(0x100, 1); } }

  gload(0); lstore(0); gload(1); lstore(1); __syncthreads();
  f32x16 sc, sn;
  QK_UNIT(sc, lds, 0);
  int cur = 0;
  for (int st = 0; st < NST; ++st) {
    const int nxt = cur == 2 ? 0 : cur + 1, wr = nxt == 2 ? 0 : nxt + 1;
    if (st + 2 < NST) gload(st + 2);
    const char* Kc = lds + cur * ABUF; const char* Kn = lds + nxt * ABUF;
    bf16x8 pa[2], pb[2];
    __builtin_amdgcn_sched_barrier(0);
    if constexpr (NQT == 2) {
      QK_UNIT(sn, Kc, 1); EXP_UNIT(sc, 0, pa); SCHED_ITER(NKS); sc = sn;
      __builtin_amdgcn_sched_barrier(0);
      QK_UNIT(sn, Kc, 2); EXP_UNIT(sc, 1, pb); PV_UNIT(Kc, 0, pa); SCHED_ITER(NKS + 4); sc = sn;
      __builtin_amdgcn_sched_barrier(0);
      QK_UNIT(sn, Kc, 3); EXP_UNIT(sc, 2, pa); PV_UNIT(Kc, 1, pb); SCHED_ITER(NKS + 4); sc = sn;
      __builtin_amdgcn_sched_barrier(0);
      QK_UNIT(sn, Kn, 0); EXP_UNIT(sc, 3, pb); PV_UNIT(Kc, 2, pa); SCHED_ITER(NKS + 4); sc = sn;
      __builtin_amdgcn_sched_barrier(0);
      PV_UNIT(Kc, 3, pb);
    } else {
      QK_UNIT(sn, Kc, 1); EXP_UNIT(sc, 0, pa); SCHED_ITER(NKS); sc = sn;
      __builtin_amdgcn_sched_barrier(0);
      QK_UNIT(sn, Kn, 0); EXP_UNIT(sc, 1, pb); PV_UNIT(Kc, 0, pa); SCHED_ITER(NKS + 4); sc = sn;
      __builtin_amdgcn_sched_barrier(0);
      PV_UNIT(Kc, 1, pb);
    }
    __builtin_amdgcn_sched_barrier(0);
    if (st + 2 < NST) lstore(wr);
    __syncthreads();
    cur = nxt;
  }
#undef QK_UNIT
#undef EXP_UNIT
#undef PV_UNIT
#undef SCHED_ITER

#pragma unroll
  for (int qt = 0; qt < NQT; ++qt) l[qt] += __shfl_xor(l[qt], 32);
  if constexpr (MODE == 1) {
    float pa = 0.f, pb = 0.f;
    if (lane < 32) { pa = a.lq1[lane] * a.lk1[lane]; pb = a.lq2[lane] * a.lk2[lane]; }
#pragma unroll
    for (int o = 32; o; o >>= 1) { pa += __shfl_xor(pa, o); pb += __shfl_xor(pb, o); }
    const float lam = expf(pa) - expf(pb) + a.lam_init;
    const float i0 = 1.f / l[0], i1 = lam / l[1];
    f32x16 o[2]; float ss = 0.f;
#pragma unroll
    for (int dt = 0; dt < 2; ++dt)
#pragma unroll
      for (int r = 0; r < 16; ++r) { o[dt][r] = O[0][dt][r] * i0 - O[1][dt][r] * i1; ss += o[dt][r] * o[dt][r]; }
    ss += __shfl_xor(ss, 32);
    const float rn = rsqrtf(ss * (1.f / 64.f) + EPS) * (1.f - a.lam_init);
#pragma unroll
    for (int dt = 0; dt < 2; ++dt) {
#pragma unroll
      for (int g = 0; g < 4; ++g) { const f32x4 gg = *(const f32x4*)(a.subln + dt * 32 + 8 * g + 4 * h);
#pragma unroll
        for (int i = 0; i < 4; ++i) o[dt][4 * g + i] *= rn * gg[i]; }
      store_plain(a.mix + (size_t)qtok[0] * 1024 + 256 + hd * 64 + dt * 32, o[dt], h);
    }
  } else {
#pragma unroll
    for (int qt = 0; qt < NQT; ++qt) {
      const float inv = 1.f / l[qt]; float ss = 0.f;
#pragma unroll
      for (int dt = 0; dt < 2; ++dt) { f32x16 o = O[qt][dt] * inv; ss += sumsq16(o); store_plain(a.mix + (size_t)qtok[qt] * 1024 + hd * 64 + dt * 32, o, h); }
      ss += __shfl_xor(ss, 32);
      if (h == 0) a.ssm[(size_t)hd * S + qtok[qt]] = ss;
    }
  }
  return true;
}

template <class F>
__device__ __forceinline__ void conv_tile(float* tl, bf16_t* out, int K, int n0, int k0, const F& f) {
  int tid_ = threadIdx.x; asm volatile("" : "+v"(tid_));
  const int tid = tid_, tx = tid & 63, ty = tid >> 6;
#pragma unroll 4
  for (int i = 0; i < 16; ++i) { const int k = ty + 4 * i; tl[k * 65 + tx] = f(k0 + k, n0 + tx); }
  __syncthreads();
  const int kx2 = (tid & 31) * 2, ny = tid >> 5;
#pragma unroll 4
  for (int i = 0; i < 8; ++i) { const int n = ny + 8 * i; *(unsigned*)(out + (size_t)(n0 + n) * K + k0 + kx2) = pk2(tl[kx2 * 65 + n], tl[(kx2 + 1) * 65 + n]); }
  __syncthreads();
}

__device__ void conv_layer(char* lds, const Params& p, int l) {
  float* tl = (float*)lds; char* ws = p.ws;
  const float* w_in = p.w_in + (size_t)l * 1024 * 2400; const float* g1 = p.norm1_g + l * 1024;
  const float* w_out = p.w_out + (size_t)l * 1024 * 1024; const float* gm = p.g_mla + l * 256; const float* gs = p.g_swa + l * 256; const float* gn = p.g_na + l * 256;
  const float* w_up = p.w_up + (size_t)l * 1024 * 4096; const float* g2 = p.norm2_g + l * 1024;
  const float* w_dn = p.w_down + (size_t)l * 4096 * 1024;
  const float* w_uq = p.w_uq + (size_t)l * 192 * 384; const float* qg = p.qn_g + l * 192;
  const float* w_uk = p.w_uk + (size_t)l * 128 * 256; const float* w_uv = p.w_uv + (size_t)l * 128 * 256; const float* kg = p.kvn_g + l * 128;
  const float sB = 0.17677669529663687f * LOG2E, sC = 0.125f * LOG2E, sA = 0.10206207261596577f * LOG2E;
  for (int t = bid_(); t < 2946; t += gridDim.x) {
    if (t < 608) { const int nt = t >> 4, kt = t & 15;
      conv_tile(tl, (bf16_t*)(ws + OFF_WIN), 1024, nt * 64, kt * 64, [&](int k, int n) -> float {
        int src; if (n < 192) src = n; else if (n < 224) src = 320 + n - 192; else if (n < 256) src = -1; else if (n < 384) src = 192 + n - 256; else src = 352 + n - 384;
        if (src < 0) return 0.f;
        float sc = 1.f; if (n >= 384 && n < 640) sc = sB; else if ((n >= 1152 && n < 1408) || (n >= 1664 && n < 1920)) sc = sC;
        return w_in[(size_t)k * 2400 + src] * g1[k] * sc; });
    } else if (t < 864) { const int u = t - 608, nt = u >> 4, kt = u & 15;
      conv_tile(tl, (bf16_t*)(ws + OFF_WOUT), 1024, nt * 64, kt * 64, [&](int k, int n) -> float {
        const float g = k < 256 ? gm[k] : (k < 512 ? 1.f : (k < 768 ? gs[k - 512] : gn[k - 768]));
        return w_out[(size_t)k * 1024 + n] * g; });
    } else if (t < 1888) { const int u = t - 864, nt = u >> 4, kt = u & 15;
      conv_tile(tl, (bf16_t*)(ws + OFF_WUP), 1024, nt * 64, kt * 64, [&](int k, int n) -> float { return w_up[(size_t)k * 4096 + n] * g2[k]; });
    } else if (t < 2912) { const int u = t - 1888, nt = u >> 6, kt = u & 63;
      conv_tile(tl, (bf16_t*)(ws + OFF_WDN), 4096, nt * 64, kt * 64, [&](int k, int n) -> float { return w_dn[(size_t)k * 1024 + n]; });
    } else if (t < 2930) { const int u = t - 2912, nt = u / 3, kt = u % 3;
      conv_tile(tl, (bf16_t*)(ws + OFF_WUQ), 192, nt * 64, kt * 64, [&](int k, int n) -> float { return w_uq[(size_t)k * 384 + n] * qg[k] * sA; });
    } else { const int u = t - 2930, nt = u >> 1, kt = u & 1;
      conv_tile(tl, (bf16_t*)(ws + OFF_WKV), 128, nt * 64, kt * 64, [&](int k, int n) -> float {
        return (n < 256 ? w_uk[(size_t)k * 256 + n] : w_uv[(size_t)k * 256 + n - 256]) * kg[k]; });
    }
  }
}

__device__ __forceinline__ void gbar(unsigned* base) {
  __syncthreads();
  if (threadIdx.x == 0) {
    __builtin_amdgcn_fence(__ATOMIC_RELEASE, "agent");
    const unsigned g = blockIdx.x & 15u, ng = gridDim.x >> 4;
    unsigned* cnt = base + g * 32; unsigned* root = base + 16 * 32; unsigned* gen = base + (17 + g) * 32;
    const unsigned old = __hip_atomic_load(gen, __ATOMIC_RELAXED, __HIP_MEMORY_SCOPE_AGENT);
    if (__hip_atomic_fetch_add(cnt, 1u, __ATOMIC_RELAXED, __HIP_MEMORY_SCOPE_AGENT) == ng - 1u) {
      __hip_atomic_store(cnt, 0u, __ATOMIC_RELAXED, __HIP_MEMORY_SCOPE_AGENT);
      __builtin_amdgcn_fence(__ATOMIC_RELEASE, "agent");
      if (__hip_atomic_fetch_add(root, 1u, __ATOMIC_RELAXED, __HIP_MEMORY_SCOPE_AGENT) == 15u) {
        __hip_atomic_store(root, 0u, __ATOMIC_RELAXED, __HIP_MEMORY_SCOPE_AGENT);
        __builtin_amdgcn_fence(__ATOMIC_RELEASE, "agent");
        for (unsigned k = 0; k < 16; ++k) __hip_atomic_fetch_add(base + (17 + k) * 32, 1u, __ATOMIC_RELAXED, __HIP_MEMORY_SCOPE_AGENT);
      }
    }
    while (__hip_atomic_load(gen, __ATOMIC_RELAXED, __HIP_MEMORY_SCOPE_AGENT) == old) __builtin_amdgcn_s_sleep(2);
    __builtin_amdgcn_fence(__ATOMIC_ACQUIRE, "agent");
  }
  __syncthreads();
}

__device__ __forceinline__ void sincos_acc(float ang, float& sn, float& cs) {
  const double a = (double)ang; const double n = rint(a * 0.15915494309189535);
  const double r = a - n * 6.283185307179586476925; const double r2 = r * r;
  double s = -1.0 / 51090942171709440000.0;
  s = s * r2 + 1.0 / 121645100408832000.0; s = s * r2 - 1.0 / 355687428096000.0; s = s * r2 + 1.0 / 1307674368000.0; s = s * r2 - 1.0 / 6227020800.0;
  s = s * r2 + 1.0 / 39916800.0; s = s * r2 - 1.0 / 362880.0; s = s * r2 + 1.0 / 5040.0; s = s * r2 - 1.0 / 120.0; s = s * r2 + 1.0 / 6.0; s = s * r2 - 1.0; s = -s * r;
  double c = 1.0 / 1124000727777607680000.0;
  c = c * r2 - 1.0 / 2432902008176640000.0; c = c * r2 + 1.0 / 6402373705728000.0; c = c * r2 - 1.0 / 20922789888000.0; c = c * r2 + 1.0 / 87178291200.0;
  c = c * r2 - 1.0 / 479001600.0; c = c * r2 + 1.0 / 3628800.0; c = c * r2 - 1.0 / 40320.0; c = c * r2 + 1.0 / 720.0; c = c * r2 - 1.0 / 24.0; c = c * r2 + 0.5; c = 1.0 - c * r2;
  sn = (float)s; cs = (float)c;
}

__global__ void __launch_bounds__(256, 2) mega(Params p) {
  cg::grid_group grid = cg::this_grid();
  __shared__ __attribute__((aligned(16))) char lds[73728];
  __shared__ int s_item; __shared__ int s_q[2];
#ifdef PROBE_SEL
  __shared__ unsigned long long s_t[10];
  if (threadIdx.x == 0) { for (int i = 0; i < 9; ++i) s_t[i] = 0; s_t[9] = __builtin_amdgcn_s_memrealtime(); }
#define TSTAMP(k) { if (blockIdx.x == 0 && threadIdx.x == 0) { const unsigned long long t_ = __builtin_amdgcn_s_memrealtime(); s_t[k] += t_ - s_t[9]; s_t[9] = t_; } }
#else
#define TSTAMP(k)
#endif
#define GBAR { size_t wz2_ = 0; asm volatile("" : "+s"(wz2_)); gbar((unsigned*)(p.ws + OFF_CTRL + wz2_) + 1024); }
#define WSPTRS \
  size_t wz_ = 0; asm volatile("" : "+s"(wz_)); char* ws = p.ws + wz_; \
  bf16_t* XB = (bf16_t*)(ws + OFF_XB); bf16_t* MIX = (bf16_t*)(ws + OFF_MIX); bf16_t* P = (bf16_t*)(ws + OFF_P); bf16_t* VT = (bf16_t*)(ws + OFF_VT); \
  bf16_t* QA = (bf16_t*)(ws + OFF_QA); bf16_t* KN = (bf16_t*)(ws + OFF_KN); bf16_t* VTA = (bf16_t*)(ws + OFF_VTA); bf16_t* H = (bf16_t*)(ws + OFF_H); \
  float* C32 = (float*)(ws + OFF_TAB); float* S32 = C32 + S * 16; float* C64 = S32 + S * 16; float* S64 = C64 + S * 32; \
  float* SSX = (float*)(ws + OFF_SSX); float* SSA = (float*)(ws + OFF_SSA); float* SSM = (float*)(ws + OFF_SSM); \
  unsigned* CTRL = (unsigned*)(ws + OFF_CTRL); unsigned* kmax = CTRL + 16 + 16 * l; \
  (void)XB; (void)MIX; (void)P; (void)VT; (void)QA; (void)KN; (void)VTA; (void)H; (void)C32; (void)S32; (void)C64; (void)S64; (void)SSX; (void)SSA; (void)SSM; (void)CTRL; (void)kmax;

  { const int l = 0; WSPTRS
  int tid_ = threadIdx.x; asm volatile("" : "+v"(tid_));
  const int tid = tid_, lane = tid & 63, wid = tid >> 6, gw = bid_() * 4 + wid, nw = gridDim.x * 4;
  if (blockIdx.x == 0) { for (int i = tid; i < 4096; i += 256) CTRL[i] = 0u; }
  for (int row = gw; row < S; row += nw) {
    const f32x4* xr = (const f32x4*)(p.x + (size_t)row * 1024); float s = 0.f;
#pragma unroll
    for (int i = 0; i < 4; ++i) { const f32x4 v = xr[lane + 64 * i]; s += v[0] * v[0] + v[1] * v[1] + v[2] * v[2] + v[3] * v[3];
      u32x2 w; w.x = pk2(v[0], v[1]); w.y = pk2(v[2], v[3]); *(u32x2*)(XB + (size_t)row * 1024 + (lane + 64 * i) * 4) = w; }
#pragma unroll
    for (int o = 32; o; o >>= 1) s += __shfl_xor(s, o);
    if (lane < 16) SSX[(size_t)row * 16 + lane] = lane == 0 ? s : 0.f;
  }
  for (int idx = bid_() * 256 + tid; idx < S * 48; idx += gridDim.x * 256) {
    const int pos = idx / 48, i = idx - pos * 48; float sn, cs;
    if (i < 16) { const float inv = 1.0f / powf(10000.f, (float)(2 * i) / 32.f); sincos_acc((float)pos * inv, sn, cs); C32[pos * 16 + i] = cs; S32[pos * 16 + i] = sn; }
    else { const int j = i - 16; const float inv = 1.0f / powf(10000.f, (float)(2 * j) / 64.f); sincos_acc((float)pos * inv, sn, cs); C64[pos * 32 + j] = cs; S64[pos * 32 + j] = sn; }
  }
  }

#pragma unroll 1
  for (int l = 0; l < 4; ++l) {
    conv_layer(lds, p, l);
    if (l == 0) grid.sync(); else GBAR;
    TSTAMP(0)
    { WSPTRS GemmArgs g{XB, 1024, (const bf16_t*)(ws + OFF_WIN), 1024, 1024, nullptr};
      EpiIn e{P, VT, SSX, SSA, C32, S32, C64, S64, kmax};
      bool st_ = false;
      for (int t = bid_(); t < 128 * 19; t += gridDim.x) { const int u = remap8(t, 128 * 19); const int tn = t + (int)gridDim.x; const bool hn = tn < 128 * 19; const int un = hn ? remap8(tn, 128 * 19) : 0;
        gemm_tile<false>(lds, g, (u / 19) * 128, (u % 19) * 128, e, st_, hn ? (un / 19) * 128 : -1, (un % 19) * 128); st_ = hn; } }
    GBAR; TSTAMP(1)
    { WSPTRS GemmArgs gq{P, NP, (const bf16_t*)(ws + OFF_WUQ), 192, 192, nullptr}; EpiUq eq{QA, SSA, C32, S32};
      GemmArgs gk{P + 256, NP, (const bf16_t*)(ws + OFF_WKV), 128, 128, nullptr}; EpiKv ek{KN, VTA, SSA, kmax};
      for (int t = bid_(); t < 896; t += gridDim.x) { const int u = remap8(t, 896);
        if (u < 384) gemm_tile<false>(lds, gq, (u / 3) * 128, (u % 3) * 128, eq);
        else { const int v = u - 384; gemm_tile<false>(lds, gk, (v >> 2) * 128, (v & 3) * 128, ek); } } }
    GBAR; TSTAMP(2)
    { WSPTRS AttnArgs a{P, VT, QA, KN, VTA, MIX, SSM, kmax, p.lq1 + l * 32, p.lk1 + l * 32, p.lq2 + l * 32, p.lk2 + l * 32, p.subln_g + l * 64, p.sinks + l * 4,
                 p.rpb + l * 4 * 465, p.lam_init[l]};
      unsigned* ctr = CTRL + 128 + 32 * l;
      if (threadIdx.x == 0) { int z_ = 0; asm volatile("" : "+v"(z_)); s_q[0] = z_; s_q[1] = z_; }
      for (;;) {
        if (threadIdx.x == 0) {
          const int xcc = (int)(__builtin_amdgcn_s_getreg((3 << 11) | 20) & 7u);
          const int pq_ = s_q[0]; int pass = pq_ >> 3, dq = pq_ & 7;
          int it = -1;
          if (((blockIdx.x >> 8) & 1u) && s_q[1] < 2) { const int idx = (int)atomicAdd(ctr + 16, 1u); if (idx < 1024) { it = 2048 + idx; s_q[1] = s_q[1] + 1; } else s_q[1] = 2; }
          if (it < 0)
          while (pass < 2) {
            const int ep = pass ^ (int)((blockIdx.x >> 8) & 1u);
            const int q = (xcc + dq) & 7; const int idx = (int)atomicAdd(ctr + ep * 8 + q, 1u);
            if (idx < 64) { it = ep * 1024 + (((((q >> 2) * 64 + idx) << 2)) | (q & 3)); break; }
            if (++dq == 8) { dq = 0; ++pass; }
          }
          if (it < 0) { const int idx = (int)atomicAdd(ctr + 16, 1u); it = idx < 1024 ? 2048 + idx : -1; }
          s_item = it; s_q[0] = pass * 8 + dq;
        }
        __syncthreads(); const int item = s_item; __syncthreads();
        if (item < 0) break;
        if (item < 1024) { if (!attn_pipe<1>(lds, a, item)) attn_item<1>(lds, a, item); }
        else if (item < 2048) { if (!attn_pipe<0>(lds, a, item - 1024)) attn_item<0>(lds, a, item - 1024); }
        else if (item < 2560) attn_item<2>(lds, a, item - 2048);
        else attn_item<3>(lds, a, item - 2560);
      } }
    TSTAMP(7)
    GBAR; TSTAMP(3)
    { WSPTRS GemmArgs g{MIX, 1024, (const bf16_t*)(ws + OFF_WOUT), 1024, 1024, SSM};
      EpiRes e{XB, SSX};
      bool st_ = false;
      for (int t = bid_(); t < 1024; t += gridDim.x) { const int u = remap8(t, 1024); const int tn = t + (int)gridDim.x; const bool hn = tn < 1024; const int un = hn ? remap8(tn, 1024) : 0;
        gemm_tile<true>(lds, g, (u >> 3) * 128, (u & 7) * 128, e, st_, hn ? (un >> 3) * 128 : -1, (un & 7) * 128); st_ = hn; } }
    GBAR; TSTAMP(4)
    { WSPTRS GemmArgs g{XB, 1024, (const bf16_t*)(ws + OFF_WUP), 1024, 1024, nullptr}; EpiUp e{H, SSX};
      bool st_ = false;
      for (int t = bid_(); t < 4096; t += gridDim.x) { const int u = remap8(t, 4096); const int tn = t + (int)gridDim.x; const bool hn = tn < 4096; const int un = hn ? remap8(tn, 4096) : 0;
        gemm_tile<false>(lds, g, (u >> 5) * 128, (u & 31) * 128, e, st_, hn ? (un >> 5) * 128 : -1, (un & 31) * 128); st_ = hn; } }
    GBAR; TSTAMP(5)
    { WSPTRS GemmArgs g{H, 4096, (const bf16_t*)(ws + OFF_WDN), 4096, 4096, nullptr}; EpiRes e{XB, SSX};
      bool st_ = false;
      for (int t = bid_(); t < 1024; t += gridDim.x) { const int u = remap8(t, 1024); const int tn = t + (int)gridDim.x; const bool hn = tn < 1024; const int un = hn ? remap8(tn, 1024) : 0;
        gemm_tile<false>(lds, g, (u >> 3) * 128, (u & 7) * 128, e, st_, hn ? (un >> 3) * 128 : -1, (un & 7) * 128); st_ = hn; } }
    GBAR; TSTAMP(6)
  }
  const int l = 0; WSPTRS
  int tid_ = threadIdx.x; asm volatile("" : "+v"(tid_));
  const int lane = tid_ & 63, gw = bid_() * 4 + (tid_ >> 6), nw = gridDim.x * 4;
  for (int row = gw; row < S; row += nw) {
    const float rr = rowscale_ssx(SSX, row);
    const u32x2* xr = (const u32x2*)(XB + (size_t)row * 1024); f32x4* orow = (f32x4*)(p.out + (size_t)row * 1024);
#pragma unroll
    for (int i = 0; i < 4; ++i) { const u32x2 w = xr[lane + 64 * i]; const f32x4 g = ((const f32x4*)p.fin_g)[lane + 64 * i]; f32x4 v;
      v[0] = bf2f(w.x & 0xffffu); v[1] = __uint_as_float(w.x & 0xffff0000u); v[2] = bf2f(w.y & 0xffffu); v[3] = __uint_as_float(w.y & 0xffff0000u);
      orow[lane + 64 * i] = v * rr * g; }
  }
#ifdef PROBE_SEL
  { const int l = 0; WSPTRS
    if (blockIdx.x == 0 && threadIdx.x == 0) {
      unsigned long long tot = 0, sel = 0;
      for (int i = 0; i < 9; ++i) { tot += s_t[i]; if ((PROBE_SEL >> i) & 1) sel += s_t[i]; }
      ((float*)CTRL)[500] = (float)((double)sel / (double)tot);
    }
    grid.sync();
    const float fr = ((const float*)CTRL)[500];
    for (int row = gw; row < 64; row += nw) {
      f32x4* xr = (f32x4*)(p.out + (size_t)row * 1024);
      for (int i = 0; i < 4; ++i) { f32x4 v = xr[lane + 64 * i]; const float d = 0.05f * fr; v[0] += d; v[1] -= d; v[2] += d; v[3] -= d; xr[lane + 64 * i] = v; }
    }
  }
#endif
}

extern "C" void kernel_launch(void* const* d_in, const int* in_sizes, int n_in, void* d_out, int out_size,
                              void* d_ws, size_t ws_size, hipStream_t stream) {
  static int grid_blocks = 0;
  if (!grid_blocks) {
    int dev = 0, cus = 0, per_cu = 0;
    (void)hipGetDevice(&dev);
    (void)hipDeviceGetAttribute(&cus, hipDeviceAttributeMultiprocessorCount, dev);
    (void)hipOccupancyMaxActiveBlocksPerMultiprocessor(&per_cu, mega, 256, 0);
    per_cu = 2;
    grid_blocks = cus * per_cu;
  }
  Params p{};
  const float** pp = (const float**)&p;
  for (int i = 0; i < 23; ++i) pp[i] = (const float*)d_in[i];
  p.out = (float*)d_out; p.ws = (char*)d_ws;
  for (int l = 0; l < 4; ++l) p.lam_init[l] = (float)(0.8 - 0.6 * exp(-0.3 * (double)l));
  void* args[] = {&p};
  hipError_t e = hipLaunchCooperativeKernel((void*)mega, dim3(grid_blocks), dim3(256), args, 0, stream);
  if (e != hipSuccess) fprintf(stderr, "cooperative launch failed: %s (grid %d)\n", hipGetErrorString(e), grid_blocks);
}
```
